# Optimizing an MI355X kernel written in HIP

```python
import jax, jax.numpy as jnp
from jax import lax
import numpy as np

D_MODEL = 1024
BATCH = 16
SEQ = 2048
DEPTH = 1

RET_HEADS = 4
RET_QK_DIM = 128
RET_V_DIM = 256
RET_CHUNK = 128
ROPE_BASE = 10000.0
MOBA_HEADS = 8
MOBA_HEAD_DIM = 128
MOBA_BLOCK = 256
MOBA_TOPK = 3
MOBA_Q_CHUNK = 16
D_FF = 2816
CONV_WIDTH = 3
NORM_EPS = 1e-6

RET_QK = RET_HEADS * RET_QK_DIM
RET_V = RET_HEADS * RET_V_DIM
MOBA_W = MOBA_HEADS * MOBA_HEAD_DIM
IN_SPLITS = (RET_QK, RET_QK, RET_V, RET_V, MOBA_W, MOBA_W, MOBA_W)
D_IN = RET_QK * 2 + RET_V * 2 + MOBA_W * 3

kernel_name = "hybrid_retention_moba_convffn"


def rms_norm(x, gain):
    xf = x.astype(jnp.float32)
    inv = lax.rsqrt(jnp.mean(xf * xf, axis=-1, keepdims=True) + NORM_EPS)
    return (xf * inv).astype(x.dtype) * gain


def rotary(x, pos):
    d = x.shape[-1]
    half = d // 2
    inv_freq = ROPE_BASE ** (-jnp.arange(half, dtype=jnp.float32) / half)
    ang = pos.astype(jnp.float32)[:, None] * inv_freq[None, :]
    cos = jnp.cos(ang).astype(x.dtype)
    sin = jnp.sin(ang).astype(x.dtype)
    x1, x2 = x[..., :half], x[..., half:]
    return jnp.concatenate([x1 * cos - x2 * sin, x1 * sin + x2 * cos], axis=-1)


def retention_chunkwise(q, k, v):
    B, H, S, dk = q.shape
    dv = v.shape[-1]
    C = RET_CHUNK
    n = S // C
    dt = q.dtype
    log_gamma = jnp.log1p(-jnp.power(2.0, -5.0 - jnp.arange(H, dtype=jnp.float32)))
    pos = jnp.arange(C, dtype=jnp.float32)
    diff = pos[:, None] - pos[None, :]
    decay_in = jnp.where(diff >= 0, jnp.exp(log_gamma[:, None, None] * jnp.maximum(diff, 0.0)), 0.0).astype(dt)
    zeta = jnp.exp(log_gamma[:, None] * (C - 1 - pos)[None, :]).astype(dt)
    xi = jnp.exp(log_gamma[:, None] * (pos + 1)[None, :]).astype(dt)
    gamma_c = jnp.exp(log_gamma * C).astype(dt)
    qc = q.reshape(B, H, n, C, dk)
    kc = k.reshape(B, H, n, C, dk)
    vc = v.reshape(B, H, n, C, dv)
    scores = jnp.einsum('bhncd,bhnmd->bhncm', qc, kc) * decay_in[None, :, None]
    o_inner = jnp.einsum('bhncm,bhnme->bhnce', scores, vc)
    kv = jnp.einsum('bhnmd,hm,bhnme->bhnde', kc, zeta, vc)

    def step(R, kv_n):
        return gamma_c[None, :, None, None] * R + kv_n, R

    _, r_prev = lax.scan(step, jnp.zeros((B, H, dk, dv), dt), jnp.moveaxis(kv, 2, 0))
    r_prev = jnp.moveaxis(r_prev, 0, 2)
    o_cross = jnp.einsum('bhncd,hc,bhnde->bhnce', qc, xi, r_prev)
    return (o_inner + o_cross).reshape(B, H, S, dv)


def head_group_norm(o, gain, bias):
    B, H, S, dv = o.shape
    of = o.astype(jnp.float32)
    mu = jnp.mean(of, axis=-1, keepdims=True)
    var = jnp.mean(jnp.square(of - mu), axis=-1, keepdims=True)
    on = ((of - mu) * lax.rsqrt(var + NORM_EPS)).astype(o.dtype)
    on = on.transpose(0, 2, 1, 3).reshape(B, S, H * dv)
    return on * gain + bias


def moba_attention(q, k, v):
    B, H, S, d = q.shape
    nb = -(-S // MOBA_BLOCK)
    s_pad = nb * MOBA_BLOCK
    padw = ((0, 0), (0, 0), (0, s_pad - S), (0, 0))
    q, k, v = jnp.pad(q, padw), jnp.pad(k, padw), jnp.pad(v, padw)
    kb = k.reshape(B, H, nb, MOBA_BLOCK, d)
    vb = v.reshape(B, H, nb, MOBA_BLOCK, d)
    k_mean = jnp.mean(kb.astype(jnp.float32), axis=3).astype(k.dtype)
    top = min(MOBA_TOPK, nb)
    scale = MOBA_HEAD_DIM ** -0.5
    n_chunks = s_pad // MOBA_Q_CHUNK
    q_chunks = jnp.moveaxis(q.reshape(B, H, n_chunks, MOBA_Q_CHUNK, d), 2, 0)
    b_ix = jnp.arange(B)[:, None, None, None]
    h_ix = jnp.arange(H)[None, :, None, None]
    blk_ids = jnp.arange(nb)
    slot_ids = jnp.arange(top)

    def one_chunk(args):
        i, q_i = args
        start = i * MOBA_Q_CHUNK
        own = start // MOBA_BLOCK
        t = start + jnp.arange(MOBA_Q_CHUNK)
        gate = jnp.einsum('bhqd,bhnd->bhqn', q_i, k_mean).astype(jnp.float32)
        gate = jnp.where(blk_ids < own, gate, -jnp.inf)
        _, gidx = lax.top_k(gate, top)
        valid = slot_ids < own
        gidx = jnp.where(valid, gidx, 0)
        k_sel = kb[b_ix, h_ix, gidx]
        v_sel = vb[b_ix, h_ix, gidx]
        s_sel = jnp.einsum('bhqd,bhqnkd->bhqnk', q_i, k_sel).astype(jnp.float32) * scale
        s_sel = jnp.where(valid[:, None], s_sel, -jnp.inf).reshape(B, H, MOBA_Q_CHUNK, top * MOBA_BLOCK)
        k_own = lax.dynamic_slice_in_dim(k, own * MOBA_BLOCK, MOBA_BLOCK, axis=2)
        v_own = lax.dynamic_slice_in_dim(v, own * MOBA_BLOCK, MOBA_BLOCK, axis=2)
        kpos = own * MOBA_BLOCK + jnp.arange(MOBA_BLOCK)
        s_own = jnp.einsum('bhqd,bhkd->bhqk', q_i, k_own).astype(jnp.float32) * scale
        s_own = jnp.where(kpos[None, :] <= t[:, None], s_own, -jnp.inf)
        p = jax.nn.softmax(jnp.concatenate([s_sel, s_own], axis=-1), axis=-1).astype(v.dtype)
        p_sel = p[..., :top * MOBA_BLOCK].reshape(B, H, MOBA_Q_CHUNK, top, MOBA_BLOCK)
        p_own = p[..., top * MOBA_BLOCK:]
        return (jnp.einsum('bhqnk,bhqnkd->bhqd', p_sel, v_sel)
                + jnp.einsum('bhqk,bhkd->bhqd', p_own, v_own))

    out = lax.map(one_chunk, (jnp.arange(n_chunks), q_chunks))
    out = jnp.moveaxis(out, 0, 2).reshape(B, H, s_pad, d)
    return out[:, :, :S]


def causal_depthwise_conv(h, w, b):
    S = h.shape[1]
    hp = jnp.pad(h, ((0, 0), (CONV_WIDTH - 1, 0), (0, 0)))
    out = b + w[0] * hp[:, 0:S]
    for i in range(1, CONV_WIDTH):
        out = out + w[i] * hp[:, i:i + S]
    return out


def setup_inputs(seed: int = 0) -> dict:
    key = jax.random.key(seed)
    ks = jax.random.split(key, 18)
    f32 = jnp.float32

    def nrm(k, shape, fan_in):
        return jax.random.normal(k, shape, f32) * (fan_in ** -0.5)

    def gain(k, shape):
        return 1.0 + 0.02 * jax.random.normal(k, shape, f32)

    def small(k, shape):
        return 0.02 * jax.random.normal(k, shape, f32)

    L = DEPTH
    return {
        "x": jax.random.normal(ks[0], (BATCH, SEQ, D_MODEL), f32),
        "attn_norm": gain(ks[1], (L, D_MODEL)),
        "w_in": nrm(ks[2], (L, D_MODEL, D_IN), D_MODEL),
        "ret_norm_gain": gain(ks[3], (L, RET_V)),
        "ret_norm_bias": small(ks[4], (L, RET_V)),
        "moba_q_gain": gain(ks[5], (L, MOBA_HEAD_DIM)),
        "moba_k_gain": gain(ks[6], (L, MOBA_HEAD_DIM)),
        "w_ret_o": nrm(ks[7], (L, RET_V, D_MODEL), RET_V),
        "w_moba_o": nrm(ks[8], (L, MOBA_W, D_MODEL), MOBA_W),
        "w_gate": nrm(ks[9], (L, D_MODEL, 2 * D_MODEL), D_MODEL),
        "b_gate": small(ks[10], (L, 2 * D_MODEL)),
        "w_out": nrm(ks[11], (L, D_MODEL, D_MODEL), D_MODEL),
        "ffn_norm": gain(ks[12], (L, D_MODEL)),
        "w_up": nrm(ks[13], (L, D_MODEL, 2 * D_FF), D_MODEL),
        "conv_w": nrm(ks[14], (L, CONV_WIDTH, 2 * D_FF), CONV_WIDTH),
        "conv_b": small(ks[15], (L, 2 * D_FF)),
        "w_down": nrm(ks[16], (L, D_FF, D_MODEL), D_FF),
    }


def reference(x, attn_norm, w_in, ret_norm_gain, ret_norm_bias, moba_q_gain, moba_k_gain,
              w_ret_o, w_moba_o, w_gate, b_gate, w_out, ffn_norm, w_up, conv_w, conv_b, w_down):
    B, S, _ = x.shape
    pos = jnp.arange(S)
    offsets = tuple(int(o) for o in np.cumsum(IN_SPLITS)[:-1])

    def heads(t, nh):
        return t.reshape(B, S, nh, -1).transpose(0, 2, 1, 3)

    for l in range(DEPTH):
        h = rms_norm(x, attn_norm[l])
        proj = h @ w_in[l]
        q_r, k_r, v_r, g_r, q_m, k_m, v_m = jnp.split(proj, offsets, axis=-1)
        qr = rotary(heads(q_r, RET_HEADS), pos)
        kr = rotary(heads(k_r, RET_HEADS), pos) * (RET_QK_DIM ** -0.5)
        o_r = retention_chunkwise(qr, kr, heads(v_r, RET_HEADS))
        o_r = head_group_norm(o_r, ret_norm_gain[l], ret_norm_bias[l]) * jax.nn.silu(g_r)
        y_ret = o_r @ w_ret_o[l]
        qm = rms_norm(heads(q_m, MOBA_HEADS), moba_q_gain[l])
        km = rms_norm(heads(k_m, MOBA_HEADS), moba_k_gain[l])
        o_m = moba_attention(qm, km, heads(v_m, MOBA_HEADS))
        y_moba = o_m.transpose(0, 2, 1, 3).reshape(B, S, MOBA_W) @ w_moba_o[l]
        gates = jax.nn.sigmoid(h @ w_gate[l] + b_gate[l])
        gate_ret, gate_moba = jnp.split(gates, 2, axis=-1)
        x = x + (gate_ret * y_ret + gate_moba * y_moba) @ w_out[l]
        h = rms_norm(x, ffn_norm[l])
        u = causal_depthwise_conv(h @ w_up[l], conv_w[l], conv_b[l])
        u_gate, u_val = jnp.split(u, 2, axis=-1)
        x = x + (jax.nn.silu(u_gate) * u_val) @ w_down[l]
    return x
```

```cpp
#include <hip/hip_runtime.h>
#include <hip/hip_cooperative_groups.h>
#include <cstdio>
#include <cstdint>
namespace cg = cooperative_groups;

#define LAS __attribute__((address_space(3)))
typedef unsigned short bf16_t;
typedef short bf16x8 __attribute__((ext_vector_type(8)));
typedef short s16x4 __attribute__((ext_vector_type(4)));
typedef float f32x4 __attribute__((ext_vector_type(4)));
typedef float f32x2 __attribute__((ext_vector_type(2)));
typedef float f32x16 __attribute__((ext_vector_type(16)));
typedef unsigned u32x4 __attribute__((ext_vector_type(4)));
typedef unsigned u32x2 __attribute__((ext_vector_type(2)));
typedef __bf16 bf16x2_t __attribute__((ext_vector_type(2)));

constexpr int SEQ = 2048, NB = 16, DM = 1024, M = NB * SEQ;
constexpr int DIN = 6144, NGATE = 2048, N1 = DIN + NGATE;
constexpr int DFF = 2816, NUP = 2 * DFF;
constexpr int C_QR = 0, C_KR = 512, C_VR = 1024, C_GR = 2048, C_QM = 3072, C_KM = 4096, C_VM = 5120;
constexpr float EPS = 1e-6f;
constexpr int MH = M / 2;

constexpr size_t MiB = 1u << 20;
constexpr size_t WS_W1 = 0;
constexpr size_t WS_W2 = 16 * MiB;
constexpr size_t WS_WO = 20 * MiB;
constexpr size_t WS_WUP = 22 * MiB;
constexpr size_t WS_WDN = 33 * MiB;
constexpr size_t WS_ROPE = 39 * MiB;
constexpr size_t WS_KMEAN = 40 * MiB;
constexpr size_t WS_STATS = 41 * MiB;
constexpr size_t WS_H = 48 * MiB;
constexpr size_t WS_PROJ = 112 * MiB;
constexpr size_t WS_ACT = WS_PROJ + 176 * MiB;
constexpr size_t WS_END = 496 * MiB;

constexpr int LDS_BYTES = 147456;

__device__ __forceinline__ unsigned pk2(float lo, float hi) { f32x2 v = {lo, hi}; bf16x2_t b = __builtin_convertvector(v, bf16x2_t); return __builtin_bit_cast(unsigned, b); }
__device__ __forceinline__ float bflo(unsigned u) { return __uint_as_float(u << 16); }
__device__ __forceinline__ float bfhi(unsigned u) { return __uint_as_float(u & 0xffff0000u); }
__device__ __forceinline__ float fsigmoid(float x) { return __builtin_amdgcn_rcpf(1.f + __builtin_amdgcn_exp2f(-1.4426950408889634f * x)); }
__device__ __forceinline__ void unpack8(const u32x4 v, float* f) { f[0] = bflo(v.x); f[1] = bfhi(v.x); f[2] = bflo(v.y); f[3] = bfhi(v.y); f[4] = bflo(v.z); f[5] = bfhi(v.z); f[6] = bflo(v.w); f[7] = bfhi(v.w); }
__device__ __forceinline__ u32x4 pack8(const float* f) { u32x4 o; o.x = pk2(f[0], f[1]); o.y = pk2(f[2], f[3]); o.z = pk2(f[4], f[5]); o.w = pk2(f[6], f[7]); return o; }
#define LDS_WAIT() asm volatile("s_waitcnt lgkmcnt(0)" ::: "memory")

namespace pg8 {
constexpr int BM = 256, BK = 64, HALF = 128, HTB = HALF * BK * 2, STAGE_BYTES = 8 * HTB, NXCD = 8, WGM = 8;
__host__ __device__ __forceinline__ int lds_byte(int r, int c) { const int st = (r >> 4) * 2 + (c >> 5), rr = r & 15, cc = c & 31, ob = rr * 64 + cc * 2; return st * 1024 + (ob ^ (((ob >> 9) & 1) << 5)); }
__host__ __device__ __forceinline__ void stage_rc(int b, int& R, int& C) { const int st = b / 1024, sb = b % 1024, swz = sb ^ (((sb >> 9) & 1) << 5); R = (st >> 1) * 16 + swz / 64; C = (st & 1) * 32 + (swz % 64) / 2; }
__host__ __device__ __forceinline__ int perm32(int rho) { const int n = rho >> 4, i = rho & 15; return 8 * (i >> 2) + 4 * n + (i & 3); }

struct Unit { int pm, pn; };
struct Gemm { const bf16_t* A; const bf16_t* Bt; int M, N, K, lda; };

struct StaticOrder {
    int nM, nN, nwg, G, c;
    __device__ void init(int M_, int N_, int G_, int c_) { nM = M_ / BM; nN = N_ / BM; nwg = nM * nN; G = G_; c = c_; }
    __device__ bool next(int i, Unit& u) const {
        const long L = (long)i * G + c; if (L >= nwg) return false;
        int wgid = (int)L; { const int q = nwg / NXCD, r = nwg % NXCD, xcd = wgid % NXCD, off = wgid / NXCD; wgid = (xcd < r ? xcd * (q + 1) : r * (q + 1) + (xcd - r) * q) + off; }
        const int nig = WGM * nN, gid = wgid / nig, fm = gid * WGM, gsz = (nM - fm) < WGM ? (nM - fm) : WGM;
        u.pm = fm + ((wgid % nig) % gsz); u.pn = (wgid % nig) / gsz; return true;
    }
};

typedef f32x4 Acc[2][2][4][2];

template <class Epi, bool ALIGN_EPI = true, bool SP2 = true>
__device__ __forceinline__ void gemm_phase(LAS unsigned char* lds, const Gemm g, const StaticOrder& S, const Epi& E) {
    int tid_ = threadIdx.x; asm volatile("" : "+v"(tid_));
    const int tid = tid_, wid = __builtin_amdgcn_readfirstlane(tid >> 6), lane = tid & 63, wr = wid >> 2, wc = wid & 3, fr = lane & 15, fq = lane >> 4;
    const int K = g.K, nt = K / BK, lda = g.lda;
    unsigned voffA[2], voffB[2];
#pragma unroll
    for (int i = 0; i < 2; ++i) { int R, C; stage_rc(tid * 16 + i * 8192, R, C); const int Rb = Epi::PERM ? ((R & ~31) + perm32(R & 31)) : R;
        voffA[i] = (unsigned)(R * lda + C) * 2u; voffB[i] = (unsigned)(Rb * K + C) * 2u; }
    const size_t kstep = (size_t)(BK * 2);
    const size_t hstepA = (size_t)HALF * lda * 2, hstepB = (size_t)HALF * K * 2;
    const size_t tstepA = 2 * hstepA, tstepB = 2 * hstepB;
    const unsigned ldsw = (unsigned)wid * 1024u;
    const int aoff = lds_byte(wr * 64 + fr, fq * 8), boff = lds_byte(wc * 32 + fr, fq * 8);
#define PG8_SA(b, h) (((b) * 2 + (h)) * HTB)
#define PG8_SB(b, h) ((4 + (b) * 2 + (h)) * HTB)
#define PG8_STAGE(bufoff, gbase, voff) do { _Pragma("unroll") for (int _i = 0; _i < 2; ++_i) \
        __builtin_amdgcn_global_load_lds((const unsigned*)((const char*)(gbase) + (voff)[_i]), (LAS unsigned*)(lds + (bufoff) + ldsw + _i * 8192), 16, 0, 0); } while (0)
#define PG8_LDA(dst, b, h) do { _Pragma("unroll") for (int m = 0; m < 4; ++m) _Pragma("unroll") for (int k = 0; k < 2; ++k) dst[m][k] = *(const LAS bf16x8*)(lds + PG8_SA(b, h) + aoff + m * 2048 + k * 1024); } while (0)
#define PG8_LDB(dst, b, h) do { _Pragma("unroll") for (int n = 0; n < 2; ++n) _Pragma("unroll") for (int k = 0; k < 2; ++k) dst[n][k] = *(const LAS bf16x8*)(lds + PG8_SB(b, h) + boff + n * 2048 + k * 1024); } while (0)
#define PG8_MMA(ai, bj, At, Bt) do { __builtin_amdgcn_s_setprio(1); _Pragma("unroll") for (int m = 0; m < 4; ++m) _Pragma("unroll") for (int n = 0; n < 2; ++n) _Pragma("unroll") for (int k = 0; k < 2; ++k) \
        acc[ai][bj][m][n] = __builtin_amdgcn_mfma_f32_16x16x32_bf16(Bt[n][k], At[m][k], acc[ai][bj][m][n], 0, 0, 0); __builtin_amdgcn_s_setprio(0); } while (0)
#define PG8_WAIT_V(n) asm volatile("s_waitcnt vmcnt(" #n ")" ::: "memory")
#define PG8_WAIT_L(n) asm volatile("s_waitcnt lgkmcnt(" #n ")" ::: "memory")
#define PG8_BAR __builtin_amdgcn_s_barrier()
#define PG8_SCHED __builtin_amdgcn_sched_barrier(0)
    Unit cur, nxt; int ui = 0;
    if (!S.next(0, cur)) return;
    Acc acc;
#pragma unroll
    for (int a = 0; a < 2; ++a)
#pragma unroll
        for (int b = 0; b < 2; ++b)
#pragma unroll
            for (int m = 0; m < 4; ++m)
#pragma unroll
                for (int n = 0; n < 2; ++n) acc[a][b][m][n] = (f32x4){0.f, 0.f, 0.f, 0.f};
    bf16x8 At[4][2], B0[2][2], B1[2][2];
    const char* cA = (const char*)g.A + (size_t)cur.pm * tstepA; const char* cB = (const char*)g.Bt + (size_t)cur.pn * tstepB;
    if constexpr (SP2) {
        PG8_STAGE(PG8_SB(0, 0), cB, voffB); PG8_STAGE(PG8_SB(0, 1), cB + hstepB, voffB); PG8_STAGE(PG8_SA(0, 0), cA, voffA); PG8_STAGE(PG8_SA(0, 1), cA + hstepA, voffA);
        if (wr == 1) PG8_BAR;
        PG8_WAIT_V(2); PG8_BAR;
        PG8_STAGE(PG8_SB(1, 0), cB + kstep, voffB); PG8_STAGE(PG8_SA(1, 0), cA + kstep, voffA); PG8_STAGE(PG8_SB(1, 1), cB + hstepB + kstep, voffB);
        PG8_WAIT_V(6); PG8_BAR;
    } else {
        PG8_STAGE(PG8_SB(0, 0), cB, voffB); PG8_STAGE(PG8_SA(0, 0), cA, voffA); PG8_STAGE(PG8_SB(0, 1), cB + hstepB, voffB); PG8_STAGE(PG8_SA(0, 1), cA + hstepA, voffA);
        if (wr == 1) PG8_BAR;
        PG8_WAIT_V(4); PG8_BAR;
        PG8_STAGE(PG8_SB(1, 0), cB + kstep, voffB); PG8_STAGE(PG8_SA(1, 0), cA + kstep, voffA); PG8_STAGE(PG8_SB(1, 1), cB + hstepB + kstep, voffB);
        PG8_WAIT_V(6); PG8_BAR;
    }
    for (;;) {
        const bool has_next = S.next(ui + 1, nxt);
        const char* nA = has_next ? (const char*)g.A + (size_t)nxt.pm * tstepA : cA; const char* nB = has_next ? (const char*)g.Bt + (size_t)nxt.pn * tstepB : cB;
        for (int t = 0; t < nt; t += 2) {
            const bool last = (t == nt - 2);
            const char* a1 = cA + (size_t)(t + 1) * kstep;
            const char* a2 = last ? nA : cA + (size_t)(t + 2) * kstep; const char* b2 = last ? nB : cB + (size_t)(t + 2) * kstep;
            const char* a3 = a2 + kstep; const char* b3 = b2 + kstep;
            if constexpr (Epi::HAS_MID) { if (t == Epi::MID_T) E.mid(acc, cur, wr, wc, fr, fq); }
            if constexpr (SP2) {
            PG8_LDB(B0, 0, 0); PG8_LDB(B1, 0, 1); PG8_SCHED; PG8_LDA(At, 0, 0); PG8_STAGE(PG8_SA(1, 1), a1 + hstepA, voffA);
            PG8_WAIT_V(8); PG8_WAIT_L(0); PG8_BAR; PG8_MMA(0, 0, At, B0); PG8_MMA(0, 1, At, B1); PG8_BAR; PG8_SCHED;
            PG8_LDA(At, 0, 1); PG8_STAGE(PG8_SB(0, 0), b2, voffB); PG8_STAGE(PG8_SB(0, 1), b2 + hstepB, voffB); PG8_STAGE(PG8_SA(0, 0), a2, voffA);
            PG8_WAIT_V(8); PG8_WAIT_L(0); PG8_BAR; PG8_MMA(1, 0, At, B0); PG8_MMA(1, 1, At, B1); PG8_BAR; PG8_SCHED;
            PG8_LDB(B0, 1, 0); PG8_LDB(B1, 1, 1); PG8_SCHED; PG8_LDA(At, 1, 0); PG8_STAGE(PG8_SA(0, 1), a2 + hstepA, voffA);
            PG8_WAIT_V(8); PG8_WAIT_L(0); PG8_BAR; PG8_MMA(0, 0, At, B0); PG8_MMA(0, 1, At, B1); PG8_BAR; PG8_SCHED;
            PG8_LDA(At, 1, 1); PG8_STAGE(PG8_SB(1, 0), b3, voffB); PG8_STAGE(PG8_SB(1, 1), b3 + hstepB, voffB); PG8_STAGE(PG8_SA(1, 0), a3, voffA);
            PG8_WAIT_V(8); PG8_WAIT_L(0); PG8_BAR; PG8_MMA(1, 0, At, B0); PG8_MMA(1, 1, At, B1); PG8_BAR; PG8_SCHED;
            } else {
            PG8_LDB(B0, 0, 0); PG8_SCHED; PG8_LDA(At, 0, 0); PG8_STAGE(PG8_SA(1, 1), a1 + hstepA, voffA);
            PG8_WAIT_L(8); PG8_BAR; PG8_WAIT_L(0); PG8_MMA(0, 0, At, B0); PG8_BAR; PG8_SCHED;
            PG8_LDB(B1, 0, 1); PG8_STAGE(PG8_SB(0, 0), b2, voffB);
            PG8_BAR; PG8_WAIT_L(0); PG8_MMA(0, 1, At, B1); PG8_BAR;
            PG8_LDA(At, 0, 1); PG8_STAGE(PG8_SA(0, 0), a2, voffA);
            PG8_BAR; PG8_WAIT_L(0); PG8_MMA(1, 0, At, B0); PG8_BAR; PG8_SCHED;
            PG8_STAGE(PG8_SB(0, 1), b2 + hstepB, voffB);
            PG8_WAIT_V(6); PG8_BAR; PG8_MMA(1, 1, At, B1); PG8_BAR;
            PG8_LDB(B0, 1, 0); PG8_SCHED; PG8_LDA(At, 1, 0); PG8_STAGE(PG8_SA(0, 1), a2 + hstepA, voffA);
            PG8_WAIT_L(8); PG8_BAR; PG8_WAIT_L(0); PG8_MMA(0, 0, At, B0); PG8_BAR; PG8_SCHED;
            PG8_LDB(B1, 1, 1); PG8_STAGE(PG8_SB(1, 0), b3, voffB);
            PG8_BAR; PG8_WAIT_L(0); PG8_MMA(0, 1, At, B1); PG8_BAR;
            PG8_LDA(At, 1, 1); PG8_STAGE(PG8_SA(1, 0), a3, voffA);
            PG8_BAR; PG8_WAIT_L(0); PG8_MMA(1, 0, At, B0); PG8_BAR; PG8_SCHED;
            PG8_STAGE(PG8_SB(1, 1), b3 + hstepB, voffB);
            PG8_WAIT_V(6); PG8_BAR; PG8_MMA(1, 1, At, B1); PG8_BAR;
            }
        }
        if constexpr (ALIGN_EPI) { if (wr == 0) PG8_BAR; }
        E.fin(acc, cur, wr, wc, fr, fq);
        if (!has_next) break;
#pragma unroll
        for (int a = 0; a < 2; ++a)
#pragma unroll
            for (int b = 0; b < 2; ++b)
#pragma unroll
                for (int m = 0; m < 4; ++m)
#pragma unroll
                    for (int n = 0; n < 2; ++n) acc[a][b][m][n] = (f32x4){0.f, 0.f, 0.f, 0.f};
        cur = nxt; cA = nA; cB = nB; ++ui;
        if constexpr (ALIGN_EPI) { if (wr == 1) PG8_BAR; }
    }
    PG8_WAIT_V(0);
    if constexpr (!ALIGN_EPI) { if (wr == 0) PG8_BAR; }
    PG8_BAR;
#undef PG8_SA
#undef PG8_SB
#undef PG8_STAGE
#undef PG8_LDA
#undef PG8_LDB
#undef PG8_MMA
#undef PG8_WAIT_V
#undef PG8_WAIT_L
#undef PG8_BAR
#undef PG8_SCHED
}

struct EpiProj {
    static constexpr bool PERM = true, HAS_MID = false; static constexpr int MID_T = -1;
    bf16_t* proj; bf16_t* gates; const float* bgate;
    __device__ __forceinline__ void mid(Acc&, const Unit&, int, int, int, int) const {}
    __device__ __forceinline__ void fin(const Acc& acc, const Unit& u, int wr, int wc, int fr, int fq) const {
        asm volatile("" : "+v"(fr), "+v"(fq));
        const int row0 = u.pm * BM + wr * 64 + fr; const int col0 = u.pn * BM + wc * 32 + 8 * fq;
        if (u.pn < DIN / BM) {
#pragma unroll
            for (int ai = 0; ai < 2; ++ai)
#pragma unroll
                for (int m = 0; m < 4; ++m) { bf16_t* rowp = proj + (size_t)(row0 + ai * HALF + m * 16) * DIN + col0;
#pragma unroll
                    for (int bj = 0; bj < 2; ++bj) { const f32x4 v0 = acc[ai][bj][m][0], v1 = acc[ai][bj][m][1]; u32x4 w; w.x = pk2(v0[0], v0[1]); w.y = pk2(v0[2], v0[3]); w.z = pk2(v1[0], v1[1]); w.w = pk2(v1[2], v1[3]);
                        *(u32x4*)(rowp + bj * HALF) = w; } }
        } else {
            const int gc0 = col0 - DIN;
            f32x4 bv[2][2];
#pragma unroll
            for (int bj = 0; bj < 2; ++bj)
#pragma unroll
                for (int n = 0; n < 2; ++n) bv[bj][n] = *(const f32x4*)(bgate + gc0 + bj * HALF + 4 * n);
#pragma unroll
            for (int ai = 0; ai < 2; ++ai)
#pragma unroll
                for (int m = 0; m < 4; ++m) { bf16_t* rowp = gates + (size_t)(row0 + ai * HALF + m * 16) * NGATE + gc0;
#pragma unroll
                    for (int bj = 0; bj < 2; ++bj) { const f32x4 v0 = acc[ai][bj][m][0] + bv[bj][0], v1 = acc[ai][bj][m][1] + bv[bj][1]; u32x4 w;
                        w.x = pk2(fsigmoid(v0[0]), fsigmoid(v0[1])); w.y = pk2(fsigmoid(v0[2]), fsigmoid(v0[3])); w.z = pk2(fsigmoid(v1[0]), fsigmoid(v1[1])); w.w = pk2(fsigmoid(v1[2]), fsigmoid(v1[3]));
                        *(u32x4*)(rowp + bj * HALF) = w; } }
        }
    }
};
struct EpiBf16 {
    static constexpr bool PERM = true, HAS_MID = false; static constexpr int MID_T = -1;
    bf16_t* O; int ldc;
    __device__ __forceinline__ void mid(Acc&, const Unit&, int, int, int, int) const {}
    __device__ __forceinline__ void fin(const Acc& acc, const Unit& u, int wr, int wc, int fr, int fq) const {
        asm volatile("" : "+v"(fr), "+v"(fq));
        const int row0 = u.pm * BM + wr * 64 + fr; const int col0 = u.pn * BM + wc * 32 + 8 * fq;
#pragma unroll
        for (int ai = 0; ai < 2; ++ai)
#pragma unroll
            for (int m = 0; m < 4; ++m) { bf16_t* rowp = O + (size_t)(row0 + ai * HALF + m * 16) * ldc + col0;
#pragma unroll
                for (int bj = 0; bj < 2; ++bj) { const f32x4 v0 = acc[ai][bj][m][0], v1 = acc[ai][bj][m][1]; u32x4 w; w.x = pk2(v0[0], v0[1]); w.y = pk2(v0[2], v0[3]); w.z = pk2(v1[0], v1[1]); w.w = pk2(v1[2], v1[3]);
                    *(u32x4*)(rowp + bj * HALF) = w; } }
    }
};
struct EpiMerge {
    static constexpr bool PERM = true, HAS_MID = true; static constexpr int MID_T = 16;
    const bf16_t* gates; bf16_t* O;
    __device__ __forceinline__ void mid(Acc& acc, const Unit& u, int wr, int wc, int fr, int fq) const {
        asm volatile("" : "+v"(fr), "+v"(fq));
        const int row0 = u.pm * BM + wr * 64 + fr; const int col0 = u.pn * BM + wc * 32 + 8 * fq;
#pragma unroll
        for (int ai = 0; ai < 2; ++ai)
#pragma unroll
            for (int m = 0; m < 4; ++m) { const bf16_t* gp = gates + (size_t)(row0 + ai * HALF + m * 16) * NGATE + col0;
#pragma unroll
                for (int bj = 0; bj < 2; ++bj) { const u32x4 gr = *(const u32x4*)(gp + bj * HALF), gm = *(const u32x4*)(gp + DM + bj * HALF); float a[8], b[8]; unpack8(gr, a); unpack8(gm, b);
                    f32x4 r0, r1;
#pragma unroll
                    for (int j = 0; j < 4; ++j) { r0[j] = a[j] * __builtin_amdgcn_rcpf(fmaxf(b[j], 1e-30f)); r1[j] = a[4 + j] * __builtin_amdgcn_rcpf(fmaxf(b[4 + j], 1e-30f)); }
                    acc[ai][bj][m][0] *= r0; acc[ai][bj][m][1] *= r1; asm volatile("" ::: "memory"); } }
    }
    __device__ __forceinline__ void fin(const Acc& acc, const Unit& u, int wr, int wc, int fr, int fq) const {
        asm volatile("" : "+v"(fr), "+v"(fq));
        const int row0 = u.pm * BM + wr * 64 + fr; const int col0 = u.pn * BM + wc * 32 + 8 * fq;
#pragma unroll
        for (int ai = 0; ai < 2; ++ai)
#pragma unroll
            for (int m = 0; m < 4; ++m) { const size_t r = (size_t)(row0 + ai * HALF + m * 16); const bf16_t* gp = gates + r * NGATE + DM + col0; bf16_t* rowp = O + r * DM + col0;
#pragma unroll
                for (int bj = 0; bj < 2; ++bj) { const u32x4 gm = *(const u32x4*)(gp + bj * HALF); float b[8]; unpack8(gm, b);
                    const f32x4 v0 = acc[ai][bj][m][0], v1 = acc[ai][bj][m][1]; u32x4 w;
                    w.x = pk2(v0[0] * b[0], v0[1] * b[1]); w.y = pk2(v0[2] * b[2], v0[3] * b[3]); w.z = pk2(v1[0] * b[4], v1[1] * b[5]); w.w = pk2(v1[2] * b[6], v1[3] * b[7]);
                    *(u32x4*)(rowp + bj * HALF) = w; } }
    }
};
struct EpiResid {
    static constexpr bool PERM = false, HAS_MID = false; static constexpr int MID_T = -1;
    const float* base; float* out;
    __device__ __forceinline__ void mid(Acc&, const Unit&, int, int, int, int) const {}
    __device__ __forceinline__ void fin(const Acc& acc, const Unit& u, int wr, int wc, int fr, int fq) const {
        asm volatile("" : "+v"(fr), "+v"(fq));
        const int row0 = u.pm * BM + wr * 64 + fr; const int col0 = u.pn * BM + wc * 32 + 4 * fq;
#pragma unroll
        for (int ai = 0; ai < 2; ++ai)
#pragma unroll
            for (int m = 0; m < 4; ++m) { const size_t off = (size_t)(row0 + ai * HALF + m * 16) * DM + col0;
#pragma unroll
                for (int bj = 0; bj < 2; ++bj)
#pragma unroll
                    for (int n = 0; n < 2; ++n) { const f32x4 bs = *(const f32x4*)(base + off + bj * HALF + n * 16); *(f32x4*)(out + off + bj * HALF + n * 16) = bs + acc[ai][bj][m][n]; } }
    }
};
}

__device__ __forceinline__ float wave_sum(float v) {
#pragma unroll
    for (int o = 1; o < 64; o <<= 1) v += __shfl_xor(v, o);
    return v;
}
__device__ __forceinline__ void transpose_item(const float* W, int K, int N, bf16_t* WT, int ldt, int row_off, int col_off, float* scr, int item, int lane) {
    const int nblk = N / 32, kb = item / nblk, nb = item % nblk, k0 = 64 * kb, n0 = 32 * nb;
#pragma unroll 8
    for (int i = 0; i < 32; ++i) { const int kk = 2 * i + (lane >> 5); scr[kk * 33 + (lane & 31)] = W[(size_t)(k0 + kk) * N + n0 + (lane & 31)]; }
    LDS_WAIT();
    const int c = lane & 7;
#pragma unroll
    for (int j = 0; j < 4; ++j) { const int n = (lane >> 3) + 8 * j; const float* s = scr + (8 * c) * 33 + n;
        u32x4 o; o.x = pk2(s[0 * 33], s[1 * 33]); o.y = pk2(s[2 * 33], s[3 * 33]); o.z = pk2(s[4 * 33], s[5 * 33]); o.w = pk2(s[6 * 33], s[7 * 33]);
        *(u32x4*)(WT + (size_t)(row_off + n0 + n) * ldt + col_off + k0 + 8 * c) = o; }
    LDS_WAIT();
}
__device__ __forceinline__ void rms_row_to_bf16(const float* xrow, const float* gain, bf16_t* orow, int lane) {
    const f32x4* xr = (const f32x4*)xrow + lane; const f32x4* gr = (const f32x4*)gain + lane;
    f32x4 v[4]; float s = 0.f;
#pragma unroll
    for (int j = 0; j < 4; ++j) { v[j] = xr[64 * j]; s += (v[j].x * v[j].x + v[j].y * v[j].y) + (v[j].z * v[j].z + v[j].w * v[j].w); }
    const float rstd = 1.f / sqrtf(wave_sum(s) * (1.f / DM) + EPS);
    u32x2* o8 = (u32x2*)orow + lane;
#pragma unroll
    for (int j = 0; j < 4; ++j) { const f32x4 gg = gr[64 * j]; u32x2 w; w.x = pk2(v[j].x * rstd * gg.x, v[j].y * rstd * gg.y); w.y = pk2(v[j].z * rstd * gg.z, v[j].w * rstd * gg.w); o8[64 * j] = w; }
}

__device__ __forceinline__ void retention_item(unsigned char* lds, bf16_t* proj, const f32x2* rope, f32x2* stats, int b, int h, int sl) {
    int tid_ = threadIdx.x; asm volatile("" : "+v"(tid_));
    const int tid = tid_, lane = tid & 63, w = __builtin_amdgcn_readfirstlane(tid >> 6), l15 = lane & 15, quad = lane >> 4;
    constexpr int P = 136;
    bf16_t* Qs = (bf16_t*)lds; bf16_t* Ks = Qs + 128 * P; bf16_t* KsT = Ks + 128 * P; bf16_t* VsT = KsT + 128 * P; bf16_t* RsT = VsT + 64 * P;
    const float lg2 = __builtin_log2f(1.f - __builtin_amdgcn_exp2f(-5.f - (float)h));
    const float gamma_c = __builtin_amdgcn_exp2f(lg2 * 128.f);
    const float kscale = 0.08838834764831845f;
    for (int i = tid; i < 64 * P / 2; i += 512) ((unsigned*)RsT)[i] = 0u;
    f32x4 accR[4];
#pragma unroll
    for (int i = 0; i < 4; ++i) accR[i] = (f32x4){0.f, 0.f, 0.f, 0.f};
    const size_t rowbase = (size_t)b * SEQ;
    for (int n = 0; n < 16; ++n) {
        const int t0 = n * 128;
#pragma unroll
        for (int k = 0; k < 2; ++k) {
            const int i = tid + 512 * k, r = i & 127, g8 = i >> 7;
            const bf16_t* qp = proj + (rowbase + t0 + r) * DIN + C_QR + h * 128 + 8 * g8;
            const u32x4 q1 = *(const u32x4*)qp, q2 = *(const u32x4*)(qp + 64), k1 = *(const u32x4*)(qp + C_KR), k2 = *(const u32x4*)(qp + C_KR + 64);
            const f32x4* cs = (const f32x4*)(rope + (size_t)(t0 + r) * 64 + 8 * g8);
            float a1[8], a2[8], b1[8], b2[8], cc[8], ss[8];
            unpack8(q1, a1); unpack8(q2, a2); unpack8(k1, b1); unpack8(k2, b2);
#pragma unroll
            for (int j = 0; j < 4; ++j) { const f32x4 t = cs[j]; cc[2 * j] = t.x; ss[2 * j] = t.y; cc[2 * j + 1] = t.z; ss[2 * j + 1] = t.w; }
            float qa[8], qb[8], ka[8], kb[8];
#pragma unroll
            for (int j = 0; j < 8; ++j) { qa[j] = a1[j] * cc[j] - a2[j] * ss[j]; qb[j] = a1[j] * ss[j] + a2[j] * cc[j];
                ka[j] = (b1[j] * cc[j] - b2[j] * ss[j]) * kscale; kb[j] = (b1[j] * ss[j] + b2[j] * cc[j]) * kscale; }
            *(u32x4*)(Qs + r * P + 8 * g8) = pack8(qa); *(u32x4*)(Qs + r * P + 64 + 8 * g8) = pack8(qb);
            *(u32x4*)(Ks + r * P + 8 * g8) = pack8(ka); *(u32x4*)(Ks + r * P + 64 + 8 * g8) = pack8(kb);
            const float zeta = __builtin_amdgcn_exp2f(lg2 * (float)(127 - r));
#pragma unroll
            for (int j = 0; j < 8; j += 2) { const unsigned p0 = pk2(ka[j] * zeta, ka[j + 1] * zeta), p1 = pk2(kb[j] * zeta, kb[j + 1] * zeta);
                KsT[(8 * g8 + j) * P + r] = (bf16_t)(p0 & 0xffffu); KsT[(8 * g8 + j + 1) * P + r] = (bf16_t)(p0 >> 16);
                KsT[(64 + 8 * g8 + j) * P + r] = (bf16_t)(p1 & 0xffffu); KsT[(64 + 8 * g8 + j + 1) * P + r] = (bf16_t)(p1 >> 16); }
            const u32x4 vv = *(const u32x4*)(proj + (rowbase + t0 + r) * DIN + C_VR + h * 256 + sl * 64 + 8 * g8);
            VsT[(8 * g8 + 0) * P + r] = (bf16_t)(vv.x & 0xffffu); VsT[(8 * g8 + 1) * P + r] = (bf16_t)(vv.x >> 16);
            VsT[(8 * g8 + 2) * P + r] = (bf16_t)(vv.y & 0xffffu); VsT[(8 * g8 + 3) * P + r] = (bf16_t)(vv.y >> 16);
            VsT[(8 * g8 + 4) * P + r] = (bf16_t)(vv.z & 0xffffu); VsT[(8 * g8 + 5) * P + r] = (bf16_t)(vv.z >> 16);
            VsT[(8 * g8 + 6) * P + r] = (bf16_t)(vv.w & 0xffffu); VsT[(8 * g8 + 7) * P + r] = (bf16_t)(vv.w >> 16);
        }
        __syncthreads();
        bf16x8 qf[4];
#pragma unroll
        for (int s = 0; s < 4; ++s) qf[s] = *(const bf16x8*)(Qs + (16 * w + l15) * P + 32 * s + 8 * quad);
        u32x4 pf[4];
#pragma unroll
        for (int s = 0; s < 4; ++s) pf[s] = (u32x4){0u, 0u, 0u, 0u};
        const int qpos = 16 * w + l15;
#pragma unroll
        for (int kb = 0; kb < 8; ++kb) {
            if (kb <= w) {
                f32x4 a = (f32x4){0.f, 0.f, 0.f, 0.f};
#pragma unroll
                for (int s = 0; s < 4; ++s) { const bf16x8 kf = *(const bf16x8*)(Ks + (16 * kb + l15) * P + 32 * s + 8 * quad); a = __builtin_amdgcn_mfma_f32_16x16x32_bf16(kf, qf[s], a, 0, 0, 0); }
                float pv[4];
#pragma unroll
                for (int i = 0; i < 4; ++i) { const int diff = qpos - (16 * kb + 4 * quad + i); pv[i] = diff >= 0 ? a[i] * __builtin_amdgcn_exp2f(lg2 * (float)diff) : 0.f; }
                if (kb & 1) { pf[kb >> 1].z = pk2(pv[0], pv[1]); pf[kb >> 1].w = pk2(pv[2], pv[3]); } else { pf[kb >> 1].x = pk2(pv[0], pv[1]); pf[kb >> 1].y = pk2(pv[2], pv[3]); }
            }
        }
        f32x4 ao[4], ac[4];
#pragma unroll
        for (int i = 0; i < 4; ++i) { ao[i] = (f32x4){0.f, 0.f, 0.f, 0.f}; ac[i] = (f32x4){0.f, 0.f, 0.f, 0.f}; }
#pragma unroll
        for (int s2 = 0; s2 < 4; ++s2) {
            if (2 * s2 <= w) {
#pragma unroll
                for (int dvb = 0; dvb < 4; ++dvb) { const bf16_t* vp = VsT + (16 * dvb + l15) * P + 32 * s2 + 4 * quad;
                    const s16x4 lo = *(const s16x4*)vp, hi = *(const s16x4*)(vp + 16); const bf16x8 va = __builtin_shufflevector(lo, hi, 0, 1, 2, 3, 4, 5, 6, 7);
                    ao[dvb] = __builtin_amdgcn_mfma_f32_16x16x32_bf16(va, __builtin_bit_cast(bf16x8, pf[s2]), ao[dvb], 0, 0, 0); }
            }
        }
#pragma unroll
        for (int s = 0; s < 4; ++s)
#pragma unroll
            for (int dvb = 0; dvb < 4; ++dvb) { const bf16x8 ra = *(const bf16x8*)(RsT + (16 * dvb + l15) * P + 32 * s + 8 * quad); ac[dvb] = __builtin_amdgcn_mfma_f32_16x16x32_bf16(ra, qf[s], ac[dvb], 0, 0, 0); }
        const float xi = __builtin_amdgcn_exp2f(lg2 * (float)(qpos + 1));
        float s1 = 0.f, s2s = 0.f;
        bf16_t* op = proj + (rowbase + t0 + qpos) * DIN + C_VR + h * 256 + sl * 64 + 4 * quad;
#pragma unroll
        for (int dvb = 0; dvb < 4; ++dvb) { const f32x4 o = ao[dvb] + ac[dvb] * xi; s1 += (o[0] + o[1]) + (o[2] + o[3]); s2s += (o[0] * o[0] + o[1] * o[1]) + (o[2] * o[2] + o[3] * o[3]);
            u32x2 wv; wv.x = pk2(o[0], o[1]); wv.y = pk2(o[2], o[3]); *(u32x2*)(op + 16 * dvb) = wv; }
        s1 += __shfl_xor(s1, 16); s1 += __shfl_xor(s1, 32); s2s += __shfl_xor(s2s, 16); s2s += __shfl_xor(s2s, 32);
        if (quad == 0) stats[((rowbase + t0 + qpos) * 4 + h) * 4 + sl] = (f32x2){s1, s2s};
#pragma unroll
        for (int dvb = 0; dvb < 4; ++dvb) accR[dvb] *= gamma_c;
#pragma unroll
        for (int s = 0; s < 4; ++s) { const bf16x8 ka = *(const bf16x8*)(KsT + (16 * w + l15) * P + 32 * s + 8 * quad);
#pragma unroll
            for (int dvb = 0; dvb < 4; ++dvb) { const bf16x8 vb = *(const bf16x8*)(VsT + (16 * dvb + l15) * P + 32 * s + 8 * quad); accR[dvb] = __builtin_amdgcn_mfma_f32_16x16x32_bf16(ka, vb, accR[dvb], 0, 0, 0); } }
        __syncthreads();
#pragma unroll
        for (int dvb = 0; dvb < 4; ++dvb) { u32x2 wv; wv.x = pk2(accR[dvb][0], accR[dvb][1]); wv.y = pk2(accR[dvb][2], accR[dvb][3]); *(u32x2*)(RsT + (16 * dvb + l15) * P + 16 * w + 4 * quad) = wv; }
    }
    __syncthreads();
}

__device__ __forceinline__ void knorm_item(unsigned char* lds, bf16_t* proj, const float* kgain, float* kmean, int b, int h, int blk) {
    const int tid = threadIdx.x, lane = tid & 63, w = __builtin_amdgcn_readfirstlane(tid >> 6), l15 = lane & 15, quad = lane >> 4;
    float* red = (float*)lds;
    float csum[8], gn[8];
#pragma unroll
    for (int j = 0; j < 8; ++j) { csum[j] = 0.f; gn[j] = kgain[8 * l15 + j]; }
    for (int st = 0; st < 8; ++st) {
        const int r = 32 * w + 4 * st + quad;
        bf16_t* p = proj + ((size_t)b * SEQ + blk * 256 + r) * DIN + C_KM + h * 128 + 8 * l15;
        const u32x4 v = *(const u32x4*)p; float f[8]; unpack8(v, f);
        float ss = 0.f;
#pragma unroll
        for (int j = 0; j < 8; ++j) ss += f[j] * f[j];
        ss += __shfl_xor(ss, 1); ss += __shfl_xor(ss, 2); ss += __shfl_xor(ss, 4); ss += __shfl_xor(ss, 8);
        const float rstd = 1.f / sqrtf(ss * (1.f / 128.f) + EPS);
#pragma unroll
        for (int j = 0; j < 8; ++j) { f[j] = f[j] * rstd * gn[j]; csum[j] += f[j]; }
        *(u32x4*)p = pack8(f);
    }
#pragma unroll
    for (int j = 0; j < 8; ++j) { csum[j] += __shfl_xor(csum[j], 16); csum[j] += __shfl_xor(csum[j], 32); }
    if (quad == 0) {
#pragma unroll
        for (int j = 0; j < 8; ++j) red[w * 128 + 8 * l15 + j] = csum[j];
    }
    __syncthreads();
    if (tid < 128) { float s = 0.f;
#pragma unroll
        for (int k = 0; k < 8; ++k) s += red[k * 128 + tid];
        kmean[(((size_t)b * 8 + h) * 8 + blk) * 128 + tid] = s * (1.f / 256.f); }
    __syncthreads();
}
__device__ __forceinline__ void qnorm_rows(bf16_t* proj, const float* qgain, int row4, int lane) {
    const int l15 = lane & 15, quad = lane >> 4;
    float gn[8];
#pragma unroll
    for (int j = 0; j < 8; ++j) gn[j] = qgain[8 * l15 + j];
    bf16_t* base = proj + (size_t)(4 * row4 + quad) * DIN + C_QM + 8 * l15;
#pragma unroll
    for (int hh = 0; hh < 8; ++hh) {
        bf16_t* p = base + hh * 128;
        const u32x4 v = *(const u32x4*)p; float f[8]; unpack8(v, f);
        float ss = 0.f;
#pragma unroll
        for (int j = 0; j < 8; ++j) ss += f[j] * f[j];
        ss += __shfl_xor(ss, 1); ss += __shfl_xor(ss, 2); ss += __shfl_xor(ss, 4); ss += __shfl_xor(ss, 8);
        const float rstd = 1.f / sqrtf(ss * (1.f / 128.f) + EPS);
#pragma unroll
        for (int j = 0; j < 8; ++j) f[j] = f[j] * rstd * gn[j];
        *(u32x4*)p = pack8(f);
    }
}
__device__ __forceinline__ void vtrans_item(bf16_t* T, const bf16_t* proj, bf16_t* Vt, int item, int lane) {
    const int dh = item & 1, st = (item >> 1) & 31, h = (item >> 6) & 7, b = item >> 9;
    const bf16_t* src = proj + ((size_t)b * SEQ + 64 * st + lane) * DIN + C_VM + h * 128 + 64 * dh;
#pragma unroll
    for (int c = 0; c < 8; ++c) { const u32x4 v = *(const u32x4*)(src + 8 * c);
        T[(8 * c + 0) * 72 + lane] = (bf16_t)(v.x & 0xffffu); T[(8 * c + 1) * 72 + lane] = (bf16_t)(v.x >> 16);
        T[(8 * c + 2) * 72 + lane] = (bf16_t)(v.y & 0xffffu); T[(8 * c + 3) * 72 + lane] = (bf16_t)(v.y >> 16);
        T[(8 * c + 4) * 72 + lane] = (bf16_t)(v.z & 0xffffu); T[(8 * c + 5) * 72 + lane] = (bf16_t)(v.z >> 16);
        T[(8 * c + 6) * 72 + lane] = (bf16_t)(v.w & 0xffffu); T[(8 * c + 7) * 72 + lane] = (bf16_t)(v.w >> 16); }
    LDS_WAIT();
    const int g = lane & 7;
#pragma unroll
    for (int k = 0; k < 8; ++k) { const int d = (lane >> 3) + 8 * k; const u32x4 o = *(const u32x4*)(T + d * 72 + 8 * g);
        *(u32x4*)(Vt + (((size_t)b * 8 + h) * 128 + 64 * dh + d) * SEQ + 64 * st + 8 * g) = o; }
    LDS_WAIT();
}

__device__ __forceinline__ int crow(int r, int hi) { return (r & 3) + 8 * (r >> 2) + 4 * hi; }
__device__ __forceinline__ void moba_unit(unsigned char* lds, bf16_t* proj, const bf16_t* Vt, const float* kmean, int b, int h, int own) {
    int tid_ = threadIdx.x; asm volatile("" : "+v"(tid_));
    const int tid = tid_, lane = tid & 63, w = __builtin_amdgcn_readfirstlane(tid >> 6), r32 = lane & 31, hh = lane >> 5;
    constexpr int KP = 136, VP = 72;
    bf16_t* KsB = (bf16_t*)lds;
    bf16_t* VsB = KsB + 2 * 64 * KP;
    const size_t rowbase = (size_t)b * SEQ;
    const int qrel = 32 * w + r32;
    bf16_t* qptr = proj + (rowbase + own * 256 + qrel) * DIN + C_QM + h * 128;
    bf16x8 qf[8];
#pragma unroll
    for (int s = 0; s < 8; ++s) qf[s] = *(const bf16x8*)(qptr + 16 * s + 8 * hh);
    unsigned sel = 0u;
    {
        float g[7];
        const float* km = kmean + ((size_t)b * 8 + h) * 8 * 128;
#pragma unroll
        for (int jb = 0; jb < 7; ++jb) {
            float a = 0.f;
            if (jb < own) {
#pragma unroll
                for (int s = 0; s < 8; ++s) { const f32x4 k0 = *(const f32x4*)(km + jb * 128 + 16 * s + 8 * hh), k1 = *(const f32x4*)(km + jb * 128 + 16 * s + 8 * hh + 4);
                    const u32x4 qu = __builtin_bit_cast(u32x4, qf[s]);
                    a += bflo(qu.x) * k0.x + bfhi(qu.x) * k0.y + bflo(qu.y) * k0.z + bfhi(qu.y) * k0.w + bflo(qu.z) * k1.x + bfhi(qu.z) * k1.y + bflo(qu.w) * k1.z + bfhi(qu.w) * k1.w; }
                a += __shfl_xor(a, 32);
            }
            g[jb] = a;
        }
#pragma unroll
        for (int jb = 0; jb < 7; ++jb) {
            int rank = 0;
#pragma unroll
            for (int j2 = 0; j2 < 7; ++j2) { if (j2 != jb) { const bool better = (g[j2] > g[jb]) || (g[j2] == g[jb] && j2 < jb); rank += (j2 < own && better) ? 1 : 0; } }
            if (jb < own && rank < 3) sel |= (1u << jb);
        }
    }
    f32x16 o[4];
#pragma unroll
    for (int i = 0; i < 4; ++i)
#pragma unroll
        for (int r = 0; r < 16; ++r) o[i][r] = 0.f;
    float mrun = -1e30f, lrun = 0.f;
    const float SC = 0.08838834764831845f * 1.4426950408889634f;
    const int NT = 4 * (own + 1);
    const bf16_t* kg = proj + rowbase * DIN + C_KM + h * 128;
    const bf16_t* vg = Vt + (((size_t)b * 8 + h) * 128) * SEQ;
    u32x4 kr[2], vr[2];
#define MOBA_LOAD(t) do { _Pragma("unroll") for (int k_ = 0; k_ < 2; ++k_) { const int c_ = tid + 512 * k_; \
        kr[k_] = *(const u32x4*)(kg + (size_t)(64 * (t) + (c_ >> 4)) * DIN + 8 * (c_ & 15)); \
        vr[k_] = *(const u32x4*)(vg + (size_t)(c_ >> 3) * SEQ + 64 * (t) + 8 * (c_ & 7)); } } while (0)
#define MOBA_STORE(buf) do { _Pragma("unroll") for (int k_ = 0; k_ < 2; ++k_) { const int c_ = tid + 512 * k_; \
        *(u32x4*)(KsB + (buf) * 64 * KP + (c_ >> 4) * KP + 8 * (c_ & 15)) = kr[k_]; \
        *(u32x4*)(VsB + (buf) * 128 * VP + (c_ >> 3) * VP + 8 * (c_ & 7)) = vr[k_]; } } while (0)
    MOBA_LOAD(0);
    for (int t = 0; t < NT; ++t) {
        const int buf = t & 1;
        MOBA_STORE(buf);
        __syncthreads();
        if (t + 1 < NT) MOBA_LOAD(t + 1);
        const int jb = t >> 2, kt = t & 3;
        const bool isown = (jb == own);
        bool active;
        if (isown) active = (64 * kt <= 32 * w + 31);
        else active = __any((sel >> jb) & 1u) != 0;
        if (active) {
            const bf16_t* Kt = KsB + buf * 64 * KP; const bf16_t* Vv = VsB + buf * 128 * VP;
            f32x16 sc[2];
#pragma unroll
            for (int kb = 0; kb < 2; ++kb) {
#pragma unroll
                for (int r = 0; r < 16; ++r) sc[kb][r] = 0.f;
#pragma unroll
                for (int s = 0; s < 8; ++s) { const bf16x8 kf = *(const bf16x8*)(Kt + (32 * kb + r32) * KP + 16 * s + 8 * hh); sc[kb] = __builtin_amdgcn_mfma_f32_32x32x16_bf16(kf, qf[s], sc[kb], 0, 0, 0); }
            }
            const bool lane_sel = ((sel >> jb) & 1u) != 0u;
            float mx = -INFINITY;
#pragma unroll
            for (int kb = 0; kb < 2; ++kb)
#pragma unroll
                for (int r = 0; r < 16; ++r) {
                    float v = sc[kb][r] * SC;
                    if (isown) { const int krel = 64 * kt + 32 * kb + crow(r, hh); if (krel > qrel) v = -INFINITY; }
                    else if (!lane_sel) v = -INFINITY;
                    sc[kb][r] = v; mx = fmaxf(mx, v);
                }
            mx = fmaxf(mx, __shfl_xor(mx, 32));
            const float mnew = fmaxf(mrun, mx);
            const float alpha = __builtin_amdgcn_exp2f(mrun - mnew);
            float ps = 0.f;
#pragma unroll
            for (int kb = 0; kb < 2; ++kb)
#pragma unroll
                for (int r = 0; r < 16; ++r) { const float p = __builtin_amdgcn_exp2f(sc[kb][r] - mnew); sc[kb][r] = p; ps += p; }
            ps += __shfl_xor(ps, 32);
            lrun = lrun * alpha + ps; mrun = mnew;
#pragma unroll
            for (int i = 0; i < 4; ++i)
#pragma unroll
                for (int r = 0; r < 16; ++r) o[i][r] *= alpha;
#pragma unroll
            for (int kb = 0; kb < 2; ++kb)
#pragma unroll
                for (int s = 0; s < 2; ++s) {
                    u32x4 pw; pw.x = pk2(sc[kb][8 * s + 0], sc[kb][8 * s + 1]); pw.y = pk2(sc[kb][8 * s + 2], sc[kb][8 * s + 3]); pw.z = pk2(sc[kb][8 * s + 4], sc[kb][8 * s + 5]); pw.w = pk2(sc[kb][8 * s + 6], sc[kb][8 * s + 7]);
                    const bf16x8 pb = __builtin_bit_cast(bf16x8, pw);
#pragma unroll
                    for (int db = 0; db < 4; ++db) { const bf16_t* vp = Vv + (32 * db + r32) * VP + 32 * kb + 16 * s + 4 * hh;
                        const s16x4 lo = *(const s16x4*)vp, hi = *(const s16x4*)(vp + 8); const bf16x8 va = __builtin_shufflevector(lo, hi, 0, 1, 2, 3, 4, 5, 6, 7);
                        o[db] = __builtin_amdgcn_mfma_f32_32x32x16_bf16(va, pb, o[db], 0, 0, 0); }
                }
        }
    }
#undef MOBA_LOAD
#undef MOBA_STORE
    const float rl = 1.f / lrun;
#pragma unroll
    for (int db = 0; db < 4; ++db)
#pragma unroll
        for (int g4 = 0; g4 < 4; ++g4) { u32x2 wv; wv.x = pk2(o[db][4 * g4 + 0] * rl, o[db][4 * g4 + 1] * rl); wv.y = pk2(o[db][4 * g4 + 2] * rl, o[db][4 * g4 + 3] * rl);
            *(u32x2*)(qptr + 32 * db + 8 * g4 + 4 * hh) = wv; }
    __syncthreads();
}

__device__ __forceinline__ void retfin_row(bf16_t* proj, const f32x2* stats, const float* gain, const float* bias, int m, int lane) {
    const int hd = lane >> 4;
    const f32x2* st = stats + ((size_t)m * 4 + hd) * 4;
    const f32x2 s0 = st[0], s1 = st[1], s2 = st[2], s3 = st[3];
    const float mu = ((s0.x + s1.x) + (s2.x + s3.x)) * (1.f / 256.f);
    const float var = fmaxf(((s0.y + s1.y) + (s2.y + s3.y)) * (1.f / 256.f) - mu * mu, 0.f);
    const float rstd = 1.f / sqrtf(var + EPS);
    bf16_t* op = proj + (size_t)m * DIN + C_VR + 16 * lane; bf16_t* gp = proj + (size_t)m * DIN + C_GR + 16 * lane;
#pragma unroll
    for (int k = 0; k < 2; ++k) {
        const u32x4 ov = *(const u32x4*)(op + 8 * k), gv = *(const u32x4*)(gp + 8 * k); float of[8], gf[8], r[8]; unpack8(ov, of); unpack8(gv, gf);
        const f32x4 ga = *(const f32x4*)(gain + 16 * lane + 8 * k), gb = *(const f32x4*)(gain + 16 * lane + 8 * k + 4), ba = *(const f32x4*)(bias + 16 * lane + 8 * k), bb = *(const f32x4*)(bias + 16 * lane + 8 * k + 4);
        const float gg[8] = {ga.x, ga.y, ga.z, ga.w, gb.x, gb.y, gb.z, gb.w}, bbv[8] = {ba.x, ba.y, ba.z, ba.w, bb.x, bb.y, bb.z, bb.w};
#pragma unroll
        for (int j = 0; j < 8; ++j) { const float on = __uint_as_float(pk2((of[j] - mu) * rstd, 0.f) << 16); r[j] = (on * gg[j] + bbv[j]) * (gf[j] * fsigmoid(gf[j])); }
        *(u32x4*)(gp + 8 * k) = pack8(r);
    }
}

struct Args { const float* in[17]; float* out; unsigned char* ws; };

__global__ void __launch_bounds__(512, 2) fwd_kernel(Args args) {
    extern __shared__ __attribute__((aligned(16))) unsigned char lds[];
    cg::grid_group grid = cg::this_grid();
    const int tid = threadIdx.x, lane = tid & 63, wave = __builtin_amdgcn_readfirstlane(tid >> 6);
    const int G = gridDim.x, bid = blockIdx.x;
    const int gw = bid * 8 + wave, NGW = G * 8;
    unsigned char* ws = args.ws;
    const float* x = args.in[0]; const float* attn_norm = args.in[1]; const float* w_in = args.in[2]; const float* ret_gain = args.in[3]; const float* ret_bias = args.in[4];
    const float* q_gain = args.in[5]; const float* k_gain = args.in[6]; const float* w_ret_o = args.in[7]; const float* w_moba_o = args.in[8]; const float* w_gate = args.in[9];
    const float* b_gate = args.in[10]; const float* w_out = args.in[11]; const float* ffn_norm = args.in[12]; const float* w_up = args.in[13]; const float* conv_w = args.in[14];
    const float* conv_b = args.in[15]; const float* w_down = args.in[16];
    float* out = args.out;
    bf16_t* W1 = (bf16_t*)(ws + WS_W1); bf16_t* W2 = (bf16_t*)(ws + WS_W2); bf16_t* WO = (bf16_t*)(ws + WS_WO); bf16_t* WUP = (bf16_t*)(ws + WS_WUP); bf16_t* WDN = (bf16_t*)(ws + WS_WDN);
    f32x2* rope = (f32x2*)(ws + WS_ROPE); float* kmean = (float*)(ws + WS_KMEAN); f32x2* stats = (f32x2*)(ws + WS_STATS);
    bf16_t* HB = (bf16_t*)(ws + WS_H); bf16_t* PROJ = (bf16_t*)(ws + WS_PROJ); bf16_t* UPRE = (bf16_t*)(ws + WS_PROJ); bf16_t* ACT = (bf16_t*)(ws + WS_ACT);
    bf16_t* GATES = (bf16_t*)out;
    LAS unsigned char* lds3 = (LAS unsigned char*)lds;

#ifndef PHMASK
#define PHMASK 0xffff
#endif
#define RUNP(n) ((((PHMASK) >> (n)) & 1) != 0)
    if constexpr (RUNP(0)) {
        float* scr = (float*)(lds + wave * 16384);
        constexpr int I_IN = 16 * (DIN / 32), I_G = 16 * (NGATE / 32), I_O = 16 * 32, I_UP = 16 * (NUP / 32), I_DN = (DFF / 64) * 32;
        constexpr int NITEMS = I_IN + I_G + 3 * I_O + I_UP + I_DN;
        for (int it = gw; it < NITEMS; it += NGW) {
            int r = it;
            if (r < I_IN) { transpose_item(w_in, DM, DIN, W1, DM, 0, 0, scr, r, lane); continue; } r -= I_IN;
            if (r < I_G) { transpose_item(w_gate, DM, NGATE, W1, DM, DIN, 0, scr, r, lane); continue; } r -= I_G;
            if (r < I_O) { transpose_item(w_ret_o, DM, DM, W2, 2 * DM, 0, 0, scr, r, lane); continue; } r -= I_O;
            if (r < I_O) { transpose_item(w_moba_o, DM, DM, W2, 2 * DM, 0, DM, scr, r, lane); continue; } r -= I_O;
            if (r < I_O) { transpose_item(w_out, DM, DM, WO, DM, 0, 0, scr, r, lane); continue; } r -= I_O;
            if (r < I_UP) { transpose_item(w_up, DM, NUP, WUP, DM, 0, 0, scr, r, lane); continue; } r -= I_UP;
            transpose_item(w_down, DFF, DM, WDN, DFF, 0, 0, scr, r, lane);
        }
        for (int m = gw; m < M; m += NGW) rms_row_to_bf16(x + (size_t)m * DM, attn_norm, HB + (size_t)m * DM, lane);
        for (int i = bid * 512 + tid; i < SEQ * 64; i += G * 512) {
            const int pos = i >> 6, fi = i & 63;
            const float inv_freq = __builtin_amdgcn_exp2f(-(float)fi * (13.287712379549449f / 64.f));
            double rev = (double)pos * (double)inv_freq * 0.15915494309189535; rev -= __builtin_floor(rev);
            const float rf = (float)rev;
            rope[i] = (f32x2){__builtin_amdgcn_cosf(rf), __builtin_amdgcn_sinf(rf)};
        }
    }
    grid.sync();
    if constexpr (RUNP(1)) {
        pg8::Gemm g{HB, W1, M, N1, DM, DM}; pg8::StaticOrder S; S.init(M, N1, G, bid);
        pg8::EpiProj E{PROJ, GATES, b_gate};
        pg8::gemm_phase<pg8::EpiProj>(lds3, g, S, E);
    }
    grid.sync();
    if constexpr (RUNP(2)) {
        if constexpr (RUNP(10)) for (int it = bid; it < NB * 4 * 4; it += G) retention_item(lds, PROJ, rope, stats, it >> 4, (it >> 2) & 3, it & 3);
        for (int it = bid; it < NB * 8 * 8; it += G) knorm_item(lds, PROJ, k_gain, kmean, it >> 6, (it >> 3) & 7, it & 7);
        for (int r4 = gw; r4 < M / 4; r4 += NGW) qnorm_rows(PROJ, q_gain, r4, lane);
        bf16_t* T = (bf16_t*)(lds + wave * 16384);
        for (int it = gw; it < NB * 8 * 32 * 2; it += NGW) vtrans_item(T, PROJ, HB, it, lane);
    }
    grid.sync();
    if constexpr (RUNP(3)) {
        for (int bh = bid >> 1; bh < NB * 8; bh += (G >> 1)) {
            const int par = bid & 1;
#pragma unroll 1
            for (int k = 0; k < 4; ++k) { const int own = par ? (k == 0 ? 6 : k == 1 ? 5 : k == 2 ? 2 : 1) : (k == 0 ? 7 : k == 1 ? 4 : k == 2 ? 3 : 0);
                moba_unit(lds, PROJ, HB, kmean, bh >> 3, bh & 7, own); }
        }
        for (int m = gw; m < M; m += NGW) retfin_row(PROJ, stats, ret_gain, ret_bias, m, lane);
    }
    grid.sync();
    if constexpr (RUNP(4)) {
        pg8::Gemm g{PROJ + C_GR, W2, M, DM, 2 * DM, DIN}; pg8::StaticOrder S; S.init(M, DM, G, bid);
        pg8::EpiMerge E{GATES, HB};
        pg8::gemm_phase<pg8::EpiMerge>(lds3, g, S, E);
    }
    grid.sync();
    if constexpr (RUNP(5)) {
        pg8::Gemm g{HB, WO, M, DM, DM, DM}; pg8::StaticOrder S; S.init(M, DM, G, bid);
        pg8::EpiResid E{x, out};
        pg8::gemm_phase<pg8::EpiResid>(lds3, g, S, E);
    }
    grid.sync();
    for (int m = gw; m < M; m += NGW) rms_row_to_bf16(out + (size_t)m * DM, ffn_norm, HB + (size_t)m * DM, lane);
    grid.sync();
#pragma unroll 1
    for (int hf = 0; hf < 2; ++hf) {
        if constexpr (RUNP(7)) {
            pg8::Gemm g{HB + (size_t)hf * MH * DM, WUP, MH, NUP, DM, DM}; pg8::StaticOrder S; S.init(MH, NUP, G, bid);
            pg8::EpiBf16 E{UPRE, NUP};
            pg8::gemm_phase<pg8::EpiBf16>(lds3, g, S, E);
        }
        grid.sync();
        if constexpr (RUNP(8)) {
            constexpr int C8 = DFF / 8;
            for (int i = bid * 512 + tid; i < MH * C8; i += G * 512) {
                const int ml = i / C8, c = (i - ml * C8) * 8; const int s = ml & (SEQ - 1);
                float ug[8], uv[8];
                {
                    const f32x4 b0 = *(const f32x4*)(conv_b + c), b1 = *(const f32x4*)(conv_b + c + 4), d0 = *(const f32x4*)(conv_b + DFF + c), d1 = *(const f32x4*)(conv_b + DFF + c + 4);
                    ug[0] = b0.x; ug[1] = b0.y; ug[2] = b0.z; ug[3] = b0.w; ug[4] = b1.x; ug[5] = b1.y; ug[6] = b1.z; ug[7] = b1.w;
                    uv[0] = d0.x; uv[1] = d0.y; uv[2] = d0.z; uv[3] = d0.w; uv[4] = d1.x; uv[5] = d1.y; uv[6] = d1.z; uv[7] = d1.w;
                }
#pragma unroll
                for (int tap = 0; tap < 3; ++tap) {
                    const int back = 2 - tap;
                    if (s >= back) {
                        const bf16_t* up = UPRE + (size_t)(ml - back) * NUP + c;
                        const u32x4 a = *(const u32x4*)up, bq = *(const u32x4*)(up + DFF); float fa[8], fb[8]; unpack8(a, fa); unpack8(bq, fb);
                        const float* wg = conv_w + (size_t)tap * NUP + c; const float* wv = wg + DFF;
                        const f32x4 w0 = *(const f32x4*)wg, w1 = *(const f32x4*)(wg + 4), v0 = *(const f32x4*)wv, v1 = *(const f32x4*)(wv + 4);
                        ug[0] += w0.x * fa[0]; ug[1] += w0.y * fa[1]; ug[2] += w0.z * fa[2]; ug[3] += w0.w * fa[3]; ug[4] += w1.x * fa[4]; ug[5] += w1.y * fa[5]; ug[6] += w1.z * fa[6]; ug[7] += w1.w * fa[7];
                        uv[0] += v0.x * fb[0]; uv[1] += v0.y * fb[1]; uv[2] += v0.z * fb[2]; uv[3] += v0.w * fb[3]; uv[4] += v1.x * fb[4]; uv[5] += v1.y * fb[5]; uv[6] += v1.z * fb[6]; uv[7] += v1.w * fb[7];
                    }
                }
                float r[8];
#pragma unroll
                for (int j = 0; j < 8; ++j) r[j] = ug[j] * fsigmoid(ug[j]) * uv[j];
                *(u32x4*)(ACT + (size_t)ml * DFF + c) = pack8(r);
            }
        }
        grid.sync();
        if constexpr (RUNP(9)) {
            pg8::Gemm g{ACT, WDN, MH, DM, DFF, DFF}; pg8::StaticOrder S; S.init(MH, DM, G, bid);
            pg8::EpiResid E{out + (size_t)hf * MH * DM, out + (size_t)hf * MH * DM};
            pg8::gemm_phase<pg8::EpiResid>(lds3, g, S, E);
        }
        if (hf == 0) grid.sync();
    }
}

extern "C" void kernel_launch(void* const* d_in, const int* in_sizes, int n_in, void* d_out, int out_size, void* d_ws, size_t ws_size, hipStream_t stream) {
    static int grid = 0;
    if (grid == 0) {
        if (n_in != 17 || out_size != M * DM || ws_size < WS_END) { fprintf(stderr, "kernel_launch: unexpected shapes (n_in %d out %d ws %zu)\n", n_in, out_size, ws_size); grid = -1; return; }
        int dev = 0, cus = 0, per_cu = 0;
        hipGetDevice(&dev); hipDeviceGetAttribute(&cus, hipDeviceAttributeMultiprocessorCount, dev);
        hipFuncSetAttribute((const void*)fwd_kernel, hipFuncAttributeMaxDynamicSharedMemorySize, LDS_BYTES);
        hipOccupancyMaxActiveBlocksPerMultiprocessor(&per_cu, (const void*)fwd_kernel, 512, LDS_BYTES);
        if (per_cu < 1) { fprintf(stderr, "kernel_launch: occupancy query says %d blocks per CU\n", per_cu); per_cu = 1; }
        (void)hipGetLastError();
        grid = cus * per_cu;
    }
    if (grid < 0) return;
    Args a{};
    for (int i = 0; i < 17; ++i) a.in[i] = (const float*)d_in[i];
    a.out = (float*)d_out; a.ws = (unsigned char*)d_ws;
    void* params[] = {&a};
    hipError_t e = hipLaunchCooperativeKernel((const void*)fwd_kernel, dim3(grid), dim3(512), params, LDS_BYTES, stream);
    if (e != hipSuccess) fprintf(stderr, "cooperative launch failed: %s (grid %d)\n", hipGetErrorString(e), grid);
}
```

```cpp
#include <hip/hip_runtime.h>
#include <hip/hip_cooperative_groups.h>
#include <cstdio>
#include <cstdint>
namespace cg = cooperative_groups;

#define LAS __attribute__((address_space(3)))
typedef unsigned short bf16_t;
typedef short bf16x8 __attribute__((ext_vector_type(8)));
typedef short s16x4 __attribute__((ext_vector_type(4)));
typedef float f32x4 __attribute__((ext_vector_type(4)));
typedef float f32x2 __attribute__((ext_vector_type(2)));
typedef float f32x16 __attribute__((ext_vector_type(16)));
typedef unsigned u32x4 __attribute__((ext_vector_type(4)));
typedef unsigned u32x2 __attribute__((ext_vector_type(2)));
typedef __bf16 bf16x2_t __attribute__((ext_vector_type(2)));

constexpr int SEQ = 2048, NB = 16, DM = 1024, M = NB * SEQ;
constexpr int DIN = 6144, NGATE = 2048, N1 = DIN + NGATE;
constexpr int DFF = 2816, NUP = 2 * DFF;
constexpr int C_QR = 0, C_KR = 512, C_VR = 1024, C_GR = 2048, C_QM = 3072, C_KM = 4096, C_VM = 5120;
constexpr float EPS = 1e-6f;
constexpr int RET_QKW = 512;
constexpr int MH = M / 2;

constexpr size_t MiB = 1u << 20;
constexpr size_t WS_W1 = 0;
constexpr size_t WS_W2 = 16 * MiB;
constexpr size_t WS_WO = 20 * MiB;
constexpr size_t WS_WUP = 22 * MiB;
constexpr size_t WS_WDN = 33 * MiB;
constexpr size_t WS_ROPE = 39 * MiB;
constexpr size_t WS_KMEAN = 40 * MiB;
constexpr size_t WS_STATS = 41 * MiB;
constexpr size_t WS_H = 48 * MiB;
constexpr size_t WS_PROJ = 112 * MiB;
constexpr size_t WS_XB = WS_PROJ + 224 * MiB;
constexpr size_t WS_RSTD = 45 * MiB;
constexpr size_t WS_UH = WS_PROJ + 200 * MiB;
constexpr size_t WS_END = 496 * MiB;

constexpr int LDS_BYTES = 147456;

__device__ __forceinline__ unsigned pk2(float lo, float hi) { f32x2 v = {lo, hi}; bf16x2_t b = __builtin_convertvector(v, bf16x2_t); return __builtin_bit_cast(unsigned, b); }
__device__ __forceinline__ float bflo(unsigned u) { return __uint_as_float(u << 16); }
__device__ __forceinline__ float bfhi(unsigned u) { return __uint_as_float(u & 0xffff0000u); }
__device__ __forceinline__ float fsigmoid(float x) { return __builtin_amdgcn_rcpf(1.f + __builtin_amdgcn_exp2f(-1.4426950408889634f * x)); }
__device__ __forceinline__ void unpack8(const u32x4 v, float* f) { f[0] = bflo(v.x); f[1] = bfhi(v.x); f[2] = bflo(v.y); f[3] = bfhi(v.y); f[4] = bflo(v.z); f[5] = bfhi(v.z); f[6] = bflo(v.w); f[7] = bfhi(v.w); }
__device__ __forceinline__ u32x4 pack8(const float* f) { u32x4 o; o.x = pk2(f[0], f[1]); o.y = pk2(f[2], f[3]); o.z = pk2(f[4], f[5]); o.w = pk2(f[6], f[7]); return o; }
#define LDS_WAIT() asm volatile("s_waitcnt lgkmcnt(0)" ::: "memory")

namespace pg8 {
constexpr int BM = 256, BK = 64, HALF = 128, HTB = HALF * BK * 2, STAGE_BYTES = 8 * HTB, NXCD = 8, WGM = 4;
__host__ __device__ __forceinline__ int lds_byte(int r, int c) { const int st = (r >> 4) * 2 + (c >> 5), rr = r & 15, cc = c & 31, ob = rr * 64 + cc * 2; return st * 1024 + (ob ^ (((ob >> 9) & 1) << 5)); }
__host__ __device__ __forceinline__ void stage_rc(int b, int& R, int& C) { const int st = b / 1024, sb = b % 1024, swz = sb ^ (((sb >> 9) & 1) << 5); R = (st >> 1) * 16 + swz / 64; C = (st & 1) * 32 + (swz % 64) / 2; }
__host__ __device__ __forceinline__ int perm32(int rho) { const int n = rho >> 4, i = rho & 15; return 8 * (i >> 2) + 4 * n + (i & 3); }

struct Unit { int pm, pn; };
struct Gemm { const bf16_t* A; const bf16_t* Bt; int M, N, K, lda; };

struct StaticOrder {
    int nM, nN, nwg, G, c;
    __device__ void init(int M_, int N_, int G_, int c_) { nM = M_ / BM; nN = N_ / BM; nwg = nM * nN; G = G_; c = c_; }
    __device__ bool next(int i, Unit& u) const {
        const long L = (long)i * G + c; if (L >= nwg) return false;
        int wgid = (int)L; { const int q = nwg / NXCD, r = nwg % NXCD, xcd = wgid % NXCD, off = wgid / NXCD; wgid = (xcd < r ? xcd * (q + 1) : r * (q + 1) + (xcd - r) * q) + off; }
        const int nig = WGM * nN, gid = wgid / nig, fm = gid * WGM, gsz = (nM - fm) < WGM ? (nM - fm) : WGM;
        u.pm = fm + ((wgid % nig) % gsz); u.pn = (wgid % nig) / gsz; return true;
    }
};

typedef f32x4 Acc[2][2][4][2];

template <class Epi, bool ALIGN_EPI = true, bool SP2 = true, bool SWAP = false>
__device__ __forceinline__ void gemm_phase(LAS unsigned char* lds, const Gemm g, const StaticOrder& S, const Epi& E) {
    int tid_ = threadIdx.x; asm volatile("" : "+v"(tid_));
    const int tid = tid_, wid = __builtin_amdgcn_readfirstlane(tid >> 6), lane = tid & 63, wr = wid >> 2, wc = wid & 3, fr = lane & 15, fq = lane >> 4;
    const int K = g.K, nt = K / BK, lda = g.lda;
    unsigned voffA[2], voffB[2], voffB1[2];
#pragma unroll
    for (int i = 0; i < 2; ++i) { int R, C; stage_rc(tid * 16 + i * 8192, R, C); const int Rb = Epi::PERM ? ((R & ~31) + perm32(R & 31)) : R;
        voffA[i] = (unsigned)(R * lda + C) * 2u; voffB[i] = (unsigned)(Rb * K + C) * 2u; voffB1[i] = voffB[i];
        if constexpr (Epi::ADJ) { const int r0 = 64 * (R >> 5) + perm32(R & 31); voffB[i] = (unsigned)(r0 * K + C) * 2u; voffB1[i] = (unsigned)((r0 + 32) * K + C) * 2u; } }
    const size_t kstep = (size_t)(BK * 2);
    const size_t hstepA = (size_t)HALF * lda * 2, hstepB_ = (size_t)HALF * K * 2;
    const size_t tstepA = 2 * hstepA, tstepB = 2 * hstepB_;
    const size_t hstepB = Epi::ADJ ? 0 : hstepB_;
    const unsigned ldsw = (unsigned)wid * 1024u;
    const int aoff = lds_byte(wr * 64 + fr, fq * 8), boff = lds_byte(wc * 32 + fr, fq * 8);
#define PG8_SA(b, h) (((b) * 2 + (h)) * HTB)
#define PG8_SB(b, h) ((4 + (b) * 2 + (h)) * HTB)
#define PG8_STAGE(bufoff, gbase, voff) do { _Pragma("unroll") for (int _i = 0; _i < 2; ++_i) \
        __builtin_amdgcn_global_load_lds((const unsigned*)((const char*)(gbase) + (voff)[_i]), (LAS unsigned*)(lds + (bufoff) + ldsw + _i * 8192), 16, 0, 0); } while (0)
#define PG8_LDA(dst, b, h) do { _Pragma("unroll") for (int m = 0; m < 4; ++m) _Pragma("unroll") for (int k = 0; k < 2; ++k) dst[m][k] = *(const LAS bf16x8*)(lds + PG8_SA(b, h) + aoff + m * 2048 + k * 1024); } while (0)
#define PG8_LDB(dst, b, h) do { _Pragma("unroll") for (int n = 0; n < 2; ++n) _Pragma("unroll") for (int k = 0; k < 2; ++k) dst[n][k] = *(const LAS bf16x8*)(lds + PG8_SB(b, h) + boff + n * 2048 + k * 1024); } while (0)
#define PG8_MMA(ai, bj, At, Bt) do { __builtin_amdgcn_s_setprio(1); _Pragma("unroll") for (int m = 0; m < 4; ++m) _Pragma("unroll") for (int n = 0; n < 2; ++n) _Pragma("unroll") for (int k = 0; k < 2; ++k) \
        acc[ai][bj][m][n] = SWAP ? __builtin_amdgcn_mfma_f32_16x16x32_bf16(At[m][k], Bt[n][k], acc[ai][bj][m][n], 0, 0, 0) : __builtin_amdgcn_mfma_f32_16x16x32_bf16(Bt[n][k], At[m][k], acc[ai][bj][m][n], 0, 0, 0); __builtin_amdgcn_s_setprio(0); } while (0)
#define PG8_WAIT_V(n) asm volatile("s_waitcnt vmcnt(" #n ")" ::: "memory")
#define PG8_WAIT_L(n) asm volatile("s_waitcnt lgkmcnt(" #n ")" ::: "memory")
#define PG8_BAR __builtin_amdgcn_s_barrier()
#define PG8_SCHED __builtin_amdgcn_sched_barrier(0)
    Unit cur, nxt; int ui = 0;
    if (!S.next(0, cur)) return;
    Acc acc;
#pragma unroll
    for (int a = 0; a < 2; ++a)
#pragma unroll
        for (int b = 0; b < 2; ++b)
#pragma unroll
            for (int m = 0; m < 4; ++m)
#pragma unroll
                for (int n = 0; n < 2; ++n) acc[a][b][m][n] = (f32x4){0.f, 0.f, 0.f, 0.f};
    bf16x8 At[4][2], B0[2][2], B1[2][2];
    const char* cA = (const char*)g.A + (size_t)cur.pm * tstepA; const char* cB = (const char*)g.Bt + (size_t)cur.pn * tstepB;
    if constexpr (SP2) {
        PG8_STAGE(PG8_SB(0, 0), cB, voffB); PG8_STAGE(PG8_SB(0, 1), cB + hstepB, voffB1); PG8_STAGE(PG8_SA(0, 0), cA, voffA); PG8_STAGE(PG8_SA(0, 1), cA + hstepA, voffA);
        if (wr == 1) PG8_BAR;
        PG8_WAIT_V(2); PG8_BAR;
        PG8_STAGE(PG8_SB(1, 0), cB + kstep, voffB); PG8_STAGE(PG8_SA(1, 0), cA + kstep, voffA); PG8_STAGE(PG8_SB(1, 1), cB + hstepB + kstep, voffB1);
        PG8_WAIT_V(6); PG8_BAR;
    } else {
        PG8_STAGE(PG8_SB(0, 0), cB, voffB); PG8_STAGE(PG8_SA(0, 0), cA, voffA); PG8_STAGE(PG8_SB(0, 1), cB + hstepB, voffB1); PG8_STAGE(PG8_SA(0, 1), cA + hstepA, voffA);
        if (wr == 1) PG8_BAR;
        PG8_WAIT_V(4); PG8_BAR;
        PG8_STAGE(PG8_SB(1, 0), cB + kstep, voffB); PG8_STAGE(PG8_SA(1, 0), cA + kstep, voffA); PG8_STAGE(PG8_SB(1, 1), cB + hstepB + kstep, voffB1);
        PG8_WAIT_V(6); PG8_BAR;
    }
    for (;;) {
        const bool has_next = S.next(ui + 1, nxt);
        const char* nA = has_next ? (const char*)g.A + (size_t)nxt.pm * tstepA : cA; const char* nB = has_next ? (const char*)g.Bt + (size_t)nxt.pn * tstepB : cB;
        for (int t = 0; t < nt; t += 2) {
            const bool last = (t == nt - 2);
            const char* a1 = cA + (size_t)(t + 1) * kstep;
            const char* a2 = last ? nA : cA + (size_t)(t + 2) * kstep; const char* b2 = last ? nB : cB + (size_t)(t + 2) * kstep;
            const char* a3 = a2 + kstep; const char* b3 = b2 + kstep;
            if constexpr (Epi::HAS_MID) { if (t == Epi::MID_T) E.mid(acc, cur, wr, wc, fr, fq); }
            if constexpr (SP2) {
            PG8_LDB(B0, 0, 0); PG8_LDB(B1, 0, 1); PG8_SCHED; PG8_LDA(At, 0, 0); PG8_STAGE(PG8_SA(1, 1), a1 + hstepA, voffA);
            PG8_WAIT_V(8); PG8_WAIT_L(0); PG8_BAR; PG8_MMA(0, 0, At, B0); PG8_MMA(0, 1, At, B1); PG8_BAR; PG8_SCHED;
            PG8_LDA(At, 0, 1); PG8_STAGE(PG8_SB(0, 0), b2, voffB); PG8_STAGE(PG8_SB(0, 1), b2 + hstepB, voffB1); PG8_STAGE(PG8_SA(0, 0), a2, voffA);
            PG8_WAIT_V(8); PG8_WAIT_L(0); PG8_BAR; PG8_MMA(1, 0, At, B0); PG8_MMA(1, 1, At, B1); PG8_BAR; PG8_SCHED;
            PG8_LDB(B0, 1, 0); PG8_LDB(B1, 1, 1); PG8_SCHED; PG8_LDA(At, 1, 0); PG8_STAGE(PG8_SA(0, 1), a2 + hstepA, voffA);
            PG8_WAIT_V(8); PG8_WAIT_L(0); PG8_BAR; PG8_MMA(0, 0, At, B0); PG8_MMA(0, 1, At, B1); PG8_BAR; PG8_SCHED;
            PG8_LDA(At, 1, 1); PG8_STAGE(PG8_SB(1, 0), b3, voffB); PG8_STAGE(PG8_SB(1, 1), b3 + hstepB, voffB1); PG8_STAGE(PG8_SA(1, 0), a3, voffA);
            PG8_WAIT_V(8); PG8_WAIT_L(0); PG8_BAR; PG8_MMA(1, 0, At, B0); PG8_MMA(1, 1, At, B1); PG8_BAR; PG8_SCHED;
            } else {
            PG8_LDB(B0, 0, 0); PG8_SCHED; PG8_LDA(At, 0, 0); PG8_STAGE(PG8_SA(1, 1), a1 + hstepA, voffA);
            PG8_WAIT_L(8); PG8_BAR; PG8_WAIT_L(0); PG8_MMA(0, 0, At, B0); PG8_BAR; PG8_SCHED;
            PG8_LDB(B1, 0, 1); PG8_STAGE(PG8_SB(0, 0), b2, voffB);
            PG8_BAR; PG8_WAIT_L(0); PG8_MMA(0, 1, At, B1); PG8_BAR;
            PG8_LDA(At, 0, 1); PG8_STAGE(PG8_SA(0, 0), a2, voffA);
            PG8_BAR; PG8_WAIT_L(0); PG8_MMA(1, 0, At, B0); PG8_BAR; PG8_SCHED;
            PG8_STAGE(PG8_SB(0, 1), b2 + hstepB, voffB1);
            PG8_WAIT_V(6); PG8_BAR; PG8_MMA(1, 1, At, B1); PG8_BAR;
            PG8_LDB(B0, 1, 0); PG8_SCHED; PG8_LDA(At, 1, 0); PG8_STAGE(PG8_SA(0, 1), a2 + hstepA, voffA);
            PG8_WAIT_L(8); PG8_BAR; PG8_WAIT_L(0); PG8_MMA(0, 0, At, B0); PG8_BAR; PG8_SCHED;
            PG8_LDB(B1, 1, 1); PG8_STAGE(PG8_SB(1, 0), b3, voffB);
            PG8_BAR; PG8_WAIT_L(0); PG8_MMA(0, 1, At, B1); PG8_BAR;
            PG8_LDA(At, 1, 1); PG8_STAGE(PG8_SA(1, 0), a3, voffA);
            PG8_BAR; PG8_WAIT_L(0); PG8_MMA(1, 0, At, B0); PG8_BAR; PG8_SCHED;
            PG8_STAGE(PG8_SB(1, 1), b3 + hstepB, voffB1);
            PG8_WAIT_V(6); PG8_BAR; PG8_MMA(1, 1, At, B1); PG8_BAR;
            }
        }
        if constexpr (ALIGN_EPI) { if (wr == 0) PG8_BAR; }
        E.fin(acc, cur, wr, wc, fr, fq);
        if (!has_next) break;
#pragma unroll
        for (int a = 0; a < 2; ++a)
#pragma unroll
            for (int b = 0; b < 2; ++b)
#pragma unroll
                for (int m = 0; m < 4; ++m)
#pragma unroll
                    for (int n = 0; n < 2; ++n) acc[a][b][m][n] = (f32x4){0.f, 0.f, 0.f, 0.f};
        cur = nxt; cA = nA; cB = nB; ++ui;
        if constexpr (ALIGN_EPI) { if (wr == 1) PG8_BAR; }
    }
    PG8_WAIT_V(0);
    if constexpr (!ALIGN_EPI) { if (wr == 0) PG8_BAR; }
    PG8_BAR;
#undef PG8_SA
#undef PG8_SB
#undef PG8_STAGE
#undef PG8_LDA
#undef PG8_LDB
#undef PG8_MMA
#undef PG8_WAIT_V
#undef PG8_WAIT_L
#undef PG8_BAR
#undef PG8_SCHED
}

__device__ __forceinline__ f32x4 ror8(const f32x4 v) { f32x4 r;
#pragma unroll
    for (int j = 0; j < 4; ++j) r[j] = __int_as_float(__builtin_amdgcn_update_dpp(0, __float_as_int(v[j]), 0x128, 0xF, 0xF, false));
    return r; }
__device__ __forceinline__ u32x4 ror8u(const u32x4 v) { u32x4 r;
#pragma unroll
    for (int j = 0; j < 4; ++j) r[j] = (unsigned)__builtin_amdgcn_update_dpp(0, (int)v[j], 0x128, 0xF, 0xF, false);
    return r; }
__device__ __forceinline__ void store_pair128(bf16_t* p, int pitch, bool hi, const u32x4 w0, const u32x4 w1) {
    const u32x4 rc = ror8u(hi ? w0 : w1);
    *(u32x4*)p = hi ? rc : w0; *(u32x4*)(p + 8 * (size_t)pitch) = hi ? w1 : rc;
}
struct EpiProj {
    static constexpr bool PERM = true, HAS_MID = false, ADJ = true; static constexpr int MID_T = -1;
    bf16_t* proj; bf16_t* gates; const float* bgate; const float* qgain; const float* kgain; float* kmean; float* X; const f32x2* rope;
    __device__ __forceinline__ void mid(Acc&, const Unit&, int, int, int, int) const {}
    __device__ __forceinline__ void fin(const Acc& acc, const Unit& u, int wr, int wc, int fr, int fq) const {
        asm volatile("" : "+v"(fr), "+v"(fq));
        const bool hi = fr >= 8;
        const int rowl = wr * 64 + fr;
        const int rows = u.pm * BM + wr * 64 + (fr & 7);
        const int colw = u.pn * BM + wc * 64 + 8 * fq;
        const int cols = colw + (hi ? 32 : 0);
        if (u.pn < 2 * RET_QKW / BM) {
            const bool iskr = u.pn >= RET_QKW / BM;
            const float lg2h = __builtin_log2f(1.f - __builtin_amdgcn_exp2f(-5.f - (float)(2 * (u.pn & 1) + (wc >> 1))));
            const int dl = 32 * (wc & 1) + 8 * fq;
            bf16_t* pbase = proj + (size_t)(u.pm * BM + rowl) * DIN + u.pn * BM + 128 * (wc >> 1) + dl;
            const f32x2* rbase = rope + (size_t)((u.pm * BM + rowl) & (SEQ - 1)) * 64 + dl;
#pragma unroll
            for (int ai = 0; ai < 2; ++ai)
#pragma unroll
                for (int m = 0; m < 4; ++m) {
                    bf16_t* p = pbase + (size_t)(ai * HALF + m * 16) * DIN; const f32x4* cs = (const f32x4*)(rbase + (size_t)(ai * HALF + m * 16) * 64);
                    const float ks = iskr ? 0.08838834764831845f * __builtin_amdgcn_exp2f(lg2h * (float)(127 - (rowl + 16 * m))) : 1.f;
#pragma unroll
                    for (int n = 0; n < 2; ++n) { const f32x4 t0 = cs[2 * n], t1 = cs[2 * n + 1]; const f32x4 x1 = acc[ai][0][m][n], x2 = acc[ai][1][m][n];
                        u32x2 lo, hi2;
                        lo.x = pk2((x1[0] * t0[0] - x2[0] * t0[1]) * ks, (x1[1] * t0[2] - x2[1] * t0[3]) * ks); lo.y = pk2((x1[2] * t1[0] - x2[2] * t1[1]) * ks, (x1[3] * t1[2] - x2[3] * t1[3]) * ks);
                        hi2.x = pk2((x1[0] * t0[1] + x2[0] * t0[0]) * ks, (x1[1] * t0[3] + x2[1] * t0[2]) * ks); hi2.y = pk2((x1[2] * t1[1] + x2[2] * t1[0]) * ks, (x1[3] * t1[3] + x2[3] * t1[2]) * ks);
                        *(u32x2*)(p + 4 * n) = lo; *(u32x2*)(p + 64 + 4 * n) = hi2; }
                    asm volatile("" ::: "memory"); }
        } else if (u.pn >= C_QM / BM && u.pn < C_VM / BM) {
            const bool isk = u.pn >= C_KM / BM;
#pragma unroll
            for (int ai = 0; ai < 2; ++ai)
#pragma unroll
                for (int m = 0; m < 4; ++m) { float s = 0.f;
#pragma unroll
                    for (int bj = 0; bj < 2; ++bj) { const f32x4 v0 = acc[ai][bj][m][0], v1 = acc[ai][bj][m][1];
                        s += (v0[0] * v0[0] + v0[1] * v0[1]) + (v0[2] * v0[2] + v0[3] * v0[3]) + (v1[0] * v1[0] + v1[1] * v1[1]) + (v1[2] * v1[2] + v1[3] * v1[3]); }
                    s += __shfl_xor(s, 16); s += __shfl_xor(s, 32);
                    if (fq == 0) X[(ai * HALF + m * 16 + rowl) * 4 + wc] = s; }
            asm volatile("s_waitcnt lgkmcnt(0)" ::: "memory"); __builtin_amdgcn_s_barrier(); asm volatile("" ::: "memory");
            const int dw = (wc & 1) * 64 + 8 * fq;
            const float* gp = (isk ? kgain : qgain) + dw;
            f32x4 g[2][2];
#pragma unroll
            for (int bj = 0; bj < 2; ++bj) { g[bj][0] = *(const f32x4*)(gp + 32 * bj); g[bj][1] = *(const f32x4*)(gp + 32 * bj + 4); }
            f32x4 cs[2][2];
#pragma unroll
            for (int bj = 0; bj < 2; ++bj) { cs[bj][0] = (f32x4){0.f, 0.f, 0.f, 0.f}; cs[bj][1] = (f32x4){0.f, 0.f, 0.f, 0.f}; }
#pragma unroll
            for (int ai = 0; ai < 2; ++ai)
#pragma unroll
                for (int m = 0; m < 4; ++m) { const f32x2 p = *(const f32x2*)(X + (ai * HALF + m * 16 + rowl) * 4 + (wc & 2));
                    const float rstd = 1.f / sqrtf((p[0] + p[1]) * (1.f / 128.f) + EPS);
                    u32x4 w[2];
#pragma unroll
                    for (int bj = 0; bj < 2; ++bj) { const f32x4 v0 = acc[ai][bj][m][0] * rstd * g[bj][0], v1 = acc[ai][bj][m][1] * rstd * g[bj][1]; cs[bj][0] += v0; cs[bj][1] += v1;
                        w[bj].x = pk2(v0[0], v0[1]); w[bj].y = pk2(v0[2], v0[3]); w[bj].z = pk2(v1[0], v1[1]); w[bj].w = pk2(v1[2], v1[3]); }
                    store_pair128(proj + (size_t)(rows + ai * HALF + m * 16) * DIN + cols, DIN, hi, w[0], w[1]);
                    asm volatile("" : "+v"(cs[0][0]), "+v"(cs[0][1]), "+v"(cs[1][0]), "+v"(cs[1][1])); }
            if (isk) {
#pragma unroll
                for (int bj = 0; bj < 2; ++bj)
#pragma unroll
                    for (int n = 0; n < 2; ++n)
#pragma unroll
                        for (int i = 0; i < 4; ++i) { float s = cs[bj][n][i]; s += __shfl_xor(s, 1); s += __shfl_xor(s, 2); s += __shfl_xor(s, 4); s += __shfl_xor(s, 8); cs[bj][n][i] = s; }
                if (fr == 0) {
                    const int bb = u.pm >> 3, blk = u.pm & 7, head = 2 * (u.pn - C_KM / BM) + (wc >> 1);
                    float* kp = kmean + (((size_t)bb * 8 + head) * 8 + blk) * 128 + dw;
#pragma unroll
                    for (int bj = 0; bj < 2; ++bj)
#pragma unroll
                        for (int n = 0; n < 2; ++n)
#pragma unroll
                            for (int i = 0; i < 4; ++i) atomicAdd(kp + 32 * bj + 4 * n + i, cs[bj][n][i] * (1.f / 256.f));
                }
            }
        } else if (u.pn < DIN / BM) {
#pragma unroll
            for (int ai = 0; ai < 2; ++ai)
#pragma unroll
                for (int m = 0; m < 4; ++m) { u32x4 w[2];
#pragma unroll
                    for (int bj = 0; bj < 2; ++bj) { const f32x4 v0 = acc[ai][bj][m][0], v1 = acc[ai][bj][m][1]; w[bj].x = pk2(v0[0], v0[1]); w[bj].y = pk2(v0[2], v0[3]); w[bj].z = pk2(v1[0], v1[1]); w[bj].w = pk2(v1[2], v1[3]); }
                    store_pair128(proj + (size_t)(rows + ai * HALF + m * 16) * DIN + cols, DIN, hi, w[0], w[1]); }
        } else {
            const int gcw = colw - DIN;
            f32x4 bv[2][2];
#pragma unroll
            for (int bj = 0; bj < 2; ++bj)
#pragma unroll
                for (int n = 0; n < 2; ++n) bv[bj][n] = *(const f32x4*)(bgate + gcw + 32 * bj + 4 * n);
#pragma unroll
            for (int ai = 0; ai < 2; ++ai)
#pragma unroll
                for (int m = 0; m < 4; ++m) { u32x4 w[2];
#pragma unroll
                    for (int bj = 0; bj < 2; ++bj) { const f32x4 v0 = acc[ai][bj][m][0] + bv[bj][0], v1 = acc[ai][bj][m][1] + bv[bj][1];
                        w[bj].x = pk2(fsigmoid(v0[0]), fsigmoid(v0[1])); w[bj].y = pk2(fsigmoid(v0[2]), fsigmoid(v0[3])); w[bj].z = pk2(fsigmoid(v1[0]), fsigmoid(v1[1])); w[bj].w = pk2(fsigmoid(v1[2]), fsigmoid(v1[3])); }
                    store_pair128(gates + (size_t)(rows + ai * HALF + m * 16) * NGATE + (cols - DIN), NGATE, hi, w[0], w[1]); }
        }
    }
};
struct EpiBf16 {
    static constexpr bool PERM = true, HAS_MID = false, ADJ = false; static constexpr int MID_T = -1;
    bf16_t* O; int ldc;
    __device__ __forceinline__ void mid(Acc&, const Unit&, int, int, int, int) const {}
    __device__ __forceinline__ void fin(const Acc& acc, const Unit& u, int wr, int wc, int fr, int fq) const {
        asm volatile("" : "+v"(fr), "+v"(fq));
        const int row0 = u.pm * BM + wr * 64 + fr; const int col0 = u.pn * BM + wc * 32 + 8 * fq;
#pragma unroll
        for (int ai = 0; ai < 2; ++ai)
#pragma unroll
            for (int m = 0; m < 4; ++m) { bf16_t* rowp = O + (size_t)(row0 + ai * HALF + m * 16) * ldc + col0;
#pragma unroll
                for (int bj = 0; bj < 2; ++bj) { const f32x4 v0 = acc[ai][bj][m][0], v1 = acc[ai][bj][m][1]; u32x4 w; w.x = pk2(v0[0], v0[1]); w.y = pk2(v0[2], v0[3]); w.z = pk2(v1[0], v1[1]); w.w = pk2(v1[2], v1[3]);
                    *(u32x4*)(rowp + bj * HALF) = w; } }
    }
};
struct EpiMerge {
    static constexpr bool PERM = true, HAS_MID = true, ADJ = true; static constexpr int MID_T = 16;
    const bf16_t* gates; bf16_t* O;
    static __device__ __forceinline__ void unswap(bool hi, const u32x4 l1, const u32x4 l2, u32x4& b0, u32x4& b1) { const u32x4 rc = ror8u(hi ? l1 : l2); b0 = hi ? rc : l1; b1 = hi ? l2 : rc; }
    __device__ __forceinline__ void mid(Acc& acc, const Unit& u, int wr, int wc, int fr, int fq) const {
        asm volatile("" : "+v"(fr), "+v"(fq));
        const bool hi = fr >= 8;
        const bf16_t* gbase = gates + (size_t)(u.pm * BM + wr * 64 + (fr & 7)) * NGATE + u.pn * BM + wc * 64 + 8 * fq + (hi ? 32 : 0);
#pragma unroll
        for (int ai = 0; ai < 2; ++ai) {
            u32x4 r1[4], r2[4], m1[4], m2[4];
#pragma unroll
            for (int m = 0; m < 4; ++m) { const bf16_t* gp = gbase + (size_t)(ai * HALF + m * 16) * NGATE;
                r1[m] = *(const u32x4*)gp; r2[m] = *(const u32x4*)(gp + 8 * NGATE); m1[m] = *(const u32x4*)(gp + DM); m2[m] = *(const u32x4*)(gp + 8 * NGATE + DM); }
#pragma unroll
            for (int m = 0; m < 4; ++m) { u32x4 gr[2], gm[2]; unswap(hi, r1[m], r2[m], gr[0], gr[1]); unswap(hi, m1[m], m2[m], gm[0], gm[1]);
#pragma unroll
                for (int bj = 0; bj < 2; ++bj) { float a[8], b[8]; unpack8(gr[bj], a); unpack8(gm[bj], b);
                    f32x4 q0, q1;
#pragma unroll
                    for (int j = 0; j < 4; ++j) { q0[j] = a[j] * __builtin_amdgcn_rcpf(fmaxf(b[j], 1e-30f)); q1[j] = a[4 + j] * __builtin_amdgcn_rcpf(fmaxf(b[4 + j], 1e-30f)); }
                    acc[ai][bj][m][0] *= q0; acc[ai][bj][m][1] *= q1; } }
            asm volatile("" ::: "memory");
        }
    }
    __device__ __forceinline__ void fin(const Acc& acc, const Unit& u, int wr, int wc, int fr, int fq) const {
        asm volatile("" : "+v"(fr), "+v"(fq));
        const bool hi = fr >= 8;
        const size_t rs = (size_t)(u.pm * BM + wr * 64 + (fr & 7)); const int cs = u.pn * BM + wc * 64 + 8 * fq + (hi ? 32 : 0);
#pragma unroll
        for (int ai = 0; ai < 2; ++ai)
#pragma unroll
            for (int m = 0; m < 4; ++m) { const size_t r = rs + ai * HALF + m * 16; const bf16_t* gp = gates + r * NGATE + DM + cs;
                u32x4 gm[2]; unswap(hi, *(const u32x4*)gp, *(const u32x4*)(gp + 8 * NGATE), gm[0], gm[1]);
                u32x4 w[2];
#pragma unroll
                for (int bj = 0; bj < 2; ++bj) { float b[8]; unpack8(gm[bj], b); const f32x4 v0 = acc[ai][bj][m][0], v1 = acc[ai][bj][m][1];
                    w[bj].x = pk2(v0[0] * b[0], v0[1] * b[1]); w[bj].y = pk2(v0[2] * b[2], v0[3] * b[3]); w[bj].z = pk2(v1[0] * b[4], v1[1] * b[5]); w[bj].w = pk2(v1[2] * b[6], v1[3] * b[7]); }
                store_pair128(O + r * DM + cs, DM, hi, w[0], w[1]); }
    }
};
struct EpiResid {
    static constexpr bool PERM = false, HAS_MID = false, ADJ = false; static constexpr int MID_T = -1;
    const bf16_t* base; float* out;
    __device__ __forceinline__ void mid(Acc&, const Unit&, int, int, int, int) const {}
    __device__ __forceinline__ void fin(const Acc& acc, const Unit& u, int wr, int wc, int fr, int fq) const {
        asm volatile("" : "+v"(fr), "+v"(fq));
        const bool hi = fr >= 8;
        const int row0 = u.pm * BM + wr * 64 + (fr & 7); const int col0 = u.pn * BM + wc * 32 + (hi ? 16 : 0) + 4 * fq;
#pragma unroll
        for (int ai = 0; ai < 2; ++ai)
#pragma unroll
            for (int m = 0; m < 4; ++m) { const size_t off = (size_t)(row0 + ai * HALF + m * 16) * DM + col0;
#pragma unroll
                for (int bj = 0; bj < 2; ++bj) { const f32x4 a0 = acc[ai][bj][m][0], a1 = acc[ai][bj][m][1]; const f32x4 rc = ror8(hi ? a0 : a1);
                    const f32x4 first = hi ? rc : a0, second = hi ? a1 : rc;
                    const u32x2 p1 = *(const u32x2*)(base + off + bj * HALF), p2 = *(const u32x2*)(base + off + 8 * DM + bj * HALF);
                    const f32x4 b1 = (f32x4){bflo(p1.x), bfhi(p1.x), bflo(p1.y), bfhi(p1.y)}, b2 = (f32x4){bflo(p2.x), bfhi(p2.x), bflo(p2.y), bfhi(p2.y)};
                    *(f32x4*)(out + off + bj * HALF) = b1 + first; *(f32x4*)(out + off + 8 * DM + bj * HALF) = b2 + second; } }
    }
};

struct EpiConv {
    static constexpr bool PERM = false, HAS_MID = false, ADJ = false; static constexpr int MID_T = -1;
    bf16_t* act; float* UH; const float* cw; const float* cb; f32x2* X; const float* rstd;
    __device__ __forceinline__ void mid(Acc&, const Unit&, int, int, int, int) const {}
    __device__ __forceinline__ void fin(Acc& acc, const Unit& u, int wr, int wc, int fr, int fq) const {
        asm volatile("" : "+v"(fr), "+v"(fq));
        const int lane = fr + 16 * fq, src_lane = (lane - 16) & 63;
#pragma unroll
        for (int ai = 0; ai < 2; ++ai)
#pragma unroll
            for (int m = 0; m < 4; ++m) { const f32x4 rs = *(const f32x4*)(rstd + u.pm * BM + ai * HALF + wr * 64 + 16 * m + 4 * fq);
#pragma unroll
                for (int bj = 0; bj < 2; ++bj)
#pragma unroll
                    for (int n = 0; n < 2; ++n) acc[ai][bj][m][n] *= rs; }
        if (fq == 3) {
#pragma unroll
            for (int ai = 0; ai < 2; ++ai)
#pragma unroll
                for (int bj = 0; bj < 2; ++bj)
#pragma unroll
                    for (int n = 0; n < 2; ++n) X[((((ai * 2 + wr) * 2 + bj) * 4 + wc) * 2 + n) * 16 + fr] = (f32x2){acc[ai][bj][3][n][2], acc[ai][bj][3][n][3]};
        }
        {
            const int colt = u.pn * BM + wc * 32 + fr;
            if (wr == 0 && fq == 0) {
#pragma unroll
                for (int bj = 0; bj < 2; ++bj)
#pragma unroll
                    for (int n = 0; n < 2; ++n) { UH[((size_t)u.pm * 4 + 0) * NUP + colt + bj * HALF + n * 16] = acc[0][bj][0][n][0]; UH[((size_t)u.pm * 4 + 1) * NUP + colt + bj * HALF + n * 16] = acc[0][bj][0][n][1]; }
            }
            if (wr == 1 && fq == 3) {
#pragma unroll
                for (int bj = 0; bj < 2; ++bj)
#pragma unroll
                    for (int n = 0; n < 2; ++n) { UH[((size_t)u.pm * 4 + 2) * NUP + colt + bj * HALF + n * 16] = acc[1][bj][3][n][2]; UH[((size_t)u.pm * 4 + 3) * NUP + colt + bj * HALF + n * 16] = acc[1][bj][3][n][3]; }
            }
        }
        asm volatile("s_waitcnt lgkmcnt(0)" ::: "memory"); __builtin_amdgcn_s_barrier(); asm volatile("" ::: "memory");
#pragma unroll
        for (int n = 0; n < 2; ++n) {
            const int c = u.pn * HALF + wc * 32 + n * 16 + fr;
            const float gb = cb[c], g0 = cw[c], g1 = cw[NUP + c], g2 = cw[2 * NUP + c];
            const float vb = cb[DFF + c], v0 = cw[DFF + c], v1 = cw[NUP + DFF + c], v2 = cw[2 * NUP + DFF + c];
#pragma unroll
            for (int ai = 0; ai < 2; ++ai) {
                f32x2 xg = (f32x2){0.f, 0.f}, xv = (f32x2){0.f, 0.f};
                if (!(ai == 0 && wr == 0)) { const int sa = wr ? ai : ai - 1, sw = wr ? 0 : 1;
                    xg = X[((((sa * 2 + sw) * 2 + 0) * 4 + wc) * 2 + n) * 16 + fr]; xv = X[((((sa * 2 + sw) * 2 + 1) * 4 + wc) * 2 + n) * 16 + fr]; }
                bf16_t* ap = act + (size_t)(u.pm * BM + ai * HALF + wr * 64 + 4 * fq) * DFF + c;
#pragma unroll
                for (int m = 0; m < 4; ++m) {
                    const f32x4 a = acc[ai][0][m][n], b = acc[ai][1][m][n];
                    const f32x4 pa = acc[ai][0][m > 0 ? m - 1 : 0][n], pb = acc[ai][1][m > 0 ? m - 1 : 0][n];
                    const bool up = (fq == 3) && (m > 0);
                    float a2 = __shfl(up ? pa[2] : a[2], src_lane), a1 = __shfl(up ? pa[3] : a[3], src_lane);
                    float b2 = __shfl(up ? pb[2] : b[2], src_lane), b1 = __shfl(up ? pb[3] : b[3], src_lane);
                    if (m == 0 && fq == 0) { a2 = xg.x; a1 = xg.y; b2 = xv.x; b1 = xv.y; }
                    const float og0 = gb + g0 * a2 + g1 * a1 + g2 * a[0], og1 = gb + g0 * a1 + g1 * a[0] + g2 * a[1], og2 = gb + g0 * a[0] + g1 * a[1] + g2 * a[2], og3 = gb + g0 * a[1] + g1 * a[2] + g2 * a[3];
                    const float ov0 = vb + v0 * b2 + v1 * b1 + v2 * b[0], ov1 = vb + v0 * b1 + v1 * b[0] + v2 * b[1], ov2 = vb + v0 * b[0] + v1 * b[1] + v2 * b[2], ov3 = vb + v0 * b[1] + v1 * b[2] + v2 * b[3];
                    const unsigned w01 = pk2(og0 * fsigmoid(og0) * ov0, og1 * fsigmoid(og1) * ov1), w23 = pk2(og2 * fsigmoid(og2) * ov2, og3 * fsigmoid(og3) * ov3);
                    bf16_t* rp = ap + (size_t)(16 * m) * DFF;
                    rp[0] = (bf16_t)(w01 & 0xffffu); rp[DFF] = (bf16_t)(w01 >> 16); rp[2 * DFF] = (bf16_t)(w23 & 0xffffu); rp[3 * DFF] = (bf16_t)(w23 >> 16);
                }
            }
        }
    }
};

struct EpiResidNorm {
    static constexpr bool PERM = false, HAS_MID = false, ADJ = false; static constexpr int MID_T = -1;
    const float* base; bf16_t* xb; float* ss;
    __device__ __forceinline__ void mid(Acc&, const Unit&, int, int, int, int) const {}
    __device__ __forceinline__ void fin(const Acc& acc, const Unit& u, int wr, int wc, int fr, int fq) const {
        asm volatile("" : "+v"(fr), "+v"(fq));
        const bool hi = fr >= 8;
        const int row0 = u.pm * BM + wr * 64 + (fr & 7); const int col0 = u.pn * BM + wc * 32 + (hi ? 16 : 0) + 4 * fq;
#pragma unroll
        for (int ai = 0; ai < 2; ++ai)
#pragma unroll
            for (int m = 0; m < 4; ++m) { const int row = row0 + ai * HALF + m * 16; const size_t off = (size_t)row * DM + col0; float s1 = 0.f, s2 = 0.f;
#pragma unroll
                for (int bj = 0; bj < 2; ++bj) { const f32x4 a0 = acc[ai][bj][m][0], a1 = acc[ai][bj][m][1]; const f32x4 rc = ror8(hi ? a0 : a1);
                    const f32x4 first = hi ? rc : a0, second = hi ? a1 : rc;
                    const f32x4 v1 = *(const f32x4*)(base + off + bj * HALF) + first, v2 = *(const f32x4*)(base + off + 8 * DM + bj * HALF) + second;
                    s1 += (v1[0] * v1[0] + v1[1] * v1[1]) + (v1[2] * v1[2] + v1[3] * v1[3]); s2 += (v2[0] * v2[0] + v2[1] * v2[1]) + (v2[2] * v2[2] + v2[3] * v2[3]);
                    u32x2 w1; w1.x = pk2(v1[0], v1[1]); w1.y = pk2(v1[2], v1[3]); *(u32x2*)(xb + off + bj * HALF) = w1;
                    u32x2 w2; w2.x = pk2(v2[0], v2[1]); w2.y = pk2(v2[2], v2[3]); *(u32x2*)(xb + off + 8 * DM + bj * HALF) = w2; }
                s1 += __shfl_xor(s1, 8); s1 += __shfl_xor(s1, 16); s1 += __shfl_xor(s1, 32); s2 += __shfl_xor(s2, 8); s2 += __shfl_xor(s2, 16); s2 += __shfl_xor(s2, 32);
                if (fq == 0 && !hi) { ss[(size_t)row * 16 + u.pn * 4 + wc] = s1; ss[(size_t)(row + 8) * 16 + u.pn * 4 + wc] = s2; } }
    }
};
}

__device__ __forceinline__ float wave_sum(float v) {
#pragma unroll
    for (int o = 1; o < 64; o <<= 1) v += __shfl_xor(v, o);
    return v;
}
template <int UPPERM = 0>
__device__ __forceinline__ void transpose_item(const float* W, int K, int N, bf16_t* WT, int ldt, int row_off, int col_off, float* scr, int item, int lane, const float* kgain = nullptr) {
    const int nblk = N / 32, kb = item / nblk, nb = item % nblk, k0 = 64 * kb, n0 = 32 * nb;
    int d0 = n0;
    if (UPPERM == 1) { const int isv = n0 >= DFF ? 1 : 0, c = n0 - isv * DFF; d0 = 256 * (c >> 7) + 128 * isv + (c & 127); }
    if (UPPERM == 2) { if (n0 < 2 * RET_QKW) { const int dd = n0 & 127; d0 = (n0 & ~127) + 64 * ((dd & 63) >> 5) + 32 * (dd >> 6); } }
    float wv[32];
#pragma unroll
    for (int i = 0; i < 32; ++i) { const int kk = 2 * i + (lane >> 5); wv[i] = W[(size_t)(k0 + kk) * N + n0 + (lane & 31)]; }
    if (kgain) {
#pragma unroll
        for (int i = 0; i < 32; ++i) wv[i] *= kgain[k0 + 2 * i + (lane >> 5)];
    }
#pragma unroll
    for (int i = 0; i < 32; ++i) scr[(2 * i + (lane >> 5)) * 33 + (lane & 31)] = wv[i];
    LDS_WAIT();
    const int c = lane & 7;
#pragma unroll
    for (int j = 0; j < 4; ++j) { const int n = (lane >> 3) + 8 * j; const float* s = scr + (8 * c) * 33 + n;
        u32x4 o; o.x = pk2(s[0 * 33], s[1 * 33]); o.y = pk2(s[2 * 33], s[3 * 33]); o.z = pk2(s[4 * 33], s[5 * 33]); o.w = pk2(s[6 * 33], s[7 * 33]);
        *(u32x4*)(WT + (size_t)(row_off + d0 + n) * ldt + col_off + k0 + 8 * c) = o; }
    LDS_WAIT();
}
__device__ __forceinline__ void rms_row_to_bf16(const float* xrow, const float* gain, bf16_t* orow, int lane) {
    const f32x4* xr = (const f32x4*)xrow + lane; const f32x4* gr = (const f32x4*)gain + lane;
    f32x4 v[4]; float s = 0.f;
#pragma unroll
    for (int j = 0; j < 4; ++j) { v[j] = xr[64 * j]; s += (v[j].x * v[j].x + v[j].y * v[j].y) + (v[j].z * v[j].z + v[j].w * v[j].w); }
    const float rstd = 1.f / sqrtf(wave_sum(s) * (1.f / DM) + EPS);
    u32x2* o8 = (u32x2*)orow + lane;
#pragma unroll
    for (int j = 0; j < 4; ++j) { const f32x4 gg = gr[64 * j]; u32x2 w; w.x = pk2(v[j].x * rstd * gg.x, v[j].y * rstd * gg.y); w.y = pk2(v[j].z * rstd * gg.z, v[j].w * rstd * gg.w); o8[64 * j] = w; }
}

__device__ __forceinline__ void retention_item(unsigned char* lds, bf16_t* proj, const f32x2* rope, f32x2* stats, int b, int h, int sl, bf16_t* dry = nullptr) {
    int tid_ = threadIdx.x; asm volatile("" : "+v"(tid_));
    const int tid = tid_, lane = tid & 63, w = __builtin_amdgcn_readfirstlane(tid >> 6), l15 = lane & 15, quad = lane >> 4;
    constexpr int P = 136, VPR = 96;
    bf16_t* Qs = (bf16_t*)lds;
    bf16_t* Kz = Qs + 128 * P;
    bf16_t* Vs = Kz + 128 * P;
    bf16_t* RsT = Vs + 128 * VPR;
    const float lg2 = __builtin_log2f(1.f - __builtin_amdgcn_exp2f(-5.f - (float)h));
    const float gamma_c = __builtin_amdgcn_exp2f(lg2 * 128.f);
    const float kscale = 0.08838834764831845f;
    for (int i = tid; i < 64 * P / 2; i += 512) ((unsigned*)RsT)[i] = 0u;
    f32x4 accR[4];
#pragma unroll
    for (int i = 0; i < 4; ++i) accR[i] = (f32x4){0.f, 0.f, 0.f, 0.f};
    const size_t rowbase = (size_t)b * SEQ;
    u32x4 rq1[2], rq2[2], rk1[2], rk2[2], rv[2];
#define RET_LOAD(n_) do { _Pragma("unroll") for (int k_ = 0; k_ < 2; ++k_) { const int i_ = tid + 512 * k_, r_ = i_ >> 3, g_ = i_ & 7; \
        const bf16_t* qp_ = proj + (rowbase + (n_) * 128 + r_) * DIN + C_QR + h * 128 + 8 * g_; \
        rq1[k_] = *(const u32x4*)qp_; rq2[k_] = *(const u32x4*)(qp_ + 64); rk1[k_] = *(const u32x4*)(qp_ + C_KR); rk2[k_] = *(const u32x4*)(qp_ + C_KR + 64); \
        rv[k_] = *(const u32x4*)(proj + (rowbase + (n_) * 128 + r_) * DIN + C_VR + h * 256 + sl * 64 + 8 * g_); } } while (0)
    RET_LOAD(0);
    const LAS bf16_t* VsL = (const LAS bf16_t*)Vs; const LAS bf16_t* KzL = (const LAS bf16_t*)Kz;
    const int trr = l15 >> 2, trc = 4 * (l15 & 3);
    for (int n = 0; n < 16; ++n) {
        const int t0 = n * 128;
#pragma unroll
        for (int k = 0; k < 2; ++k) {
            const int i = tid + 512 * k, r = i >> 3, g8 = i & 7;
            *(u32x4*)(Qs + r * P + 8 * g8) = rq1[k]; *(u32x4*)(Qs + r * P + 64 + 8 * g8) = rq2[k];
            *(u32x4*)(Kz + r * P + 8 * g8) = rk1[k]; *(u32x4*)(Kz + r * P + 64 + 8 * g8) = rk2[k];
            *(u32x4*)(Vs + r * VPR + 8 * g8) = rv[k];
        }
        __syncthreads();
        if (n + 1 < 16) RET_LOAD(n + 1);
        bf16x8 qf[4];
#pragma unroll
        for (int s = 0; s < 4; ++s) qf[s] = *(const bf16x8*)(Qs + (16 * w + l15) * P + 32 * s + 8 * quad);
        u32x4 pf[4];
#pragma unroll
        for (int s = 0; s < 4; ++s) pf[s] = (u32x4){0u, 0u, 0u, 0u};
        const int qpos = 16 * w + l15;
        const float qfac = __builtin_amdgcn_exp2f(lg2 * (float)(qpos - 127));
#pragma unroll
        for (int kb = 0; kb < 8; ++kb) {
            if (kb <= w) {
                f32x4 a = (f32x4){0.f, 0.f, 0.f, 0.f};
#pragma unroll
                for (int s = 0; s < 4; ++s) { const bf16x8 kf = *(const bf16x8*)(Kz + (16 * kb + l15) * P + 32 * s + 8 * quad); a = __builtin_amdgcn_mfma_f32_16x16x32_bf16(kf, qf[s], a, 0, 0, 0); }
                float pv[4];
#pragma unroll
                for (int i = 0; i < 4; ++i) pv[i] = (qpos >= 16 * kb + 4 * quad + i) ? a[i] * qfac : 0.f;
                if (kb & 1) { pf[kb >> 1].z = pk2(pv[0], pv[1]); pf[kb >> 1].w = pk2(pv[2], pv[3]); } else { pf[kb >> 1].x = pk2(pv[0], pv[1]); pf[kb >> 1].y = pk2(pv[2], pv[3]); }
            }
        }
        f32x4 ao[4], ac[4];
#pragma unroll
        for (int i = 0; i < 4; ++i) { ao[i] = (f32x4){0.f, 0.f, 0.f, 0.f}; ac[i] = (f32x4){0.f, 0.f, 0.f, 0.f}; }
#pragma unroll
        for (int s2 = 0; s2 < 4; ++s2) {
            if (2 * s2 <= w) {
#pragma unroll
                for (int dvb = 0; dvb < 4; ++dvb) { const LAS bf16_t* vp = VsL + (32 * s2 + 4 * quad + trr) * VPR + 16 * dvb + trc;
                    const s16x4 lo = __builtin_amdgcn_ds_read_tr16_b64_v4i16((LAS s16x4*)vp), hi = __builtin_amdgcn_ds_read_tr16_b64_v4i16((LAS s16x4*)(vp + 16 * VPR));
                    const bf16x8 va = __builtin_shufflevector(lo, hi, 0, 1, 2, 3, 4, 5, 6, 7);
                    ao[dvb] = __builtin_amdgcn_mfma_f32_16x16x32_bf16(va, __builtin_bit_cast(bf16x8, pf[s2]), ao[dvb], 0, 0, 0); }
            }
        }
#pragma unroll
        for (int s = 0; s < 4; ++s)
#pragma unroll
            for (int dvb = 0; dvb < 4; ++dvb) { const bf16x8 ra = *(const bf16x8*)(RsT + (16 * dvb + l15) * P + 32 * s + 8 * quad); ac[dvb] = __builtin_amdgcn_mfma_f32_16x16x32_bf16(ra, qf[s], ac[dvb], 0, 0, 0); }
        const float xi = __builtin_amdgcn_exp2f(lg2 * (float)(qpos + 1));
        float s1 = 0.f, s2s = 0.f;
        bf16_t* op = dry ? dry + tid * 128 : proj + (rowbase + t0 + qpos) * DIN + C_VR + h * 256 + sl * 64 + 4 * quad;
#pragma unroll
        for (int dvb = 0; dvb < 4; ++dvb) { const f32x4 o = ao[dvb] + ac[dvb] * xi; s1 += (o[0] + o[1]) + (o[2] + o[3]); s2s += (o[0] * o[0] + o[1] * o[1]) + (o[2] * o[2] + o[3] * o[3]);
            u32x2 wv; wv.x = pk2(o[0], o[1]); wv.y = pk2(o[2], o[3]); *(u32x2*)(op + 16 * dvb) = wv; }
        s1 += __shfl_xor(s1, 16); s1 += __shfl_xor(s1, 32); s2s += __shfl_xor(s2s, 16); s2s += __shfl_xor(s2s, 32);
        if (quad == 0) { if (dry) ((f32x2*)dry)[65536 + tid] = (f32x2){s1, s2s}; else stats[((rowbase + t0 + qpos) * 4 + h) * 4 + sl] = (f32x2){s1, s2s}; }
#pragma unroll
        for (int dvb = 0; dvb < 4; ++dvb) accR[dvb] *= gamma_c;
#pragma unroll
        for (int s = 0; s < 4; ++s) { const LAS bf16_t* kp = KzL + (32 * s + 8 * quad + trr) * P + 16 * w + trc;
            const s16x4 klo = __builtin_amdgcn_ds_read_tr16_b64_v4i16((LAS s16x4*)kp), khi = __builtin_amdgcn_ds_read_tr16_b64_v4i16((LAS s16x4*)(kp + 4 * P));
            const bf16x8 ka = __builtin_shufflevector(klo, khi, 0, 1, 2, 3, 4, 5, 6, 7);
#pragma unroll
            for (int dvb = 0; dvb < 4; ++dvb) { const LAS bf16_t* vp = VsL + (32 * s + 8 * quad + trr) * VPR + 16 * dvb + trc;
                const s16x4 vlo = __builtin_amdgcn_ds_read_tr16_b64_v4i16((LAS s16x4*)vp), vhi = __builtin_amdgcn_ds_read_tr16_b64_v4i16((LAS s16x4*)(vp + 4 * VPR));
                const bf16x8 vb = __builtin_shufflevector(vlo, vhi, 0, 1, 2, 3, 4, 5, 6, 7);
                accR[dvb] = __builtin_amdgcn_mfma_f32_16x16x32_bf16(ka, vb, accR[dvb], 0, 0, 0); } }
        __syncthreads();
#pragma unroll
        for (int dvb = 0; dvb < 4; ++dvb) { u32x2 wv; wv.x = pk2(accR[dvb][0], accR[dvb][1]); wv.y = pk2(accR[dvb][2], accR[dvb][3]); *(u32x2*)(RsT + (16 * dvb + l15) * P + 16 * w + 4 * quad) = wv; }
    }
#undef RET_LOAD
    __syncthreads();
}

__device__ __forceinline__ void knorm_item(unsigned char* lds, bf16_t* proj, const float* kgain, float* kmean, int b, int h, int blk) {
    const int tid = threadIdx.x, lane = tid & 63, w = __builtin_amdgcn_readfirstlane(tid >> 6), l15 = lane & 15, quad = lane >> 4;
    float* red = (float*)lds;
    float csum[8], gn[8];
#pragma unroll
    for (int j = 0; j < 8; ++j) { csum[j] = 0.f; gn[j] = kgain[8 * l15 + j]; }
    for (int st = 0; st < 8; ++st) {
        const int r = 32 * w + 4 * st + quad;
        bf16_t* p = proj + ((size_t)b * SEQ + blk * 256 + r) * DIN + C_KM + h * 128 + 8 * l15;
        const u32x4 v = *(const u32x4*)p; float f[8]; unpack8(v, f);
        float ss = 0.f;
#pragma unroll
        for (int j = 0; j < 8; ++j) ss += f[j] * f[j];
        ss += __shfl_xor(ss, 1); ss += __shfl_xor(ss, 2); ss += __shfl_xor(ss, 4); ss += __shfl_xor(ss, 8);
        const float rstd = 1.f / sqrtf(ss * (1.f / 128.f) + EPS);
#pragma unroll
        for (int j = 0; j < 8; ++j) { f[j] = f[j] * rstd * gn[j]; csum[j] += f[j]; }
        *(u32x4*)p = pack8(f);
    }
#pragma unroll
    for (int j = 0; j < 8; ++j) { csum[j] += __shfl_xor(csum[j], 16); csum[j] += __shfl_xor(csum[j], 32); }
    if (quad == 0) {
#pragma unroll
        for (int j = 0; j < 8; ++j) red[w * 128 + 8 * l15 + j] = csum[j];
    }
    __syncthreads();
    if (tid < 128) { float s = 0.f;
#pragma unroll
        for (int k = 0; k < 8; ++k) s += red[k * 128 + tid];
        kmean[(((size_t)b * 8 + h) * 8 + blk) * 128 + tid] = s * (1.f / 256.f); }
    __syncthreads();
}
__device__ __forceinline__ void qnorm_rows(bf16_t* proj, const float* qgain, int row4, int lane) {
    const int l15 = lane & 15, quad = lane >> 4;
    float gn[8];
#pragma unroll
    for (int j = 0; j < 8; ++j) gn[j] = qgain[8 * l15 + j];
    bf16_t* base = proj + (size_t)(4 * row4 + quad) * DIN + C_QM + 8 * l15;
#pragma unroll
    for (int hh = 0; hh < 8; ++hh) {
        bf16_t* p = base + hh * 128;
        const u32x4 v = *(const u32x4*)p; float f[8]; unpack8(v, f);
        float ss = 0.f;
#pragma unroll
        for (int j = 0; j < 8; ++j) ss += f[j] * f[j];
        ss += __shfl_xor(ss, 1); ss += __shfl_xor(ss, 2); ss += __shfl_xor(ss, 4); ss += __shfl_xor(ss, 8);
        const float rstd = 1.f / sqrtf(ss * (1.f / 128.f) + EPS);
#pragma unroll
        for (int j = 0; j < 8; ++j) f[j] = f[j] * rstd * gn[j];
        *(u32x4*)p = pack8(f);
    }
}
__device__ __forceinline__ void vtrans_item(bf16_t* T, const bf16_t* proj, bf16_t* Vt, int item, int lane) {
    const int dh = item & 1, st = (item >> 1) & 31, h = (item >> 6) & 7, b = item >> 9;
    const bf16_t* src = proj + ((size_t)b * SEQ + 64 * st + lane) * DIN + C_VM + h * 128 + 64 * dh;
#pragma unroll
    for (int c = 0; c < 8; ++c) { const u32x4 v = *(const u32x4*)(src + 8 * c);
        T[(8 * c + 0) * 72 + lane] = (bf16_t)(v.x & 0xffffu); T[(8 * c + 1) * 72 + lane] = (bf16_t)(v.x >> 16);
        T[(8 * c + 2) * 72 + lane] = (bf16_t)(v.y & 0xffffu); T[(8 * c + 3) * 72 + lane] = (bf16_t)(v.y >> 16);
        T[(8 * c + 4) * 72 + lane] = (bf16_t)(v.z & 0xffffu); T[(8 * c + 5) * 72 + lane] = (bf16_t)(v.z >> 16);
        T[(8 * c + 6) * 72 + lane] = (bf16_t)(v.w & 0xffffu); T[(8 * c + 7) * 72 + lane] = (bf16_t)(v.w >> 16); }
    LDS_WAIT();
    const int g = lane & 7;
#pragma unroll
    for (int k = 0; k < 8; ++k) { const int d = (lane >> 3) + 8 * k; const u32x4 o = *(const u32x4*)(T + d * 72 + 8 * g);
        *(u32x4*)(Vt + (((size_t)b * 8 + h) * 128 + 64 * dh + d) * SEQ + 64 * st + 8 * g) = o; }
    LDS_WAIT();
}

__device__ __forceinline__ int crow(int r, int hi) { return (r & 3) + 8 * (r >> 2) + 4 * hi; }
__device__ __forceinline__ void moba_unit(unsigned char* lds, bf16_t* proj, const bf16_t* Vt, const float* kmean, int b, int h, int own, bf16_t* dry = nullptr) {
    int tid_ = threadIdx.x; asm volatile("" : "+v"(tid_));
    const int tid = tid_, lane = tid & 63, w = __builtin_amdgcn_readfirstlane(tid >> 6), r32 = lane & 31, hh = lane >> 5;
    constexpr int KP = 136, VP = 144;
    bf16_t* KsB = (bf16_t*)lds;
    bf16_t* VsB = KsB + 2 * 128 * KP;
    const size_t rowbase = (size_t)b * SEQ;
    const int qrel = 32 * w + r32;
    bf16_t* qptr = proj + (rowbase + own * 256 + qrel) * DIN + C_QM + h * 128;
    bf16x8 qf[8];
#pragma unroll
    for (int s = 0; s < 8; ++s) qf[s] = *(const bf16x8*)(qptr + 16 * s + 8 * hh);
    unsigned sel = 0u;
    {
        float g[7];
        const float* km = kmean + ((size_t)b * 8 + h) * 8 * 128;
#pragma unroll
        for (int jb = 0; jb < 7; ++jb) {
            float a = 0.f;
            if (jb < own) {
#pragma unroll
                for (int s = 0; s < 8; ++s) { const f32x4 k0 = *(const f32x4*)(km + jb * 128 + 16 * s + 8 * hh), k1 = *(const f32x4*)(km + jb * 128 + 16 * s + 8 * hh + 4);
                    const u32x4 qu = __builtin_bit_cast(u32x4, qf[s]);
                    a += bflo(qu.x) * k0.x + bfhi(qu.x) * k0.y + bflo(qu.y) * k0.z + bfhi(qu.y) * k0.w + bflo(qu.z) * k1.x + bfhi(qu.z) * k1.y + bflo(qu.w) * k1.z + bfhi(qu.w) * k1.w; }
                a += __shfl_xor(a, 32);
            }
            g[jb] = a;
        }
#pragma unroll
        for (int jb = 0; jb < 7; ++jb) {
            int rank = 0;
#pragma unroll
            for (int j2 = 0; j2 < 7; ++j2) { if (j2 != jb) { const bool better = (g[j2] > g[jb]) || (g[j2] == g[jb] && j2 < jb); rank += (j2 < own && better) ? 1 : 0; } }
            if (jb < own && rank < 3) sel |= (1u << jb);
        }
    }
    f32x16 o[4];
#pragma unroll
    for (int i = 0; i < 4; ++i)
#pragma unroll
        for (int r = 0; r < 16; ++r) o[i][r] = 0.f;
    float mrun = -1e30f, lrun = 0.f;
    const float SC = 0.08838834764831845f * 1.4426950408889634f;
    const int NT = 4 * (own + 1);
    const bf16_t* kg = proj + rowbase * DIN + C_KM + h * 128;
    const bf16_t* vg = proj + rowbase * DIN + C_VM + h * 128;
    const int vtoff = (4 * hh + ((lane & 15) >> 2)) * VP + 16 * ((lane >> 4) & 1) + 4 * (lane & 3);
    u32x4 kr[4], vr[4];
#define MOBA_LOAD(T_) do { _Pragma("unroll") for (int k_ = 0; k_ < 4; ++k_) { const int c_ = tid + 512 * k_; \
        kr[k_] = *(const u32x4*)(kg + (size_t)(128 * (T_) + (c_ >> 4)) * DIN + 8 * (c_ & 15)); \
        vr[k_] = *(const u32x4*)(vg + (size_t)(128 * (T_) + (c_ >> 4)) * DIN + 8 * (c_ & 15)); } } while (0)
#define MOBA_STORE(buf) do { _Pragma("unroll") for (int k_ = 0; k_ < 4; ++k_) { const int c_ = tid + 512 * k_; \
        *(u32x4*)(KsB + (buf) * 128 * KP + (c_ >> 4) * KP + 8 * (c_ & 15)) = kr[k_]; \
        *(u32x4*)(VsB + (buf) * 128 * VP + (c_ >> 4) * VP + 8 * (c_ & 15)) = vr[k_]; } } while (0)
    MOBA_LOAD(0);
    for (int T = 0; T < NT / 2; ++T) {
        const int buf = T & 1;
        MOBA_STORE(buf);
        __syncthreads();
        if (2 * T + 2 < NT) MOBA_LOAD(T + 1);
#pragma unroll
      for (int hf = 0; hf < 2; ++hf) {
        const int t = 2 * T + hf;
        const int jb = t >> 2, kt = t & 3;
        const bool isown = (jb == own);
        bool active;
        if (isown) active = (64 * kt <= 32 * w + 31);
        else active = __any((sel >> jb) & 1u) != 0;
        if (active) {
            const bf16_t* Kt = KsB + (buf * 128 + hf * 64) * KP; const LAS bf16_t* Vv = (const LAS bf16_t*)(VsB + (buf * 128 + hf * 64) * VP) + vtoff;
            f32x16 sc[2];
#pragma unroll
            for (int kb = 0; kb < 2; ++kb) {
#pragma unroll
                for (int r = 0; r < 16; ++r) sc[kb][r] = 0.f;
#pragma unroll
                for (int s = 0; s < 8; ++s) { const bf16x8 kf = *(const bf16x8*)(Kt + (32 * kb + r32) * KP + 16 * s + 8 * hh); sc[kb] = __builtin_amdgcn_mfma_f32_32x32x16_bf16(kf, qf[s], sc[kb], 0, 0, 0); }
            }
            const bool lane_sel = isown || (((sel >> jb) & 1u) != 0u);
            if (isown && (64 * kt + 63 > 32 * w)) {
#pragma unroll
                for (int kb = 0; kb < 2; ++kb)
#pragma unroll
                    for (int r = 0; r < 16; ++r) { const int krel = 64 * kt + 32 * kb + crow(r, hh); if (krel > qrel) sc[kb][r] = -INFINITY; }
            }
            float mx = -INFINITY;
#pragma unroll
            for (int kb = 0; kb < 2; ++kb)
#pragma unroll
                for (int r = 0; r < 16; ++r) mx = fmaxf(mx, sc[kb][r]);
            mx = fmaxf(mx, __shfl_xor(mx, 32)) * SC;
            const bool grow = lane_sel && (mx > mrun + 8.f);
            if (__any(grow)) {
                const float mnew = grow ? mx : mrun;
                const float alpha = __builtin_amdgcn_exp2f(mrun - mnew);
                lrun *= alpha; mrun = mnew;
#pragma unroll
                for (int i = 0; i < 4; ++i)
#pragma unroll
                    for (int r = 0; r < 16; ++r) o[i][r] *= alpha;
            }
            const float mref = lane_sel ? mrun : INFINITY;
            float ps = 0.f;
#pragma unroll
            for (int kb = 0; kb < 2; ++kb)
#pragma unroll
                for (int r = 0; r < 16; ++r) { const float p = __builtin_amdgcn_exp2f(__builtin_fmaf(sc[kb][r], SC, -mref)); sc[kb][r] = p; ps += p; }
            ps += __shfl_xor(ps, 32);
            lrun += ps;
#pragma unroll
            for (int kb = 0; kb < 2; ++kb)
#pragma unroll
                for (int s = 0; s < 2; ++s) {
                    u32x4 pw; pw.x = pk2(sc[kb][8 * s + 0], sc[kb][8 * s + 1]); pw.y = pk2(sc[kb][8 * s + 2], sc[kb][8 * s + 3]); pw.z = pk2(sc[kb][8 * s + 4], sc[kb][8 * s + 5]); pw.w = pk2(sc[kb][8 * s + 6], sc[kb][8 * s + 7]);
                    const bf16x8 pb = __builtin_bit_cast(bf16x8, pw);
#pragma unroll
                    for (int db = 0; db < 4; ++db) { const LAS bf16_t* vp = Vv + (32 * kb + 16 * s) * VP + 32 * db;
                        const s16x4 lo = __builtin_amdgcn_ds_read_tr16_b64_v4i16((LAS s16x4*)vp), hi = __builtin_amdgcn_ds_read_tr16_b64_v4i16((LAS s16x4*)(vp + 8 * VP));
                        const bf16x8 va = __builtin_shufflevector(lo, hi, 0, 1, 2, 3, 4, 5, 6, 7);
                        o[db] = __builtin_amdgcn_mfma_f32_32x32x16_bf16(va, pb, o[db], 0, 0, 0); }
                }
        }
      }
    }
#undef MOBA_LOAD
#undef MOBA_STORE
    const float rl = 1.f / lrun;
#pragma unroll
    for (int db = 0; db < 4; ++db)
#pragma unroll
        for (int g4 = 0; g4 < 4; ++g4) { u32x2 wv; wv.x = pk2(o[db][4 * g4 + 0] * rl, o[db][4 * g4 + 1] * rl); wv.y = pk2(o[db][4 * g4 + 2] * rl, o[db][4 * g4 + 3] * rl);
            *(u32x2*)((dry ? dry + tid * 8 : qptr + 32 * db + 8 * g4) + 4 * hh) = wv; }
    __syncthreads();
}

__device__ __forceinline__ void retfin_rows(bf16_t* proj, const f32x2* stats, const float* gain, const float* bias, int m_first, int m_step, int lane) {
    const int hd = lane >> 4;
    float gg[16], bb[16];
#pragma unroll
    for (int k = 0; k < 4; ++k) { const f32x4 g4 = *(const f32x4*)(gain + 16 * lane + 4 * k), b4 = *(const f32x4*)(bias + 16 * lane + 4 * k);
        gg[4 * k] = g4.x; gg[4 * k + 1] = g4.y; gg[4 * k + 2] = g4.z; gg[4 * k + 3] = g4.w; bb[4 * k] = b4.x; bb[4 * k + 1] = b4.y; bb[4 * k + 2] = b4.z; bb[4 * k + 3] = b4.w; }
    for (int m = m_first; m < M; m += 2 * m_step) {
        u32x4 ov[2][2], gv[2][2]; f32x2 st[2][4];
#pragma unroll
        for (int t = 0; t < 2; ++t) { const size_t mm = (size_t)(m + t * m_step); const bf16_t* op = proj + mm * DIN + C_VR + 16 * lane; const bf16_t* gp = proj + mm * DIN + C_GR + 16 * lane;
            ov[t][0] = *(const u32x4*)op; ov[t][1] = *(const u32x4*)(op + 8); gv[t][0] = *(const u32x4*)gp; gv[t][1] = *(const u32x4*)(gp + 8);
            const f32x2* sp = stats + (mm * 4 + hd) * 4; st[t][0] = sp[0]; st[t][1] = sp[1]; st[t][2] = sp[2]; st[t][3] = sp[3]; }
#pragma unroll
        for (int t = 0; t < 2; ++t) {
            const float mu = ((st[t][0].x + st[t][1].x) + (st[t][2].x + st[t][3].x)) * (1.f / 256.f);
            const float var = fmaxf(((st[t][0].y + st[t][1].y) + (st[t][2].y + st[t][3].y)) * (1.f / 256.f) - mu * mu, 0.f);
            const float rstd = 1.f / sqrtf(var + EPS);
            bf16_t* gp = proj + (size_t)(m + t * m_step) * DIN + C_GR + 16 * lane;
#pragma unroll
            for (int k = 0; k < 2; ++k) { float of[8], gf[8], r[8]; unpack8(ov[t][k], of); unpack8(gv[t][k], gf);
#pragma unroll
                for (int j = 0; j < 8; ++j) r[j] = ((of[j] - mu) * rstd * gg[8 * k + j] + bb[8 * k + j]) * (gf[j] * fsigmoid(gf[j]));
                *(u32x4*)(gp + 8 * k) = pack8(r); }
        }
    }
}

#define XB_TMO      128
#define XB_XCNT(j)  (256  + 64 * (j))
#define XB_XSUB(j)  (1280 + 64 * (j))
#define XB_XGEN(j)  (2304 + 64 * (j))
#define XB_TOP      3328
#define XB_TOPGEN   3392
#define XCD_BAR_WORDS 3456
#define XB_SPIN_CAP (1u << 18)
__device__ __forceinline__ unsigned xb_ld(unsigned* p)              { return __hip_atomic_load(p, __ATOMIC_RELAXED, __HIP_MEMORY_SCOPE_AGENT); }
__device__ __forceinline__ unsigned xb_add(unsigned* p, unsigned v) { return __hip_atomic_fetch_add(p, v, __ATOMIC_RELAXED, __HIP_MEMORY_SCOPE_AGENT); }
__device__ __forceinline__ unsigned xb_xcc_id() { return (unsigned)__builtin_amdgcn_s_getreg((3 << 11) | 20) & 0xFu; }
#define XB_SPIN(cond, bar) do { unsigned _sp = 0; while (cond) { __builtin_amdgcn_s_sleep(1); \
    if ((++_sp & 255u) == 0u) { if (xb_ld(&(bar)[XB_TMO])) break; if (_sp > XB_SPIN_CAP) { atomicAdd(&(bar)[XB_TMO], 1u); break; } } } } while (0)
struct XcdBarrier { unsigned* bar; unsigned x; volatile LAS unsigned* st; };
__device__ __forceinline__ XcdBarrier xcd_barrier_post(unsigned* bar, volatile LAS unsigned* st) {
    XcdBarrier b; b.bar = bar; b.x = xb_xcc_id(); b.st = st;
    if (threadIdx.x == 0) (void)xb_add(&bar[XB_XCNT(b.x)], 1u);
    return b;
}
__device__ __forceinline__ void xcd_barrier_complete(unsigned* bar, unsigned x, unsigned& nloc, unsigned& nx) {
    const unsigned G = gridDim.x * gridDim.y * gridDim.z;
    unsigned sum, cnt, mine, sp = 0u;
    for (;;) {
        sum = 0u; cnt = 0u; mine = 0u;
#pragma unroll
        for (unsigned j = 0; j < 16; ++j) { const unsigned c = xb_ld(&bar[XB_XCNT(j)]); sum += c; cnt += (c > 0u) ? 1u : 0u; mine = (j == x) ? c : mine; }
        if (sum == G) break;
        __builtin_amdgcn_s_sleep(1);
        if ((++sp & 255u) == 0u) { if (xb_ld(&bar[XB_TMO])) break; if (sp > XB_SPIN_CAP) { atomicAdd(&bar[XB_TMO], 1u); break; } }
    }
    nloc = mine > 0u ? mine : 1u; nx = cnt > 0u ? cnt : 1u;
}
__device__ __forceinline__ void xcd_barrier(const XcdBarrier& b) {
    asm volatile("s_waitcnt vmcnt(0)" ::: "memory");
    __syncthreads();
    if (threadIdx.x == 0) {
        unsigned* bar = b.bar;
        __builtin_amdgcn_s_waitcnt(0);
        unsigned nloc = b.st[0], nx = b.st[1];
        if (nloc == 0u) { xcd_barrier_complete(bar, b.x, nloc, nx); b.st[0] = nloc; b.st[1] = nx; }
        const unsigned old = xb_add(&bar[XB_XSUB(b.x)], 1u);
        const unsigned gen = old / nloc;
        if (old + 1u == (gen + 1u) * nloc) {
            __builtin_amdgcn_fence(__ATOMIC_RELEASE, "agent");
            asm volatile("s_waitcnt vmcnt(0)" ::: "memory");
            const unsigned og = xb_add(&bar[XB_TOP], 1u);
            const unsigned tg = og / nx;
            if (og + 1u == (tg + 1u) * nx) xb_add(&bar[XB_TOPGEN], 1u);
            else XB_SPIN(xb_ld(&bar[XB_TOPGEN]) == tg, bar);
            __builtin_amdgcn_fence(__ATOMIC_ACQUIRE, "agent");
            xb_add(&bar[XB_XGEN(b.x)], 1u);
            asm volatile("s_waitcnt vmcnt(0)" ::: "memory");
        } else {
            XB_SPIN(xb_ld(&bar[XB_XGEN(b.x)]) == gen, bar);
            __builtin_amdgcn_fence(__ATOMIC_ACQUIRE, "agent");
            asm volatile("s_waitcnt vmcnt(0)" ::: "memory");
        }
    }
    __syncthreads();
}

struct Args { const float* in[17]; float* out; unsigned char* ws; int never; int pad; };

__global__ void __launch_bounds__(512, 2) fwd_kernel(Args args) {
    extern __shared__ __attribute__((aligned(16))) unsigned char lds[];
    cg::grid_group grid = cg::this_grid();
    const int tid = threadIdx.x, lane = tid & 63, wave = __builtin_amdgcn_readfirstlane(tid >> 6);
    const int G = gridDim.x, bid = blockIdx.x;
    const int gw = bid * 8 + wave, NGW = G * 8;
    unsigned char* ws = args.ws;
    const float* x = args.in[0]; const float* attn_norm = args.in[1]; const float* w_in = args.in[2]; const float* ret_gain = args.in[3]; const float* ret_bias = args.in[4];
    const float* q_gain = args.in[5]; const float* k_gain = args.in[6]; const float* w_ret_o = args.in[7]; const float* w_moba_o = args.in[8]; const float* w_gate = args.in[9];
    const float* b_gate = args.in[10]; const float* w_out = args.in[11]; const float* ffn_norm = args.in[12]; const float* w_up = args.in[13]; const float* conv_w = args.in[14];
    const float* conv_b = args.in[15]; const float* w_down = args.in[16];
    float* out = args.out;
    bf16_t* W1 = (bf16_t*)(ws + WS_W1); bf16_t* W2 = (bf16_t*)(ws + WS_W2); bf16_t* WO = (bf16_t*)(ws + WS_WO); bf16_t* WUP = (bf16_t*)(ws + WS_WUP); bf16_t* WDN = (bf16_t*)(ws + WS_WDN);
    f32x2* rope = (f32x2*)(ws + WS_ROPE); float* kmean = (float*)(ws + WS_KMEAN); f32x2* stats = (f32x2*)(ws + WS_STATS);
    bf16_t* HB = (bf16_t*)(ws + WS_H); bf16_t* PROJ = (bf16_t*)(ws + WS_PROJ); bf16_t* ACT = (bf16_t*)(ws + WS_PROJ); float* UH = (float*)(ws + WS_UH); bf16_t* XB = (bf16_t*)(ws + WS_XB); float* SSQ = (float*)(ws + WS_STATS); float* RSTD = (float*)(ws + WS_RSTD);
    bf16_t* GATES = (bf16_t*)out;
    LAS unsigned char* lds3 = (LAS unsigned char*)lds;
#ifndef PROBE_A
#define PROBE_A -1
#endif
#ifndef PROBE_B
#define PROBE_B -1
#endif
    unsigned long long* stamps = (unsigned long long*)(ws + 46 * MiB);
    int n_stamp = 0;
#define STAMP() do { if (PROBE_A >= 0) { if (bid == 0 && tid == 0) stamps[n_stamp] = __builtin_amdgcn_s_memrealtime(); ++n_stamp; } } while (0)
    STAMP();
    unsigned* barw = (unsigned*)(ws + 47 * MiB);
    volatile LAS unsigned* bst = (volatile LAS unsigned*)(lds3 + LDS_BYTES - 256);
    if (tid < 2) bst[tid] = 0u;
    const XcdBarrier xbar = xcd_barrier_post(barw, bst);
#define GSYNC() xcd_barrier(xbar)

#ifndef PHMASK
#define PHMASK 0xffff
#endif
#define RUNP(n) ((((PHMASK) >> (n)) & 1) != 0)
    if constexpr (RUNP(0)) {
        float* scr = (float*)(lds + wave * 16384);
        constexpr int I_IN = 16 * (DIN / 32), I_G = 16 * (NGATE / 32), I_O = 16 * 32, I_UP = 16 * (NUP / 32), I_DN = (DFF / 64) * 32;
        (void)I_O; (void)I_UP; (void)I_DN;
        for (int it = gw; it < I_IN + I_G; it += NGW) {
            int r = it;
            if (r < I_IN) { transpose_item<2>(w_in, DM, DIN, W1, DM, 0, 0, scr, r, lane); continue; } r -= I_IN;
            transpose_item(w_gate, DM, NGATE, W1, DM, DIN, 0, scr, r, lane);
        }
        for (int m = gw; m < M; m += 2 * NGW) {
            const int m2 = m + NGW;
            const f32x4* xa = (const f32x4*)(x + (size_t)m * DM) + lane; const f32x4* xc = (const f32x4*)(x + (size_t)m2 * DM) + lane; const f32x4* gr = (const f32x4*)attn_norm + lane;
            f32x4 va[4], vc[4]; float sa = 0.f, sc = 0.f;
#pragma unroll
            for (int j = 0; j < 4; ++j) { va[j] = xa[64 * j]; vc[j] = xc[64 * j]; }
#pragma unroll
            for (int j = 0; j < 4; ++j) { sa += (va[j].x * va[j].x + va[j].y * va[j].y) + (va[j].z * va[j].z + va[j].w * va[j].w); sc += (vc[j].x * vc[j].x + vc[j].y * vc[j].y) + (vc[j].z * vc[j].z + vc[j].w * vc[j].w); }
            const float ra = 1.f / sqrtf(wave_sum(sa) * (1.f / DM) + EPS), rc = 1.f / sqrtf(wave_sum(sc) * (1.f / DM) + EPS);
            u32x2* oa = (u32x2*)(HB + (size_t)m * DM) + lane; u32x2* oc = (u32x2*)(HB + (size_t)m2 * DM) + lane;
#pragma unroll
            for (int j = 0; j < 4; ++j) { const f32x4 gg = gr[64 * j]; u32x2 w; w.x = pk2(va[j].x * ra * gg.x, va[j].y * ra * gg.y); w.y = pk2(va[j].z * ra * gg.z, va[j].w * ra * gg.w); oa[64 * j] = w;
                u32x2 w2; w2.x = pk2(vc[j].x * rc * gg.x, vc[j].y * rc * gg.y); w2.y = pk2(vc[j].z * rc * gg.z, vc[j].w * rc * gg.w); oc[64 * j] = w2; }
        }
        for (int i = bid * 512 + tid; i < NB * 8 * 8 * 128; i += G * 512) kmean[i] = 0.f;
        for (int i = bid * 512 + tid; i < SEQ * 64; i += G * 512) {
            const int pos = i >> 6, fi = i & 63;
            const float inv_freq = __builtin_amdgcn_exp2f(-(float)fi * (13.287712379549449f / 64.f));
            double rev = (double)pos * (double)inv_freq * 0.15915494309189535; rev -= __builtin_floor(rev);
            const float rf = (float)rev;
            rope[i] = (f32x2){__builtin_amdgcn_cosf(rf), __builtin_amdgcn_sinf(rf)};
        }
    }
    if (args.never) grid.sync();
    GSYNC(); STAMP();
#ifdef DUP_SYNC
    for (int i_ = 0; i_ < 10; ++i_) GSYNC();
#endif
#ifdef DUP_G1
    {
        pg8::Gemm g{HB, W1, M, N1, DM, DM}; pg8::StaticOrder S; S.init(M, N1, G, bid);
        pg8::EpiProj E{PROJ, GATES, b_gate, q_gain, k_gain, kmean, (float*)(lds + 131072), rope};
        pg8::gemm_phase<pg8::EpiProj>(lds3, g, S, E);
    }
#endif
    if constexpr (RUNP(1)) {
        pg8::Gemm g{HB, W1, M, N1, DM, DM}; pg8::StaticOrder S; S.init(M, N1, G, bid);
        pg8::EpiProj E{PROJ, GATES, b_gate, q_gain, k_gain, kmean, (float*)(lds + 131072), rope};
        pg8::gemm_phase<pg8::EpiProj>(lds3, g, S, E);
    }
    GSYNC(); STAMP();
    if constexpr (RUNP(2)) {
#ifdef DUP_RET
        for (int it = bid; it < NB * 4 * 4; it += G) retention_item(lds, PROJ, rope, stats, it >> 4, (it >> 2) & 3, it & 3, (bf16_t*)(ws + 500 * MiB));
#endif
        if constexpr (RUNP(10)) for (int it = bid; it < NB * 4 * 4; it += G) retention_item(lds, PROJ, rope, stats, it >> 4, (it >> 2) & 3, it & 3);
    }
    GSYNC(); STAMP();
    if constexpr (RUNP(3)) {
      const int first_fin = (bid >> 3) & 1;
#pragma unroll 1
      for (int step = 0; step < 2; ++step) {
       if ((step ^ first_fin) == 1) {
        for (int bh = bid >> 1; bh < NB * 8; bh += (G >> 1)) {
            const int par = bid & 1;
#pragma unroll 1
            for (int k = 0; k < 4; ++k) { const int own = par ? (k == 0 ? 6 : k == 1 ? 5 : k == 2 ? 2 : 1) : (k == 0 ? 7 : k == 1 ? 4 : k == 2 ? 3 : 0);
#ifdef DUP_MOBA
                moba_unit(lds, PROJ, HB, kmean, bh >> 3, bh & 7, own, (bf16_t*)(ws + 500 * MiB));
#endif
                moba_unit(lds, PROJ, HB, kmean, bh >> 3, bh & 7, own); }
        }
       } else {
        retfin_rows(PROJ, stats, ret_gain, ret_bias, gw, NGW, lane);
        {
            float* scr = (float*)(lds + wave * 16384);
            constexpr int I_O = 16 * 32, I_UP = 16 * (NUP / 32), I_DN = (DFF / 64) * 32;
            for (int it = gw; it < 3 * I_O + I_UP + I_DN; it += NGW) {
                int r = it;
                if (r < I_O) { transpose_item(w_ret_o, DM, DM, W2, 2 * DM, 0, 0, scr, r, lane); continue; } r -= I_O;
                if (r < I_O) { transpose_item(w_moba_o, DM, DM, W2, 2 * DM, 0, DM, scr, r, lane); continue; } r -= I_O;
                if (r < I_O) { transpose_item(w_out, DM, DM, WO, DM, 0, 0, scr, r, lane); continue; } r -= I_O;
                if (r < I_UP) { transpose_item<1>(w_up, DM, NUP, WUP, DM, 0, 0, scr, r, lane, ffn_norm); continue; } r -= I_UP;
                transpose_item(w_down, DFF, DM, WDN, DFF, 0, 0, scr, r, lane);
            }
            __syncthreads();
        }
       }
      }
    }
    GSYNC(); STAMP();
    if constexpr (RUNP(4)) {
        pg8::Gemm g{PROJ + C_GR, W2, M, DM, 2 * DM, DIN}; pg8::StaticOrder S; S.init(M, DM, G, bid);
        pg8::EpiMerge E{GATES, HB};
        pg8::gemm_phase<pg8::EpiMerge>(lds3, g, S, E);
    }
    GSYNC(); STAMP();
#ifdef DUP_G4
    {
        pg8::Gemm g{HB, WO, M, DM, DM, DM}; pg8::StaticOrder S; S.init(M, DM, G, bid);
        pg8::EpiResidNorm E{x, XB, SSQ};
        pg8::gemm_phase<pg8::EpiResidNorm>(lds3, g, S, E);
    }
    GSYNC();
#endif
    if constexpr (RUNP(5)) {
        pg8::Gemm g{HB, WO, M, DM, DM, DM}; pg8::StaticOrder S; S.init(M, DM, G, bid);
        pg8::EpiResidNorm E{x, XB, SSQ};
        pg8::gemm_phase<pg8::EpiResidNorm>(lds3, g, S, E);
    }
    GSYNC(); STAMP();
    for (int m = bid * 512 + tid; m < M; m += G * 512) { const f32x4* p = (const f32x4*)(SSQ + (size_t)m * 16); const f32x4 a = p[0], b = p[1], c = p[2], d = p[3];
        const float s = ((a.x + a.y) + (a.z + a.w)) + ((b.x + b.y) + (b.z + b.w)) + ((c.x + c.y) + (c.z + c.w)) + ((d.x + d.y) + (d.z + d.w));
        RSTD[m] = 1.f / sqrtf(s * (1.f / DM) + EPS); }
    GSYNC(); STAMP();
#ifdef DUP_G5
    {
        pg8::Gemm g{XB, WUP, M, NUP, DM, DM}; pg8::StaticOrder S; S.init(M, NUP, G, bid);
        pg8::EpiConv E{ACT, UH, conv_w, conv_b, (f32x2*)(lds + 131072), RSTD};
        pg8::gemm_phase<pg8::EpiConv, true, true, true>(lds3, g, S, E);
    }
#endif
    {
        pg8::Gemm g{XB, WUP, M, NUP, DM, DM}; pg8::StaticOrder S; S.init(M, NUP, G, bid);
        pg8::EpiConv E{ACT, UH, conv_w, conv_b, (f32x2*)(lds + 131072), RSTD};
        pg8::gemm_phase<pg8::EpiConv, true, true, true>(lds3, g, S, E);
    }
    GSYNC(); STAMP();
    for (int idx = bid * 512 + tid; idx < 112 * DFF; idx += G * 512) {
        const int t = idx / DFF, c = idx - t * DFF, pm = (t / 7) * 8 + (t % 7) + 1;
        const int colg = 256 * (c >> 7) + (c & 127), colv = colg + 128;
        const float* up = UH + ((size_t)(pm - 1) * 4 + 2) * NUP; const float* uc = UH + ((size_t)pm * 4) * NUP;
        const float a2 = up[colg], a1 = up[NUP + colg], a0 = uc[colg], an = uc[NUP + colg];
        const float b2 = up[colv], b1 = up[NUP + colv], b0 = uc[colv], bn = uc[NUP + colv];
        const float gb = conv_b[c], g0 = conv_w[c], g1 = conv_w[NUP + c], g2 = conv_w[2 * NUP + c];
        const float vb = conv_b[DFF + c], v0 = conv_w[DFF + c], v1 = conv_w[NUP + DFF + c], v2 = conv_w[2 * NUP + DFF + c];
        const float og0 = gb + g0 * a2 + g1 * a1 + g2 * a0, og1 = gb + g0 * a1 + g1 * a0 + g2 * an;
        const float ov0 = vb + v0 * b2 + v1 * b1 + v2 * b0, ov1 = vb + v0 * b1 + v1 * b0 + v2 * bn;
        const unsigned w = pk2(og0 * fsigmoid(og0) * ov0, og1 * fsigmoid(og1) * ov1);
        ACT[(size_t)(pm * 256) * DFF + c] = (bf16_t)(w & 0xffffu); ACT[(size_t)(pm * 256 + 1) * DFF + c] = (bf16_t)(w >> 16);
    }
    GSYNC(); STAMP();
    {
        pg8::Gemm g{ACT, WDN, M, DM, DFF, DFF}; pg8::StaticOrder S; S.init(M, DM, G, bid);
        pg8::EpiResid E{XB, out};
        pg8::gemm_phase<pg8::EpiResid>(lds3, g, S, E);
    }
    if (PROBE_A >= 0) {
        GSYNC(); STAMP(); __threadfence(); __syncthreads();
        if (bid == 0) {
            const int pa = PROBE_A, pb = PROBE_B;
            const float ta = (float)(stamps[pa + 1] - stamps[pa]) * 0.01f;
            const float tb = pb >= 100 ? (float)(stamps[n_stamp - 1] - stamps[0]) * 0.01f : (pb >= 0 ? (float)(stamps[pb + 1] - stamps[pb]) * 0.01f : 0.f);
            if (tid == 0) out[0] += ta * 0.01f;
            for (int i = tid; i < 65536; i += 512) out[4096 + i] += tb * 0.001f;
        }
    }
}

extern "C" void kernel_launch(void* const* d_in, const int* in_sizes, int n_in, void* d_out, int out_size, void* d_ws, size_t ws_size, hipStream_t stream) {
    static int grid = 0;
    if (grid == 0) {
        if (n_in != 17 || out_size != M * DM || ws_size < WS_END) { fprintf(stderr, "kernel_launch: unexpected shapes (n_in %d out %d ws %zu)\n", n_in, out_size, ws_size); grid = -1; return; }
        int dev = 0, cus = 0, per_cu = 0;
        hipGetDevice(&dev); hipDeviceGetAttribute(&cus, hipDeviceAttributeMultiprocessorCount, dev);
        hipFuncSetAttribute((const void*)fwd_kernel, hipFuncAttributeMaxDynamicSharedMemorySize, LDS_BYTES);
        hipOccupancyMaxActiveBlocksPerMultiprocessor(&per_cu, (const void*)fwd_kernel, 512, LDS_BYTES);
        if (per_cu < 1) { fprintf(stderr, "kernel_launch: occupancy query says %d blocks per CU\n", per_cu); per_cu = 1; }
        (void)hipGetLastError();
        grid = cus * per_cu;
    }
    if (grid < 0) return;
    if (hipMemsetAsync((char*)d_ws + 47 * MiB, 0, XCD_BAR_WORDS * 4, stream) != hipSuccess) { fprintf(stderr, "kernel_launch: memset of the barrier words failed\n"); return; }
    Args a{};
    for (int i = 0; i < 17; ++i) a.in[i] = (const float*)d_in[i];
    a.out = (float*)d_out; a.ws = (unsigned char*)d_ws;
    void* params[] = {&a};
    hipError_t e = hipLaunchCooperativeKernel((const void*)fwd_kernel, dim3(grid), dim3(512), params, LDS_BYTES, stream);
    if (e != hipSuccess) fprintf(stderr, "cooperative launch failed: %s (grid %d)\n", hipGetErrorString(e), grid);
}
```

```cpp
#include <hip/hip_runtime.h>
#include <hip/hip_cooperative_groups.h>
#include <cstdio>
#include <cstdint>
namespace cg = cooperative_groups;

#define LAS __attribute__((address_space(3)))
typedef unsigned short bf16_t;
typedef short bf16x8 __attribute__((ext_vector_type(8)));
typedef short s16x4 __attribute__((ext_vector_type(4)));
typedef float f32x4 __attribute__((ext_vector_type(4)));
typedef float f32x2 __attribute__((ext_vector_type(2)));
typedef float f32x16 __attribute__((ext_vector_type(16)));
typedef unsigned u32x4 __attribute__((ext_vector_type(4)));
typedef unsigned u32x2 __attribute__((ext_vector_type(2)));
typedef __bf16 bf16x2_t __attribute__((ext_vector_type(2)));

constexpr int SEQ = 2048, NB = 16, DM = 1024, M = NB * SEQ;
constexpr int DIN = 6144, NGATE = 2048, N1 = DIN + NGATE;
constexpr int DFF = 2816, NUP = 2 * DFF;
constexpr int C_QR = 0, C_KR = 512, C_VR = 1024, C_GR = 2048, C_QM = 3072, C_KM = 4096, C_VM = 5120;
constexpr float EPS = 1e-6f;
constexpr int RET_QKW = 512;
constexpr int MH = M / 2;

constexpr size_t MiB = 1u << 20;
constexpr size_t WS_W1 = 0;
constexpr size_t WS_W2 = 16 * MiB;
constexpr size_t WS_WO = 20 * MiB;
constexpr size_t WS_WUP = 22 * MiB;
constexpr size_t WS_WDN = 33 * MiB;
constexpr size_t WS_ROPE = 39 * MiB;
constexpr size_t WS_KMEAN = 40 * MiB;
constexpr size_t WS_STATS = 41 * MiB;
constexpr size_t WS_H = 48 * MiB;
constexpr size_t WS_PROJ = 112 * MiB;
constexpr size_t WS_XB = WS_PROJ + 224 * MiB;
constexpr size_t WS_RSTD = 45 * MiB;
constexpr size_t WS_UH = WS_PROJ + 200 * MiB;
constexpr size_t WS_END = 496 * MiB;

constexpr int LDS_BYTES = 147456;

__device__ __forceinline__ unsigned pk2(float lo, float hi) { f32x2 v = {lo, hi}; bf16x2_t b = __builtin_convertvector(v, bf16x2_t); return __builtin_bit_cast(unsigned, b); }
__device__ __forceinline__ float bflo(unsigned u) { return __uint_as_float(u << 16); }
__device__ __forceinline__ float bfhi(unsigned u) { return __uint_as_float(u & 0xffff0000u); }
__device__ __forceinline__ float fsigmoid(float x) { return __builtin_amdgcn_rcpf(1.f + __builtin_amdgcn_exp2f(-1.4426950408889634f * x)); }
__device__ __forceinline__ void unpack8(const u32x4 v, float* f) { f[0] = bflo(v.x); f[1] = bfhi(v.x); f[2] = bflo(v.y); f[3] = bfhi(v.y); f[4] = bflo(v.z); f[5] = bfhi(v.z); f[6] = bflo(v.w); f[7] = bfhi(v.w); }
__device__ __forceinline__ u32x4 pack8(const float* f) { u32x4 o; o.x = pk2(f[0], f[1]); o.y = pk2(f[2], f[3]); o.z = pk2(f[4], f[5]); o.w = pk2(f[6], f[7]); return o; }
#define LDS_WAIT() asm volatile("s_waitcnt lgkmcnt(0)" ::: "memory")

namespace pg8 {
constexpr int BM = 256, BK = 64, HALF = 128, HTB = HALF * BK * 2, STAGE_BYTES = 8 * HTB, NXCD = 8, WGM = 4;
__host__ __device__ __forceinline__ int lds_byte(int r, int c) { const int st = (r >> 4) * 2 + (c >> 5), rr = r & 15, cc = c & 31, ob = rr * 64 + cc * 2; return st * 1024 + (ob ^ (((ob >> 9) & 1) << 5)); }
__host__ __device__ __forceinline__ void stage_rc(int b, int& R, int& C) { const int st = b / 1024, sb = b % 1024, swz = sb ^ (((sb >> 9) & 1) << 5); R = (st >> 1) * 16 + swz / 64; C = (st & 1) * 32 + (swz % 64) / 2; }
__host__ __device__ __forceinline__ int perm32(int rho) { const int n = rho >> 4, i = rho & 15; return 8 * (i >> 2) + 4 * n + (i & 3); }

struct Unit { int pm, pn; };
struct Gemm { const bf16_t* A; const bf16_t* Bt; int M, N, K, lda; };

struct StaticOrder {
    int nM, nN, nwg, G, c;
    __device__ void init(int M_, int N_, int G_, int c_) { nM = M_ / BM; nN = N_ / BM; nwg = nM * nN; G = G_; c = c_; }
    __device__ bool next(int i, Unit& u) const {
        const long L = (long)i * G + c; if (L >= nwg) return false;
        int wgid = (int)L; { const int q = nwg / NXCD, r = nwg % NXCD, xcd = wgid % NXCD, off = wgid / NXCD; wgid = (xcd < r ? xcd * (q + 1) : r * (q + 1) + (xcd - r) * q) + off; }
        const int nig = WGM * nN, gid = wgid / nig, fm = gid * WGM, gsz = (nM - fm) < WGM ? (nM - fm) : WGM;
        u.pm = fm + ((wgid % nig) % gsz); u.pn = (wgid % nig) / gsz; return true;
    }
};

typedef f32x4 Acc[2][2][4][2];

template <class Epi, bool ALIGN_EPI = true, bool SP2 = true, bool SWAP = false>
__device__ __forceinline__ void gemm_phase(LAS unsigned char* lds, const Gemm g, const StaticOrder& S, const Epi& E) {
    int tid_ = threadIdx.x; asm volatile("" : "+v"(tid_));
    const int tid = tid_, wid = __builtin_amdgcn_readfirstlane(tid >> 6), lane = tid & 63, wr = wid >> 2, wc = wid & 3, fr = lane & 15, fq = lane >> 4;
    const int K = g.K, nt = K / BK, lda = g.lda;
    unsigned voffA[2], voffB[2], voffB1[2];
#pragma unroll
    for (int i = 0; i < 2; ++i) { int R, C; stage_rc(tid * 16 + i * 8192, R, C); const int Rb = Epi::PERM ? ((R & ~31) + perm32(R & 31)) : R;
        voffA[i] = (unsigned)(R * lda + C) * 2u; voffB[i] = (unsigned)(Rb * K + C) * 2u; voffB1[i] = voffB[i];
        if constexpr (Epi::ADJ) { const int r0 = 64 * (R >> 5) + perm32(R & 31); voffB[i] = (unsigned)(r0 * K + C) * 2u; voffB1[i] = (unsigned)((r0 + 32) * K + C) * 2u; } }
    const size_t kstep = (size_t)(BK * 2);
    const size_t hstepA = (size_t)HALF * lda * 2, hstepB_ = (size_t)HALF * K * 2;
    const size_t tstepA = 2 * hstepA, tstepB = 2 * hstepB_;
    const size_t hstepB = Epi::ADJ ? 0 : hstepB_;
    const unsigned ldsw = (unsigned)wid * 1024u;
    const int aoff = lds_byte(wr * 64 + fr, fq * 8), boff = lds_byte(wc * 32 + fr, fq * 8);
#define PG8_SA(b, h) (((b) * 2 + (h)) * HTB)
#define PG8_SB(b, h) ((4 + (b) * 2 + (h)) * HTB)
#define PG8_STAGE(bufoff, gbase, voff) do { _Pragma("unroll") for (int _i = 0; _i < 2; ++_i) \
        __builtin_amdgcn_global_load_lds((const unsigned*)((const char*)(gbase) + (voff)[_i]), (LAS unsigned*)(lds + (bufoff) + ldsw + _i * 8192), 16, 0, 0); } while (0)
#define PG8_LDA(dst, b, h) do { _Pragma("unroll") for (int m = 0; m < 4; ++m) _Pragma("unroll") for (int k = 0; k < 2; ++k) dst[m][k] = *(const LAS bf16x8*)(lds + PG8_SA(b, h) + aoff + m * 2048 + k * 1024); } while (0)
#define PG8_LDB(dst, b, h) do { _Pragma("unroll") for (int n = 0; n < 2; ++n) _Pragma("unroll") for (int k = 0; k < 2; ++k) dst[n][k] = *(const LAS bf16x8*)(lds + PG8_SB(b, h) + boff + n * 2048 + k * 1024); } while (0)
#define PG8_MMA(ai, bj, At, Bt) do { __builtin_amdgcn_s_setprio(1); _Pragma("unroll") for (int m = 0; m < 4; ++m) _Pragma("unroll") for (int n = 0; n < 2; ++n) _Pragma("unroll") for (int k = 0; k < 2; ++k) \
        acc[ai][bj][m][n] = SWAP ? __builtin_amdgcn_mfma_f32_16x16x32_bf16(At[m][k], Bt[n][k], acc[ai][bj][m][n], 0, 0, 0) : __builtin_amdgcn_mfma_f32_16x16x32_bf16(Bt[n][k], At[m][k], acc[ai][bj][m][n], 0, 0, 0); __builtin_amdgcn_s_setprio(0); } while (0)
#define PG8_WAIT_V(n) asm volatile("s_waitcnt vmcnt(" #n ")" ::: "memory")
#define PG8_WAIT_L(n) asm volatile("s_waitcnt lgkmcnt(" #n ")" ::: "memory")
#define PG8_BAR __builtin_amdgcn_s_barrier()
#define PG8_SCHED __builtin_amdgcn_sched_barrier(0)
    Unit cur, nxt; int ui = 0;
    if (!S.next(0, cur)) return;
    Acc acc;
#pragma unroll
    for (int a = 0; a < 2; ++a)
#pragma unroll
        for (int b = 0; b < 2; ++b)
#pragma unroll
            for (int m = 0; m < 4; ++m)
#pragma unroll
                for (int n = 0; n < 2; ++n) acc[a][b][m][n] = (f32x4){0.f, 0.f, 0.f, 0.f};
    bf16x8 At[4][2], B0[2][2], B1[2][2];
    const char* cA = (const char*)g.A + (size_t)cur.pm * tstepA; const char* cB = (const char*)g.Bt + (size_t)cur.pn * tstepB;
    if constexpr (SP2) {
        PG8_STAGE(PG8_SB(0, 0), cB, voffB); PG8_STAGE(PG8_SB(0, 1), cB + hstepB, voffB1); PG8_STAGE(PG8_SA(0, 0), cA, voffA); PG8_STAGE(PG8_SA(0, 1), cA + hstepA, voffA);
        if (wr == 1) PG8_BAR;
        PG8_WAIT_V(2); PG8_BAR;
        PG8_STAGE(PG8_SB(1, 0), cB + kstep, voffB); PG8_STAGE(PG8_SA(1, 0), cA + kstep, voffA); PG8_STAGE(PG8_SB(1, 1), cB + hstepB + kstep, voffB1);
        PG8_WAIT_V(6); PG8_BAR;
    } else {
        PG8_STAGE(PG8_SB(0, 0), cB, voffB); PG8_STAGE(PG8_SA(0, 0), cA, voffA); PG8_STAGE(PG8_SB(0, 1), cB + hstepB, voffB1); PG8_STAGE(PG8_SA(0, 1), cA + hstepA, voffA);
        if (wr == 1) PG8_BAR;
        PG8_WAIT_V(4); PG8_BAR;
        PG8_STAGE(PG8_SB(1, 0), cB + kstep, voffB); PG8_STAGE(PG8_SA(1, 0), cA + kstep, voffA); PG8_STAGE(PG8_SB(1, 1), cB + hstepB + kstep, voffB1);
        PG8_WAIT_V(6); PG8_BAR;
    }
    for (;;) {
        const bool has_next = S.next(ui + 1, nxt);
        const char* nA = has_next ? (const char*)g.A + (size_t)nxt.pm * tstepA : cA; const char* nB = has_next ? (const char*)g.Bt + (size_t)nxt.pn * tstepB : cB;
        for (int t = 0; t < nt; t += 2) {
            const bool last = (t == nt - 2);
            const char* a1 = cA + (size_t)(t + 1) * kstep;
            const char* a2 = last ? nA : cA + (size_t)(t + 2) * kstep; const char* b2 = last ? nB : cB + (size_t)(t + 2) * kstep;
            const char* a3 = a2 + kstep; const char* b3 = b2 + kstep;
            if constexpr (Epi::HAS_MID) { if (t == Epi::MID_T) E.mid(acc, cur, wr, wc, fr, fq); }
            if constexpr (SP2) {
            PG8_LDB(B0, 0, 0); PG8_LDB(B1, 0, 1); PG8_SCHED; PG8_LDA(At, 0, 0); PG8_STAGE(PG8_SA(1, 1), a1 + hstepA, voffA);
            PG8_WAIT_V(8); PG8_WAIT_L(0); PG8_BAR; PG8_MMA(0, 0, At, B0); PG8_MMA(0, 1, At, B1); PG8_BAR; PG8_SCHED;
            PG8_LDA(At, 0, 1); PG8_STAGE(PG8_SB(0, 0), b2, voffB); PG8_STAGE(PG8_SB(0, 1), b2 + hstepB, voffB1); PG8_STAGE(PG8_SA(0, 0), a2, voffA);
            PG8_WAIT_V(8); PG8_WAIT_L(0); PG8_BAR; PG8_MMA(1, 0, At, B0); PG8_MMA(1, 1, At, B1); PG8_BAR; PG8_SCHED;
            PG8_LDB(B0, 1, 0); PG8_LDB(B1, 1, 1); PG8_SCHED; PG8_LDA(At, 1, 0); PG8_STAGE(PG8_SA(0, 1), a2 + hstepA, voffA);
            PG8_WAIT_V(8); PG8_WAIT_L(0); PG8_BAR; PG8_MMA(0, 0, At, B0); PG8_MMA(0, 1, At, B1); PG8_BAR; PG8_SCHED;
            PG8_LDA(At, 1, 1); PG8_STAGE(PG8_SB(1, 0), b3, voffB); PG8_STAGE(PG8_SB(1, 1), b3 + hstepB, voffB1); PG8_STAGE(PG8_SA(1, 0), a3, voffA);
            PG8_WAIT_V(8); PG8_WAIT_L(0); PG8_BAR; PG8_MMA(1, 0, At, B0); PG8_MMA(1, 1, At, B1); PG8_BAR; PG8_SCHED;
            } else {
            PG8_LDB(B0, 0, 0); PG8_SCHED; PG8_LDA(At, 0, 0); PG8_STAGE(PG8_SA(1, 1), a1 + hstepA, voffA);
            PG8_WAIT_L(8); PG8_BAR; PG8_WAIT_L(0); PG8_MMA(0, 0, At, B0); PG8_BAR; PG8_SCHED;
            PG8_LDB(B1, 0, 1); PG8_STAGE(PG8_SB(0, 0), b2, voffB);
            PG8_BAR; PG8_WAIT_L(0); PG8_MMA(0, 1, At, B1); PG8_BAR;
            PG8_LDA(At, 0, 1); PG8_STAGE(PG8_SA(0, 0), a2, voffA);
            PG8_BAR; PG8_WAIT_L(0); PG8_MMA(1, 0, At, B0); PG8_BAR; PG8_SCHED;
            PG8_STAGE(PG8_SB(0, 1), b2 + hstepB, voffB1);
            PG8_WAIT_V(6); PG8_BAR; PG8_MMA(1, 1, At, B1); PG8_BAR;
            PG8_LDB(B0, 1, 0); PG8_SCHED; PG8_LDA(At, 1, 0); PG8_STAGE(PG8_SA(0, 1), a2 + hstepA, voffA);
            PG8_WAIT_L(8); PG8_BAR; PG8_WAIT_L(0); PG8_MMA(0, 0, At, B0); PG8_BAR; PG8_SCHED;
            PG8_LDB(B1, 1, 1); PG8_STAGE(PG8_SB(1, 0), b3, voffB);
            PG8_BAR; PG8_WAIT_L(0); PG8_MMA(0, 1, At, B1); PG8_BAR;
            PG8_LDA(At, 1, 1); PG8_STAGE(PG8_SA(1, 0), a3, voffA);
            PG8_BAR; PG8_WAIT_L(0); PG8_MMA(1, 0, At, B0); PG8_BAR; PG8_SCHED;
            PG8_STAGE(PG8_SB(1, 1), b3 + hstepB, voffB1);
            PG8_WAIT_V(6); PG8_BAR; PG8_MMA(1, 1, At, B1); PG8_BAR;
            }
        }
        if constexpr (ALIGN_EPI) { if (wr == 0) PG8_BAR; }
        E.fin(acc, cur, wr, wc, fr, fq);
        if (!has_next) break;
#pragma unroll
        for (int a = 0; a < 2; ++a)
#pragma unroll
            for (int b = 0; b < 2; ++b)
#pragma unroll
                for (int m = 0; m < 4; ++m)
#pragma unroll
                    for (int n = 0; n < 2; ++n) acc[a][b][m][n] = (f32x4){0.f, 0.f, 0.f, 0.f};
        cur = nxt; cA = nA; cB = nB; ++ui;
        if constexpr (ALIGN_EPI) { if (wr == 1) PG8_BAR; }
    }
    PG8_WAIT_V(0);
    if constexpr (!ALIGN_EPI) { if (wr == 0) PG8_BAR; }
    PG8_BAR;
#undef PG8_SA
#undef PG8_SB
#undef PG8_STAGE
#undef PG8_LDA
#undef PG8_LDB
#undef PG8_MMA
#undef PG8_WAIT_V
#undef PG8_WAIT_L
#undef PG8_BAR
#undef PG8_SCHED
}

__device__ __forceinline__ f32x4 ror8(const f32x4 v) { f32x4 r;
#pragma unroll
    for (int j = 0; j < 4; ++j) r[j] = __int_as_float(__builtin_amdgcn_update_dpp(0, __float_as_int(v[j]), 0x128, 0xF, 0xF, false));
    return r; }
__device__ __forceinline__ u32x4 ror8u(const u32x4 v) { u32x4 r;
#pragma unroll
    for (int j = 0; j < 4; ++j) r[j] = (unsigned)__builtin_amdgcn_update_dpp(0, (int)v[j], 0x128, 0xF, 0xF, false);
    return r; }
__device__ __forceinline__ void store_pair128(bf16_t* p, int pitch, bool hi, const u32x4 w0, const u32x4 w1) {
    const u32x4 rc = ror8u(hi ? w0 : w1);
    *(u32x4*)p = hi ? rc : w0; *(u32x4*)(p + 8 * (size_t)pitch) = hi ? w1 : rc;
}
struct EpiProj {
    static constexpr bool PERM = true, HAS_MID = false, ADJ = true; static constexpr int MID_T = -1;
    bf16_t* proj; bf16_t* gates; const float* bgate; const float* qgain; const float* kgain; float* kmean; float* X; const f32x2* rope;
    __device__ __forceinline__ void mid(Acc&, const Unit&, int, int, int, int) const {}
    __device__ __forceinline__ void fin(const Acc& acc, const Unit& u, int wr, int wc, int fr, int fq) const {
        asm volatile("" : "+v"(fr), "+v"(fq));
        const bool hi = fr >= 8;
        const int rowl = wr * 64 + fr;
        const int rows = u.pm * BM + wr * 64 + (fr & 7);
        const int colw = u.pn * BM + wc * 64 + 8 * fq;
        const int cols = colw + (hi ? 32 : 0);
        if (u.pn < 2 * RET_QKW / BM) {
            const bool iskr = u.pn >= RET_QKW / BM;
            const float lg2h = __builtin_log2f(1.f - __builtin_amdgcn_exp2f(-5.f - (float)(2 * (u.pn & 1) + (wc >> 1))));
            const int dl = 32 * (wc & 1) + 8 * fq;
            bf16_t* pbase = proj + (size_t)(u.pm * BM + rowl) * DIN + u.pn * BM + 128 * (wc >> 1) + dl;
            const f32x2* rbase = rope + (size_t)((u.pm * BM + rowl) & (SEQ - 1)) * 64 + dl;
#pragma unroll
            for (int ai = 0; ai < 2; ++ai)
#pragma unroll
                for (int m = 0; m < 4; ++m) {
                    bf16_t* p = pbase + (size_t)(ai * HALF + m * 16) * DIN; const f32x4* cs = (const f32x4*)(rbase + (size_t)(ai * HALF + m * 16) * 64);
                    const float ks = iskr ? 0.08838834764831845f * __builtin_amdgcn_exp2f(lg2h * (float)(127 - (rowl + 16 * m))) : 1.f;
#pragma unroll
                    for (int n = 0; n < 2; ++n) { const f32x4 t0 = cs[2 * n], t1 = cs[2 * n + 1]; const f32x4 x1 = acc[ai][0][m][n], x2 = acc[ai][1][m][n];
                        u32x2 lo, hi2;
                        lo.x = pk2((x1[0] * t0[0] - x2[0] * t0[1]) * ks, (x1[1] * t0[2] - x2[1] * t0[3]) * ks); lo.y = pk2((x1[2] * t1[0] - x2[2] * t1[1]) * ks, (x1[3] * t1[2] - x2[3] * t1[3]) * ks);
                        hi2.x = pk2((x1[0] * t0[1] + x2[0] * t0[0]) * ks, (x1[1] * t0[3] + x2[1] * t0[2]) * ks); hi2.y = pk2((x1[2] * t1[1] + x2[2] * t1[0]) * ks, (x1[3] * t1[3] + x2[3] * t1[2]) * ks);
                        *(u32x2*)(p + 4 * n) = lo; *(u32x2*)(p + 64 + 4 * n) = hi2; }
                    asm volatile("" ::: "memory"); }
        } else if (u.pn >= C_QM / BM && u.pn < C_VM / BM) {
            const bool isk = u.pn >= C_KM / BM;
#pragma unroll
            for (int ai = 0; ai < 2; ++ai)
#pragma unroll
                for (int m = 0; m < 4; ++m) { float s = 0.f;
#pragma unroll
                    for (int bj = 0; bj < 2; ++bj) { const f32x4 v0 = acc[ai][bj][m][0], v1 = acc[ai][bj][m][1];
                        s += (v0[0] * v0[0] + v0[1] * v0[1]) + (v0[2] * v0[2] + v0[3] * v0[3]) + (v1[0] * v1[0] + v1[1] * v1[1]) + (v1[2] * v1[2] + v1[3] * v1[3]); }
                    s += __shfl_xor(s, 16); s += __shfl_xor(s, 32);
                    if (fq == 0) X[(ai * HALF + m * 16 + rowl) * 4 + wc] = s; }
            asm volatile("s_waitcnt lgkmcnt(0)" ::: "memory"); __builtin_amdgcn_s_barrier(); asm volatile("" ::: "memory");
            const int dw = (wc & 1) * 64 + 8 * fq;
            const float* gp = (isk ? kgain : qgain) + dw;
            f32x4 g[2][2];
#pragma unroll
            for (int bj = 0; bj < 2; ++bj) { g[bj][0] = *(const f32x4*)(gp + 32 * bj); g[bj][1] = *(const f32x4*)(gp + 32 * bj + 4); }
            f32x4 cs[2][2];
#pragma unroll
            for (int bj = 0; bj < 2; ++bj) { cs[bj][0] = (f32x4){0.f, 0.f, 0.f, 0.f}; cs[bj][1] = (f32x4){0.f, 0.f, 0.f, 0.f}; }
#pragma unroll
            for (int ai = 0; ai < 2; ++ai)
#pragma unroll
                for (int m = 0; m < 4; ++m) { const f32x2 p = *(const f32x2*)(X + (ai * HALF + m * 16 + rowl) * 4 + (wc & 2));
                    const float rstd = 1.f / sqrtf((p[0] + p[1]) * (1.f / 128.f) + EPS);
                    u32x4 w[2];
#pragma unroll
                    for (int bj = 0; bj < 2; ++bj) { const f32x4 v0 = acc[ai][bj][m][0] * rstd * g[bj][0], v1 = acc[ai][bj][m][1] * rstd * g[bj][1]; cs[bj][0] += v0; cs[bj][1] += v1;
                        w[bj].x = pk2(v0[0], v0[1]); w[bj].y = pk2(v0[2], v0[3]); w[bj].z = pk2(v1[0], v1[1]); w[bj].w = pk2(v1[2], v1[3]); }
                    store_pair128(proj + (size_t)(rows + ai * HALF + m * 16) * DIN + cols, DIN, hi, w[0], w[1]);
                    asm volatile("" : "+v"(cs[0][0]), "+v"(cs[0][1]), "+v"(cs[1][0]), "+v"(cs[1][1])); }
            if (isk) {
#pragma unroll
                for (int bj = 0; bj < 2; ++bj)
#pragma unroll
                    for (int n = 0; n < 2; ++n)
#pragma unroll
                        for (int i = 0; i < 4; ++i) { float s = cs[bj][n][i]; s += __shfl_xor(s, 1); s += __shfl_xor(s, 2); s += __shfl_xor(s, 4); s += __shfl_xor(s, 8); cs[bj][n][i] = s; }
                if (fr == 0) {
                    const int bb = u.pm >> 3, blk = u.pm & 7, head = 2 * (u.pn - C_KM / BM) + (wc >> 1);
                    float* kp = kmean + (((size_t)bb * 8 + head) * 8 + blk) * 128 + dw;
#pragma unroll
                    for (int bj = 0; bj < 2; ++bj)
#pragma unroll
                        for (int n = 0; n < 2; ++n)
#pragma unroll
                            for (int i = 0; i < 4; ++i) atomicAdd(kp + 32 * bj + 4 * n + i, cs[bj][n][i] * (1.f / 256.f));
                }
            }
        } else if (u.pn < DIN / BM) {
#pragma unroll
            for (int ai = 0; ai < 2; ++ai)
#pragma unroll
                for (int m = 0; m < 4; ++m) { u32x4 w[2];
#pragma unroll
                    for (int bj = 0; bj < 2; ++bj) { const f32x4 v0 = acc[ai][bj][m][0], v1 = acc[ai][bj][m][1]; w[bj].x = pk2(v0[0], v0[1]); w[bj].y = pk2(v0[2], v0[3]); w[bj].z = pk2(v1[0], v1[1]); w[bj].w = pk2(v1[2], v1[3]); }
                    store_pair128(proj + (size_t)(rows + ai * HALF + m * 16) * DIN + cols, DIN, hi, w[0], w[1]); }
        } else {
            const int gcw = colw - DIN;
            f32x4 bv[2][2];
#pragma unroll
            for (int bj = 0; bj < 2; ++bj)
#pragma unroll
                for (int n = 0; n < 2; ++n) bv[bj][n] = *(const f32x4*)(bgate + gcw + 32 * bj + 4 * n);
#pragma unroll
            for (int ai = 0; ai < 2; ++ai)
#pragma unroll
                for (int m = 0; m < 4; ++m) { u32x4 w[2];
#pragma unroll
                    for (int bj = 0; bj < 2; ++bj) { const f32x4 v0 = acc[ai][bj][m][0] + bv[bj][0], v1 = acc[ai][bj][m][1] + bv[bj][1];
                        w[bj].x = pk2(fsigmoid(v0[0]), fsigmoid(v0[1])); w[bj].y = pk2(fsigmoid(v0[2]), fsigmoid(v0[3])); w[bj].z = pk2(fsigmoid(v1[0]), fsigmoid(v1[1])); w[bj].w = pk2(fsigmoid(v1[2]), fsigmoid(v1[3])); }
                    store_pair128(gates + (size_t)(rows + ai * HALF + m * 16) * NGATE + (cols - DIN), NGATE, hi, w[0], w[1]); }
        }
    }
};
struct EpiBf16 {
    static constexpr bool PERM = true, HAS_MID = false, ADJ = false; static constexpr int MID_T = -1;
    bf16_t* O; int ldc;
    __device__ __forceinline__ void mid(Acc&, const Unit&, int, int, int, int) const {}
    __device__ __forceinline__ void fin(const Acc& acc, const Unit& u, int wr, int wc, int fr, int fq) const {
        asm volatile("" : "+v"(fr), "+v"(fq));
        const int row0 = u.pm * BM + wr * 64 + fr; const int col0 = u.pn * BM + wc * 32 + 8 * fq;
#pragma unroll
        for (int ai = 0; ai < 2; ++ai)
#pragma unroll
            for (int m = 0; m < 4; ++m) { bf16_t* rowp = O + (size_t)(row0 + ai * HALF + m * 16) * ldc + col0;
#pragma unroll
                for (int bj = 0; bj < 2; ++bj) { const f32x4 v0 = acc[ai][bj][m][0], v1 = acc[ai][bj][m][1]; u32x4 w; w.x = pk2(v0[0], v0[1]); w.y = pk2(v0[2], v0[3]); w.z = pk2(v1[0], v1[1]); w.w = pk2(v1[2], v1[3]);
                    *(u32x4*)(rowp + bj * HALF) = w; } }
    }
};
struct EpiMerge {
    static constexpr bool PERM = true, HAS_MID = true, ADJ = true; static constexpr int MID_T = 16;
    const bf16_t* gates; bf16_t* O;
    static __device__ __forceinline__ void unswap(bool hi, const u32x4 l1, const u32x4 l2, u32x4& b0, u32x4& b1) { const u32x4 rc = ror8u(hi ? l1 : l2); b0 = hi ? rc : l1; b1 = hi ? l2 : rc; }
    __device__ __forceinline__ void mid(Acc& acc, const Unit& u, int wr, int wc, int fr, int fq) const {
        asm volatile("" : "+v"(fr), "+v"(fq));
        const bool hi = fr >= 8;
        const bf16_t* gbase = gates + (size_t)(u.pm * BM + wr * 64 + (fr & 7)) * NGATE + u.pn * BM + wc * 64 + 8 * fq + (hi ? 32 : 0);
#pragma unroll
        for (int ai = 0; ai < 2; ++ai) {
            u32x4 r1[4], r2[4], m1[4], m2[4];
#pragma unroll
            for (int m = 0; m < 4; ++m) { const bf16_t* gp = gbase + (size_t)(ai * HALF + m * 16) * NGATE;
                r1[m] = *(const u32x4*)gp; r2[m] = *(const u32x4*)(gp + 8 * NGATE); m1[m] = *(const u32x4*)(gp + DM); m2[m] = *(const u32x4*)(gp + 8 * NGATE + DM); }
#pragma unroll
            for (int m = 0; m < 4; ++m) { u32x4 gr[2], gm[2]; unswap(hi, r1[m], r2[m], gr[0], gr[1]); unswap(hi, m1[m], m2[m], gm[0], gm[1]);
#pragma unroll
                for (int bj = 0; bj < 2; ++bj) { float a[8], b[8]; unpack8(gr[bj], a); unpack8(gm[bj], b);
                    f32x4 q0, q1;
#pragma unroll
                    for (int j = 0; j < 4; ++j) { q0[j] = a[j] * __builtin_amdgcn_rcpf(fmaxf(b[j], 1e-30f)); q1[j] = a[4 + j] * __builtin_amdgcn_rcpf(fmaxf(b[4 + j], 1e-30f)); }
                    acc[ai][bj][m][0] *= q0; acc[ai][bj][m][1] *= q1; } }
            asm volatile("" ::: "memory");
        }
    }
    __device__ __forceinline__ void fin(const Acc& acc, const Unit& u, int wr, int wc, int fr, int fq) const {
        asm volatile("" : "+v"(fr), "+v"(fq));
        const bool hi = fr >= 8;
        const size_t rs = (size_t)(u.pm * BM + wr * 64 + (fr & 7)); const int cs = u.pn * BM + wc * 64 + 8 * fq + (hi ? 32 : 0);
#pragma unroll
        for (int ai = 0; ai < 2; ++ai)
#pragma unroll
            for (int m = 0; m < 4; ++m) { const size_t r = rs + ai * HALF + m * 16; const bf16_t* gp = gates + r * NGATE + DM + cs;
                u32x4 gm[2]; unswap(hi, *(const u32x4*)gp, *(const u32x4*)(gp + 8 * NGATE), gm[0], gm[1]);
                u32x4 w[2];
#pragma unroll
                for (int bj = 0; bj < 2; ++bj) { float b[8]; unpack8(gm[bj], b); const f32x4 v0 = acc[ai][bj][m][0], v1 = acc[ai][bj][m][1];
                    w[bj].x = pk2(v0[0] * b[0], v0[1] * b[1]); w[bj].y = pk2(v0[2] * b[2], v0[3] * b[3]); w[bj].z = pk2(v1[0] * b[4], v1[1] * b[5]); w[bj].w = pk2(v1[2] * b[6], v1[3] * b[7]); }
                store_pair128(O + r * DM + cs, DM, hi, w[0], w[1]); }
    }
};
struct EpiResid {
    static constexpr bool PERM = false, HAS_MID = false, ADJ = false; static constexpr int MID_T = -1;
    const bf16_t* base; float* out;
    __device__ __forceinline__ void mid(Acc&, const Unit&, int, int, int, int) const {}
    __device__ __forceinline__ void fin(const Acc& acc, const Unit& u, int wr, int wc, int fr, int fq) const {
        asm volatile("" : "+v"(fr), "+v"(fq));
        const bool hi = fr >= 8;
        const int row0 = u.pm * BM + wr * 64 + (fr & 7); const int col0 = u.pn * BM + wc * 32 + (hi ? 16 : 0) + 4 * fq;
#pragma unroll
        for (int ai = 0; ai < 2; ++ai)
#pragma unroll
            for (int m = 0; m < 4; ++m) { const size_t off = (size_t)(row0 + ai * HALF + m * 16) * DM + col0;
#pragma unroll
                for (int bj = 0; bj < 2; ++bj) { const f32x4 a0 = acc[ai][bj][m][0], a1 = acc[ai][bj][m][1]; const f32x4 rc = ror8(hi ? a0 : a1);
                    const f32x4 first = hi ? rc : a0, second = hi ? a1 : rc;
                    const u32x2 p1 = *(const u32x2*)(base + off + bj * HALF), p2 = *(const u32x2*)(base + off + 8 * DM + bj * HALF);
                    const f32x4 b1 = (f32x4){bflo(p1.x), bfhi(p1.x), bflo(p1.y), bfhi(p1.y)}, b2 = (f32x4){bflo(p2.x), bfhi(p2.x), bflo(p2.y), bfhi(p2.y)};
                    *(f32x4*)(out + off + bj * HALF) = b1 + first; *(f32x4*)(out + off + 8 * DM + bj * HALF) = b2 + second; } }
    }
};

struct EpiConv {
    static constexpr bool PERM = false, HAS_MID = false, ADJ = false; static constexpr int MID_T = -1;
    bf16_t* act; float* UH; const float* cw; const float* cb; f32x2* X; const float* rstd;
    __device__ __forceinline__ void mid(Acc&, const Unit&, int, int, int, int) const {}
    __device__ __forceinline__ void fin(Acc& acc, const Unit& u, int wr, int wc, int fr, int fq) const {
        asm volatile("" : "+v"(fr), "+v"(fq));
        const int lane = fr + 16 * fq, src_lane = (lane - 16) & 63;
#pragma unroll
        for (int ai = 0; ai < 2; ++ai)
#pragma unroll
            for (int m = 0; m < 4; ++m) { const f32x4 rs = *(const f32x4*)(rstd + u.pm * BM + ai * HALF + wr * 64 + 16 * m + 4 * fq);
#pragma unroll
                for (int bj = 0; bj < 2; ++bj)
#pragma unroll
                    for (int n = 0; n < 2; ++n) acc[ai][bj][m][n] *= rs; }
        if (fq == 3) {
#pragma unroll
            for (int ai = 0; ai < 2; ++ai)
#pragma unroll
                for (int bj = 0; bj < 2; ++bj)
#pragma unroll
                    for (int n = 0; n < 2; ++n) X[((((ai * 2 + wr) * 2 + bj) * 4 + wc) * 2 + n) * 16 + fr] = (f32x2){acc[ai][bj][3][n][2], acc[ai][bj][3][n][3]};
        }
        {
            const int colt = u.pn * BM + wc * 32 + fr;
            if (wr == 0 && fq == 0) {
#pragma unroll
                for (int bj = 0; bj < 2; ++bj)
#pragma unroll
                    for (int n = 0; n < 2; ++n) { UH[((size_t)u.pm * 4 + 0) * NUP + colt + bj * HALF + n * 16] = acc[0][bj][0][n][0]; UH[((size_t)u.pm * 4 + 1) * NUP + colt + bj * HALF + n * 16] = acc[0][bj][0][n][1]; }
            }
            if (wr == 1 && fq == 3) {
#pragma unroll
                for (int bj = 0; bj < 2; ++bj)
#pragma unroll
                    for (int n = 0; n < 2; ++n) { UH[((size_t)u.pm * 4 + 2) * NUP + colt + bj * HALF + n * 16] = acc[1][bj][3][n][2]; UH[((size_t)u.pm * 4 + 3) * NUP + colt + bj * HALF + n * 16] = acc[1][bj][3][n][3]; }
            }
        }
        asm volatile("s_waitcnt lgkmcnt(0)" ::: "memory"); __builtin_amdgcn_s_barrier(); asm volatile("" ::: "memory");
#pragma unroll
        for (int n = 0; n < 2; ++n) {
            const int c = u.pn * HALF + wc * 32 + n * 16 + fr;
            const float gb = cb[c], g0 = cw[c], g1 = cw[NUP + c], g2 = cw[2 * NUP + c];
            const float vb = cb[DFF + c], v0 = cw[DFF + c], v1 = cw[NUP + DFF + c], v2 = cw[2 * NUP + DFF + c];
#pragma unroll
            for (int ai = 0; ai < 2; ++ai) {
                f32x2 xg = (f32x2){0.f, 0.f}, xv = (f32x2){0.f, 0.f};
                if (!(ai == 0 && wr == 0)) { const int sa = wr ? ai : ai - 1, sw = wr ? 0 : 1;
                    xg = X[((((sa * 2 + sw) * 2 + 0) * 4 + wc) * 2 + n) * 16 + fr]; xv = X[((((sa * 2 + sw) * 2 + 1) * 4 + wc) * 2 + n) * 16 + fr]; }
                bf16_t* ap = act + (size_t)(u.pm * BM + ai * HALF + wr * 64 + 4 * fq) * DFF + c;
#pragma unroll
                for (int m = 0; m < 4; ++m) {
                    const f32x4 a = acc[ai][0][m][n], b = acc[ai][1][m][n];
                    const f32x4 pa = acc[ai][0][m > 0 ? m - 1 : 0][n], pb = acc[ai][1][m > 0 ? m - 1 : 0][n];
                    const bool up = (fq == 3) && (m > 0);
                    float a2 = __shfl(up ? pa[2] : a[2], src_lane), a1 = __shfl(up ? pa[3] : a[3], src_lane);
                    float b2 = __shfl(up ? pb[2] : b[2], src_lane), b1 = __shfl(up ? pb[3] : b[3], src_lane);
                    if (m == 0 && fq == 0) { a2 = xg.x; a1 = xg.y; b2 = xv.x; b1 = xv.y; }
                    const float og0 = gb + g0 * a2 + g1 * a1 + g2 * a[0], og1 = gb + g0 * a1 + g1 * a[0] + g2 * a[1], og2 = gb + g0 * a[0] + g1 * a[1] + g2 * a[2], og3 = gb + g0 * a[1] + g1 * a[2] + g2 * a[3];
                    const float ov0 = vb + v0 * b2 + v1 * b1 + v2 * b[0], ov1 = vb + v0 * b1 + v1 * b[0] + v2 * b[1], ov2 = vb + v0 * b[0] + v1 * b[1] + v2 * b[2], ov3 = vb + v0 * b[1] + v1 * b[2] + v2 * b[3];
                    const unsigned w01 = pk2(og0 * fsigmoid(og0) * ov0, og1 * fsigmoid(og1) * ov1), w23 = pk2(og2 * fsigmoid(og2) * ov2, og3 * fsigmoid(og3) * ov3);
                    bf16_t* rp = ap + (size_t)(16 * m) * DFF;
                    rp[0] = (bf16_t)(w01 & 0xffffu); rp[DFF] = (bf16_t)(w01 >> 16); rp[2 * DFF] = (bf16_t)(w23 & 0xffffu); rp[3 * DFF] = (bf16_t)(w23 >> 16);
                }
            }
        }
    }
};

struct EpiResidNorm {
    static constexpr bool PERM = false, HAS_MID = false, ADJ = false; static constexpr int MID_T = -1;
    const float* base; bf16_t* xb; float* ss;
    __device__ __forceinline__ void mid(Acc&, const Unit&, int, int, int, int) const {}
    __device__ __forceinline__ void fin(const Acc& acc, const Unit& u, int wr, int wc, int fr, int fq) const {
        asm volatile("" : "+v"(fr), "+v"(fq));
        const bool hi = fr >= 8;
        const int row0 = u.pm * BM + wr * 64 + (fr & 7); const int col0 = u.pn * BM + wc * 32 + (hi ? 16 : 0) + 4 * fq;
#pragma unroll
        for (int ai = 0; ai < 2; ++ai)
#pragma unroll
            for (int m = 0; m < 4; ++m) { const int row = row0 + ai * HALF + m * 16; const size_t off = (size_t)row * DM + col0; float s1 = 0.f, s2 = 0.f;
#pragma unroll
                for (int bj = 0; bj < 2; ++bj) { const f32x4 a0 = acc[ai][bj][m][0], a1 = acc[ai][bj][m][1]; const f32x4 rc = ror8(hi ? a0 : a1);
                    const f32x4 first = hi ? rc : a0, second = hi ? a1 : rc;
                    const f32x4 v1 = *(const f32x4*)(base + off + bj * HALF) + first, v2 = *(const f32x4*)(base + off + 8 * DM + bj * HALF) + second;
                    s1 += (v1[0] * v1[0] + v1[1] * v1[1]) + (v1[2] * v1[2] + v1[3] * v1[3]); s2 += (v2[0] * v2[0] + v2[1] * v2[1]) + (v2[2] * v2[2] + v2[3] * v2[3]);
                    u32x2 w1; w1.x = pk2(v1[0], v1[1]); w1.y = pk2(v1[2], v1[3]); *(u32x2*)(xb + off + bj * HALF) = w1;
                    u32x2 w2; w2.x = pk2(v2[0], v2[1]); w2.y = pk2(v2[2], v2[3]); *(u32x2*)(xb + off + 8 * DM + bj * HALF) = w2; }
                s1 += __shfl_xor(s1, 8); s1 += __shfl_xor(s1, 16); s1 += __shfl_xor(s1, 32); s2 += __shfl_xor(s2, 8); s2 += __shfl_xor(s2, 16); s2 += __shfl_xor(s2, 32);
                if (fq == 0 && !hi) { ss[(size_t)row * 16 + u.pn * 4 + wc] = s1; ss[(size_t)(row + 8) * 16 + u.pn * 4 + wc] = s2; } }
    }
};
}

__device__ __forceinline__ float wave_sum(float v) {
#pragma unroll
    for (int o = 1; o < 64; o <<= 1) v += __shfl_xor(v, o);
    return v;
}
template <int UPPERM = 0>
__device__ __forceinline__ void transpose_item(const float* W, int K, int N, bf16_t* WT, int ldt, int row_off, int col_off, float* scr, int item, int lane, const float* kgain = nullptr) {
    const int nblk = N / 32, kb = item / nblk, nb = item % nblk, k0 = 64 * kb, n0 = 32 * nb;
    int d0 = n0;
    if (UPPERM == 1) { const int isv = n0 >= DFF ? 1 : 0, c = n0 - isv * DFF; d0 = 256 * (c >> 7) + 128 * isv + (c & 127); }
    if (UPPERM == 2) { if (n0 < 2 * RET_QKW) { const int dd = n0 & 127; d0 = (n0 & ~127) + 64 * ((dd & 63) >> 5) + 32 * (dd >> 6); } }
    float wv[32];
#pragma unroll
    for (int i = 0; i < 32; ++i) { const int kk = 2 * i + (lane >> 5); wv[i] = __builtin_nontemporal_load(&W[(size_t)(k0 + kk) * N + n0 + (lane & 31)]); }
    if (kgain) {
#pragma unroll
        for (int i = 0; i < 32; ++i) wv[i] *= kgain[k0 + 2 * i + (lane >> 5)];
    }
#pragma unroll
    for (int i = 0; i < 32; ++i) scr[(2 * i + (lane >> 5)) * 33 + (lane & 31)] = wv[i];
    LDS_WAIT();
    const int c = lane & 7;
#pragma unroll
    for (int j = 0; j < 4; ++j) { const int n = (lane >> 3) + 8 * j; const float* s = scr + (8 * c) * 33 + n;
        u32x4 o; o.x = pk2(s[0 * 33], s[1 * 33]); o.y = pk2(s[2 * 33], s[3 * 33]); o.z = pk2(s[4 * 33], s[5 * 33]); o.w = pk2(s[6 * 33], s[7 * 33]);
        *(u32x4*)(WT + (size_t)(row_off + d0 + n) * ldt + col_off + k0 + 8 * c) = o; }
    LDS_WAIT();
}
__device__ __forceinline__ void rms_row_to_bf16(const float* xrow, const float* gain, bf16_t* orow, int lane) {
    const f32x4* xr = (const f32x4*)xrow + lane; const f32x4* gr = (const f32x4*)gain + lane;
    f32x4 v[4]; float s = 0.f;
#pragma unroll
    for (int j = 0; j < 4; ++j) { v[j] = xr[64 * j]; s += (v[j].x * v[j].x + v[j].y * v[j].y) + (v[j].z * v[j].z + v[j].w * v[j].w); }
    const float rstd = 1.f / sqrtf(wave_sum(s) * (1.f / DM) + EPS);
    u32x2* o8 = (u32x2*)orow + lane;
#pragma unroll
    for (int j = 0; j < 4; ++j) { const f32x4 gg = gr[64 * j]; u32x2 w; w.x = pk2(v[j].x * rstd * gg.x, v[j].y * rstd * gg.y); w.y = pk2(v[j].z * rstd * gg.z, v[j].w * rstd * gg.w); o8[64 * j] = w; }
}

__device__ __forceinline__ void retention_item(unsigned char* lds, bf16_t* proj, const f32x2* rope, f32x2* stats, int b, int h, int sl, bf16_t* dry = nullptr) {
    int tid_ = threadIdx.x; asm volatile("" : "+v"(tid_));
    const int tid = tid_, lane = tid & 63, w = __builtin_amdgcn_readfirstlane(tid >> 6), l15 = lane & 15, quad = lane >> 4;
    constexpr int P = 136, VPR = 96;
    bf16_t* Qs = (bf16_t*)lds;
    bf16_t* Kz = Qs + 128 * P;
    bf16_t* Vs = Kz + 128 * P;
    bf16_t* RsT = Vs + 128 * VPR;
    const float lg2 = __builtin_log2f(1.f - __builtin_amdgcn_exp2f(-5.f - (float)h));
    const float gamma_c = __builtin_amdgcn_exp2f(lg2 * 128.f);
    const float kscale = 0.08838834764831845f;
    for (int i = tid; i < 64 * P / 2; i += 512) ((unsigned*)RsT)[i] = 0u;
    f32x4 accR[4];
#pragma unroll
    for (int i = 0; i < 4; ++i) accR[i] = (f32x4){0.f, 0.f, 0.f, 0.f};
    const size_t rowbase = (size_t)b * SEQ;
    u32x4 rq1[2], rq2[2], rk1[2], rk2[2], rv[2];
#define RET_LOAD(n_) do { _Pragma("unroll") for (int k_ = 0; k_ < 2; ++k_) { const int i_ = tid + 512 * k_, r_ = i_ >> 3, g_ = i_ & 7; \
        const bf16_t* qp_ = proj + (rowbase + (n_) * 128 + r_) * DIN + C_QR + h * 128 + 8 * g_; \
        rq1[k_] = *(const u32x4*)qp_; rq2[k_] = *(const u32x4*)(qp_ + 64); rk1[k_] = *(const u32x4*)(qp_ + C_KR); rk2[k_] = *(const u32x4*)(qp_ + C_KR + 64); \
        rv[k_] = *(const u32x4*)(proj + (rowbase + (n_) * 128 + r_) * DIN + C_VR + h * 256 + sl * 64 + 8 * g_); } } while (0)
    RET_LOAD(0);
    const LAS bf16_t* VsL = (const LAS bf16_t*)Vs; const LAS bf16_t* KzL = (const LAS bf16_t*)Kz;
    const int trr = l15 >> 2, trc = 4 * (l15 & 3);
    for (int n = 0; n < 16; ++n) {
        const int t0 = n * 128;
#pragma unroll
        for (int k = 0; k < 2; ++k) {
            const int i = tid + 512 * k, r = i >> 3, g8 = i & 7;
            *(u32x4*)(Qs + r * P + 8 * g8) = rq1[k]; *(u32x4*)(Qs + r * P + 64 + 8 * g8) = rq2[k];
            *(u32x4*)(Kz + r * P + 8 * g8) = rk1[k]; *(u32x4*)(Kz + r * P + 64 + 8 * g8) = rk2[k];
            *(u32x4*)(Vs + r * VPR + 8 * g8) = rv[k];
        }
        __syncthreads();
        if (n + 1 < 16) RET_LOAD(n + 1);
        bf16x8 qf[4];
#pragma unroll
        for (int s = 0; s < 4; ++s) qf[s] = *(const bf16x8*)(Qs + (16 * w + l15) * P + 32 * s + 8 * quad);
        u32x4 pf[4];
#pragma unroll
        for (int s = 0; s < 4; ++s) pf[s] = (u32x4){0u, 0u, 0u, 0u};
        const int qpos = 16 * w + l15;
        const float qfac = __builtin_amdgcn_exp2f(lg2 * (float)(qpos - 127));
#pragma unroll
        for (int kb = 0; kb < 8; ++kb) {
            if (kb <= w) {
                f32x4 a = (f32x4){0.f, 0.f, 0.f, 0.f};
#pragma unroll
                for (int s = 0; s < 4; ++s) { const bf16x8 kf = *(const bf16x8*)(Kz + (16 * kb + l15) * P + 32 * s + 8 * quad); a = __builtin_amdgcn_mfma_f32_16x16x32_bf16(kf, qf[s], a, 0, 0, 0); }
                float pv[4];
#pragma unroll
                for (int i = 0; i < 4; ++i) pv[i] = (qpos >= 16 * kb + 4 * quad + i) ? a[i] * qfac : 0.f;
                if (kb & 1) { pf[kb >> 1].z = pk2(pv[0], pv[1]); pf[kb >> 1].w = pk2(pv[2], pv[3]); } else { pf[kb >> 1].x = pk2(pv[0], pv[1]); pf[kb >> 1].y = pk2(pv[2], pv[3]); }
            }
        }
        f32x4 ao[4], ac[4];
#pragma unroll
        for (int i = 0; i < 4; ++i) { ao[i] = (f32x4){0.f, 0.f, 0.f, 0.f}; ac[i] = (f32x4){0.f, 0.f, 0.f, 0.f}; }
#pragma unroll
        for (int s2 = 0; s2 < 4; ++s2) {
            if (2 * s2 <= w) {
#pragma unroll
                for (int dvb = 0; dvb < 4; ++dvb) { const LAS bf16_t* vp = VsL + (32 * s2 + 4 * quad + trr) * VPR + 16 * dvb + trc;
                    const s16x4 lo = __builtin_amdgcn_ds_read_tr16_b64_v4i16((LAS s16x4*)vp), hi = __builtin_amdgcn_ds_read_tr16_b64_v4i16((LAS s16x4*)(vp + 16 * VPR));
                    const bf16x8 va = __builtin_shufflevector(lo, hi, 0, 1, 2, 3, 4, 5, 6, 7);
                    ao[dvb] = __builtin_amdgcn_mfma_f32_16x16x32_bf16(va, __builtin_bit_cast(bf16x8, pf[s2]), ao[dvb], 0, 0, 0); }
            }
        }
#pragma unroll
        for (int s = 0; s < 4; ++s)
#pragma unroll
            for (int dvb = 0; dvb < 4; ++dvb) { const bf16x8 ra = *(const bf16x8*)(RsT + (16 * dvb + l15) * P + 32 * s + 8 * quad); ac[dvb] = __builtin_amdgcn_mfma_f32_16x16x32_bf16(ra, qf[s], ac[dvb], 0, 0, 0); }
        const float xi = __builtin_amdgcn_exp2f(lg2 * (float)(qpos + 1));
        float s1 = 0.f, s2s = 0.f;
        bf16_t* op = dry ? dry + tid * 128 : proj + (rowbase + t0 + qpos) * DIN + C_VR + h * 256 + sl * 64 + 4 * quad;
#pragma unroll
        for (int dvb = 0; dvb < 4; ++dvb) { const f32x4 o = ao[dvb] + ac[dvb] * xi; s1 += (o[0] + o[1]) + (o[2] + o[3]); s2s += (o[0] * o[0] + o[1] * o[1]) + (o[2] * o[2] + o[3] * o[3]);
            u32x2 wv; wv.x = pk2(o[0], o[1]); wv.y = pk2(o[2], o[3]); *(u32x2*)(op + 16 * dvb) = wv; }
        s1 += __shfl_xor(s1, 16); s1 += __shfl_xor(s1, 32); s2s += __shfl_xor(s2s, 16); s2s += __shfl_xor(s2s, 32);
        if (quad == 0) { if (dry) ((f32x2*)dry)[65536 + tid] = (f32x2){s1, s2s}; else stats[((rowbase + t0 + qpos) * 4 + h) * 4 + sl] = (f32x2){s1, s2s}; }
#pragma unroll
        for (int dvb = 0; dvb < 4; ++dvb) accR[dvb] *= gamma_c;
#pragma unroll
        for (int s = 0; s < 4; ++s) { const LAS bf16_t* kp = KzL + (32 * s + 8 * quad + trr) * P + 16 * w + trc;
            const s16x4 klo = __builtin_amdgcn_ds_read_tr16_b64_v4i16((LAS s16x4*)kp), khi = __builtin_amdgcn_ds_read_tr16_b64_v4i16((LAS s16x4*)(kp + 4 * P));
            const bf16x8 ka = __builtin_shufflevector(klo, khi, 0, 1, 2, 3, 4, 5, 6, 7);
#pragma unroll
            for (int dvb = 0; dvb < 4; ++dvb) { const LAS bf16_t* vp = VsL + (32 * s + 8 * quad + trr) * VPR + 16 * dvb + trc;
                const s16x4 vlo = __builtin_amdgcn_ds_read_tr16_b64_v4i16((LAS s16x4*)vp), vhi = __builtin_amdgcn_ds_read_tr16_b64_v4i16((LAS s16x4*)(vp + 4 * VPR));
                const bf16x8 vb = __builtin_shufflevector(vlo, vhi, 0, 1, 2, 3, 4, 5, 6, 7);
                accR[dvb] = __builtin_amdgcn_mfma_f32_16x16x32_bf16(ka, vb, accR[dvb], 0, 0, 0); } }
        __syncthreads();
#pragma unroll
        for (int dvb = 0; dvb < 4; ++dvb) { u32x2 wv; wv.x = pk2(accR[dvb][0], accR[dvb][1]); wv.y = pk2(accR[dvb][2], accR[dvb][3]); *(u32x2*)(RsT + (16 * dvb + l15) * P + 16 * w + 4 * quad) = wv; }
    }
#undef RET_LOAD
    __syncthreads();
}

__device__ __forceinline__ void knorm_item(unsigned char* lds, bf16_t* proj, const float* kgain, float* kmean, int b, int h, int blk) {
    const int tid = threadIdx.x, lane = tid & 63, w = __builtin_amdgcn_readfirstlane(tid >> 6), l15 = lane & 15, quad = lane >> 4;
    float* red = (float*)lds;
    float csum[8], gn[8];
#pragma unroll
    for (int j = 0; j < 8; ++j) { csum[j] = 0.f; gn[j] = kgain[8 * l15 + j]; }
    for (int st = 0; st < 8; ++st) {
        const int r = 32 * w + 4 * st + quad;
        bf16_t* p = proj + ((size_t)b * SEQ + blk * 256 + r) * DIN + C_KM + h * 128 + 8 * l15;
        const u32x4 v = *(const u32x4*)p; float f[8]; unpack8(v, f);
        float ss = 0.f;
#pragma unroll
        for (int j = 0; j < 8; ++j) ss += f[j] * f[j];
        ss += __shfl_xor(ss, 1); ss += __shfl_xor(ss, 2); ss += __shfl_xor(ss, 4); ss += __shfl_xor(ss, 8);
        const float rstd = 1.f / sqrtf(ss * (1.f / 128.f) + EPS);
#pragma unroll
        for (int j = 0; j < 8; ++j) { f[j] = f[j] * rstd * gn[j]; csum[j] += f[j]; }
        *(u32x4*)p = pack8(f);
    }
#pragma unroll
    for (int j = 0; j < 8; ++j) { csum[j] += __shfl_xor(csum[j], 16); csum[j] += __shfl_xor(csum[j], 32); }
    if (quad == 0) {
#pragma unroll
        for (int j = 0; j < 8; ++j) red[w * 128 + 8 * l15 + j] = csum[j];
    }
    __syncthreads();
    if (tid < 128) { float s = 0.f;
#pragma unroll
        for (int k = 0; k < 8; ++k) s += red[k * 128 + tid];
        kmean[(((size_t)b * 8 + h) * 8 + blk) * 128 + tid] = s * (1.f / 256.f); }
    __syncthreads();
}
__device__ __forceinline__ void qnorm_rows(bf16_t* proj, const float* qgain, int row4, int lane) {
    const int l15 = lane & 15, quad = lane >> 4;
    float gn[8];
#pragma unroll
    for (int j = 0; j < 8; ++j) gn[j] = qgain[8 * l15 + j];
    bf16_t* base = proj + (size_t)(4 * row4 + quad) * DIN + C_QM + 8 * l15;
#pragma unroll
    for (int hh = 0; hh < 8; ++hh) {
        bf16_t* p = base + hh * 128;
        const u32x4 v = *(const u32x4*)p; float f[8]; unpack8(v, f);
        float ss = 0.f;
#pragma unroll
        for (int j = 0; j < 8; ++j) ss += f[j] * f[j];
        ss += __shfl_xor(ss, 1); ss += __shfl_xor(ss, 2); ss += __shfl_xor(ss, 4); ss += __shfl_xor(ss, 8);
        const float rstd = 1.f / sqrtf(ss * (1.f / 128.f) + EPS);
#pragma unroll
        for (int j = 0; j < 8; ++j) f[j] = f[j] * rstd * gn[j];
        *(u32x4*)p = pack8(f);
    }
}
__device__ __forceinline__ void vtrans_item(bf16_t* T, const bf16_t* proj, bf16_t* Vt, int item, int lane) {
    const int dh = item & 1, st = (item >> 1) & 31, h = (item >> 6) & 7, b = item >> 9;
    const bf16_t* src = proj + ((size_t)b * SEQ + 64 * st + lane) * DIN + C_VM + h * 128 + 64 * dh;
#pragma unroll
    for (int c = 0; c < 8; ++c) { const u32x4 v = *(const u32x4*)(src + 8 * c);
        T[(8 * c + 0) * 72 + lane] = (bf16_t)(v.x & 0xffffu); T[(8 * c + 1) * 72 + lane] = (bf16_t)(v.x >> 16);
        T[(8 * c + 2) * 72 + lane] = (bf16_t)(v.y & 0xffffu); T[(8 * c + 3) * 72 + lane] = (bf16_t)(v.y >> 16);
        T[(8 * c + 4) * 72 + lane] = (bf16_t)(v.z & 0xffffu); T[(8 * c + 5) * 72 + lane] = (bf16_t)(v.z >> 16);
        T[(8 * c + 6) * 72 + lane] = (bf16_t)(v.w & 0xffffu); T[(8 * c + 7) * 72 + lane] = (bf16_t)(v.w >> 16); }
    LDS_WAIT();
    const int g = lane & 7;
#pragma unroll
    for (int k = 0; k < 8; ++k) { const int d = (lane >> 3) + 8 * k; const u32x4 o = *(const u32x4*)(T + d * 72 + 8 * g);
        *(u32x4*)(Vt + (((size_t)b * 8 + h) * 128 + 64 * dh + d) * SEQ + 64 * st + 8 * g) = o; }
    LDS_WAIT();
}

__device__ __forceinline__ int crow(int r, int hi) { return (r & 3) + 8 * (r >> 2) + 4 * hi; }
__device__ __forceinline__ void moba_unit(unsigned char* lds, bf16_t* proj, const bf16_t* Vt, const float* kmean, int b, int h, int own, bf16_t* dry = nullptr) {
    int tid_ = threadIdx.x; asm volatile("" : "+v"(tid_));
    const int tid = tid_, lane = tid & 63, w = __builtin_amdgcn_readfirstlane(tid >> 6), r32 = lane & 31, hh = lane >> 5;
    constexpr int KP = 136, VP = 144;
    bf16_t* KsB = (bf16_t*)lds;
    bf16_t* VsB = KsB + 2 * 128 * KP;
    const size_t rowbase = (size_t)b * SEQ;
    const int qrel = 32 * w + r32;
    bf16_t* qptr = proj + (rowbase + own * 256 + qrel) * DIN + C_QM + h * 128;
    bf16x8 qf[8];
#pragma unroll
    for (int s = 0; s < 8; ++s) qf[s] = *(const bf16x8*)(qptr + 16 * s + 8 * hh);
    unsigned sel = 0u;
    {
        float g[7];
        const float* km = kmean + ((size_t)b * 8 + h) * 8 * 128;
#pragma unroll
        for (int jb = 0; jb < 7; ++jb) {
            float a = 0.f;
            if (jb < own) {
#pragma unroll
                for (int s = 0; s < 8; ++s) { const f32x4 k0 = *(const f32x4*)(km + jb * 128 + 16 * s + 8 * hh), k1 = *(const f32x4*)(km + jb * 128 + 16 * s + 8 * hh + 4);
                    const u32x4 qu = __builtin_bit_cast(u32x4, qf[s]);
                    a += bflo(qu.x) * k0.x + bfhi(qu.x) * k0.y + bflo(qu.y) * k0.z + bfhi(qu.y) * k0.w + bflo(qu.z) * k1.x + bfhi(qu.z) * k1.y + bflo(qu.w) * k1.z + bfhi(qu.w) * k1.w; }
                a += __shfl_xor(a, 32);
            }
            g[jb] = a;
        }
#pragma unroll
        for (int jb = 0; jb < 7; ++jb) {
            int rank = 0;
#pragma unroll
            for (int j2 = 0; j2 < 7; ++j2) { if (j2 != jb) { const bool better = (g[j2] > g[jb]) || (g[j2] == g[jb] && j2 < jb); rank += (j2 < own && better) ? 1 : 0; } }
            if (jb < own && rank < 3) sel |= (1u << jb);
        }
    }
    f32x16 o[4];
#pragma unroll
    for (int i = 0; i < 4; ++i)
#pragma unroll
        for (int r = 0; r < 16; ++r) o[i][r] = 0.f;
    float mrun = -1e30f, lrun = 0.f;
    const float SC = 0.08838834764831845f * 1.4426950408889634f;
    const int NT = 4 * (own + 1);
    const bf16_t* kg = proj + rowbase * DIN + C_KM + h * 128;
    const bf16_t* vg = proj + rowbase * DIN + C_VM + h * 128;
    const int vtoff = (4 * hh + ((lane & 15) >> 2)) * VP + 16 * ((lane >> 4) & 1) + 4 * (lane & 3);
    u32x4 kr[4], vr[4];
#define MOBA_LOAD(T_) do { _Pragma("unroll") for (int k_ = 0; k_ < 4; ++k_) { const int c_ = tid + 512 * k_; \
        kr[k_] = *(const u32x4*)(kg + (size_t)(128 * (T_) + (c_ >> 4)) * DIN + 8 * (c_ & 15)); \
        vr[k_] = *(const u32x4*)(vg + (size_t)(128 * (T_) + (c_ >> 4)) * DIN + 8 * (c_ & 15)); } } while (0)
#define MOBA_STORE(buf) do { _Pragma("unroll") for (int k_ = 0; k_ < 4; ++k_) { const int c_ = tid + 512 * k_; \
        *(u32x4*)(KsB + (buf) * 128 * KP + (c_ >> 4) * KP + 8 * (c_ & 15)) = kr[k_]; \
        *(u32x4*)(VsB + (buf) * 128 * VP + (c_ >> 4) * VP + 8 * (c_ & 15)) = vr[k_]; } } while (0)
    MOBA_LOAD(0);
    for (int T = 0; T < NT / 2; ++T) {
        const int buf = T & 1;
        MOBA_STORE(buf);
        __syncthreads();
        if (2 * T + 2 < NT) MOBA_LOAD(T + 1);
#pragma unroll
      for (int hf = 0; hf < 2; ++hf) {
        const int t = 2 * T + hf;
        const int jb = t >> 2, kt = t & 3;
        const bool isown = (jb == own);
        bool active;
        if (isown) active = (64 * kt <= 32 * w + 31);
        else active = __any((sel >> jb) & 1u) != 0;
        if (active) {
            const bf16_t* Kt = KsB + (buf * 128 + hf * 64) * KP; const LAS bf16_t* Vv = (const LAS bf16_t*)(VsB + (buf * 128 + hf * 64) * VP) + vtoff;
            f32x16 sc[2];
#pragma unroll
            for (int kb = 0; kb < 2; ++kb) {
#pragma unroll
                for (int r = 0; r < 16; ++r) sc[kb][r] = 0.f;
#pragma unroll
                for (int s = 0; s < 8; ++s) { const bf16x8 kf = *(const bf16x8*)(Kt + (32 * kb + r32) * KP + 16 * s + 8 * hh); sc[kb] = __builtin_amdgcn_mfma_f32_32x32x16_bf16(kf, qf[s], sc[kb], 0, 0, 0); }
            }
            const bool lane_sel = isown || (((sel >> jb) & 1u) != 0u);
            if (isown && (64 * kt + 63 > 32 * w)) {
#pragma unroll
                for (int kb = 0; kb < 2; ++kb)
#pragma unroll
                    for (int r = 0; r < 16; ++r) { const int krel = 64 * kt + 32 * kb + crow(r, hh); if (krel > qrel) sc[kb][r] = -INFINITY; }
            }
            float mx = -INFINITY;
#pragma unroll
            for (int kb = 0; kb < 2; ++kb)
#pragma unroll
                for (int r = 0; r < 16; ++r) mx = fmaxf(mx, sc[kb][r]);
            mx = fmaxf(mx, __shfl_xor(mx, 32)) * SC;
            const bool grow = lane_sel && (mx > mrun + 8.f);
            if (__any(grow)) {
                const float mnew = grow ? mx : mrun;
                const float alpha = __builtin_amdgcn_exp2f(mrun - mnew);
                lrun *= alpha; mrun = mnew;
#pragma unroll
                for (int i = 0; i < 4; ++i)
#pragma unroll
                    for (int r = 0; r < 16; ++r) o[i][r] *= alpha;
            }
            const float mref = lane_sel ? mrun : INFINITY;
            float ps = 0.f;
#pragma unroll
            for (int kb = 0; kb < 2; ++kb)
#pragma unroll
                for (int r = 0; r < 16; ++r) { const float p = __builtin_amdgcn_exp2f(__builtin_fmaf(sc[kb][r], SC, -mref)); sc[kb][r] = p; ps += p; }
            ps += __shfl_xor(ps, 32);
            lrun += ps;
#pragma unroll
            for (int kb = 0; kb < 2; ++kb)
#pragma unroll
                for (int s = 0; s < 2; ++s) {
                    u32x4 pw; pw.x = pk2(sc[kb][8 * s + 0], sc[kb][8 * s + 1]); pw.y = pk2(sc[kb][8 * s + 2], sc[kb][8 * s + 3]); pw.z = pk2(sc[kb][8 * s + 4], sc[kb][8 * s + 5]); pw.w = pk2(sc[kb][8 * s + 6], sc[kb][8 * s + 7]);
                    const bf16x8 pb = __builtin_bit_cast(bf16x8, pw);
#pragma unroll
                    for (int db = 0; db < 4; ++db) { const LAS bf16_t* vp = Vv + (32 * kb + 16 * s) * VP + 32 * db;
                        const s16x4 lo = __builtin_amdgcn_ds_read_tr16_b64_v4i16((LAS s16x4*)vp), hi = __builtin_amdgcn_ds_read_tr16_b64_v4i16((LAS s16x4*)(vp + 8 * VP));
                        const bf16x8 va = __builtin_shufflevector(lo, hi, 0, 1, 2, 3, 4, 5, 6, 7);
                        o[db] = __builtin_amdgcn_mfma_f32_32x32x16_bf16(va, pb, o[db], 0, 0, 0); }
                }
        }
      }
    }
#undef MOBA_LOAD
#undef MOBA_STORE
    const float rl = 1.f / lrun;
#pragma unroll
    for (int db = 0; db < 4; ++db)
#pragma unroll
        for (int g4 = 0; g4 < 4; ++g4) { u32x2 wv; wv.x = pk2(o[db][4 * g4 + 0] * rl, o[db][4 * g4 + 1] * rl); wv.y = pk2(o[db][4 * g4 + 2] * rl, o[db][4 * g4 + 3] * rl);
            *(u32x2*)((dry ? dry + tid * 8 : qptr + 32 * db + 8 * g4) + 4 * hh) = wv; }
    __syncthreads();
}

__device__ __forceinline__ void retfin_rows(bf16_t* proj, const f32x2* stats, const float* gain, const float* bias, int m_first, int m_step, int lane) {
    const int hd = lane >> 4;
    float gg[16], bb[16];
#pragma unroll
    for (int k = 0; k < 4; ++k) { const f32x4 g4 = *(const f32x4*)(gain + 16 * lane + 4 * k), b4 = *(const f32x4*)(bias + 16 * lane + 4 * k);
        gg[4 * k] = g4.x; gg[4 * k + 1] = g4.y; gg[4 * k + 2] = g4.z; gg[4 * k + 3] = g4.w; bb[4 * k] = b4.x; bb[4 * k + 1] = b4.y; bb[4 * k + 2] = b4.z; bb[4 * k + 3] = b4.w; }
    for (int m = m_first; m < M; m += 2 * m_step) {
        u32x4 ov[2][2], gv[2][2]; f32x2 st[2][4];
#pragma unroll
        for (int t = 0; t < 2; ++t) { const size_t mm = (size_t)(m + t * m_step); const bf16_t* op = proj + mm * DIN + C_VR + 16 * lane; const bf16_t* gp = proj + mm * DIN + C_GR + 16 * lane;
            ov[t][0] = *(const u32x4*)op; ov[t][1] = *(const u32x4*)(op + 8); gv[t][0] = *(const u32x4*)gp; gv[t][1] = *(const u32x4*)(gp + 8);
            const f32x2* sp = stats + (mm * 4 + hd) * 4; st[t][0] = sp[0]; st[t][1] = sp[1]; st[t][2] = sp[2]; st[t][3] = sp[3]; }
#pragma unroll
        for (int t = 0; t < 2; ++t) {
            const float mu = ((st[t][0].x + st[t][1].x) + (st[t][2].x + st[t][3].x)) * (1.f / 256.f);
            const float var = fmaxf(((st[t][0].y + st[t][1].y) + (st[t][2].y + st[t][3].y)) * (1.f / 256.f) - mu * mu, 0.f);
            const float rstd = 1.f / sqrtf(var + EPS);
            bf16_t* gp = proj + (size_t)(m + t * m_step) * DIN + C_GR + 16 * lane;
#pragma unroll
            for (int k = 0; k < 2; ++k) { float of[8], gf[8], r[8]; unpack8(ov[t][k], of); unpack8(gv[t][k], gf);
#pragma unroll
                for (int j = 0; j < 8; ++j) r[j] = ((of[j] - mu) * rstd * gg[8 * k + j] + bb[8 * k + j]) * (gf[j] * fsigmoid(gf[j]));
                *(u32x4*)(gp + 8 * k) = pack8(r); }
        }
    }
}

#define XB_TMO      128
#define XB_XCNT(j)  (256  + 64 * (j))
#define XB_XSUB(j)  (1280 + 64 * (j))
#define XB_XGEN(j)  (2304 + 64 * (j))
#define XB_TOP      3328
#define XB_TOPGEN   3392
#define XCD_BAR_WORDS 3456
#define XB_SPIN_CAP (1u << 18)
__device__ __forceinline__ unsigned xb_ld(unsigned* p)              { return __hip_atomic_load(p, __ATOMIC_RELAXED, __HIP_MEMORY_SCOPE_AGENT); }
__device__ __forceinline__ unsigned xb_add(unsigned* p, unsigned v) { return __hip_atomic_fetch_add(p, v, __ATOMIC_RELAXED, __HIP_MEMORY_SCOPE_AGENT); }
__device__ __forceinline__ unsigned xb_xcc_id() { return (unsigned)__builtin_amdgcn_s_getreg((3 << 11) | 20) & 0xFu; }
#define XB_SPIN(cond, bar) do { unsigned _sp = 0; while (cond) { __builtin_amdgcn_s_sleep(1); \
    if ((++_sp & 255u) == 0u) { if (xb_ld(&(bar)[XB_TMO])) break; if (_sp > XB_SPIN_CAP) { atomicAdd(&(bar)[XB_TMO], 1u); break; } } } } while (0)
struct XcdBarrier { unsigned* bar; unsigned x; volatile LAS unsigned* st; };
__device__ __forceinline__ XcdBarrier xcd_barrier_post(unsigned* bar, volatile LAS unsigned* st) {
    XcdBarrier b; b.bar = bar; b.x = xb_xcc_id(); b.st = st;
    if (threadIdx.x == 0) (void)xb_add(&bar[XB_XCNT(b.x)], 1u);
    return b;
}
__device__ __forceinline__ void xcd_barrier_complete(unsigned* bar, unsigned x, unsigned& nloc, unsigned& nx) {
    const unsigned G = gridDim.x * gridDim.y * gridDim.z;
    unsigned sum, cnt, mine, sp = 0u;
    for (;;) {
        sum = 0u; cnt = 0u; mine = 0u;
#pragma unroll
        for (unsigned j = 0; j < 16; ++j) { const unsigned c = xb_ld(&bar[XB_XCNT(j)]); sum += c; cnt += (c > 0u) ? 1u : 0u; mine = (j == x) ? c : mine; }
        if (sum == G) break;
        __builtin_amdgcn_s_sleep(1);
        if ((++sp & 255u) == 0u) { if (xb_ld(&bar[XB_TMO])) break; if (sp > XB_SPIN_CAP) { atomicAdd(&bar[XB_TMO], 1u); break; } }
    }
    nloc = mine > 0u ? mine : 1u; nx = cnt > 0u ? cnt : 1u;
}
__device__ __forceinline__ void xcd_barrier(const XcdBarrier& b) {
    asm volatile("s_waitcnt vmcnt(0)" ::: "memory");
    __syncthreads();
    if (threadIdx.x == 0) {
        unsigned* bar = b.bar;
        __builtin_amdgcn_s_waitcnt(0);
        unsigned nloc = b.st[0], nx = b.st[1];
        if (nloc == 0u) { xcd_barrier_complete(bar, b.x, nloc, nx); b.st[0] = nloc; b.st[1] = nx; }
        const unsigned old = xb_add(&bar[XB_XSUB(b.x)], 1u);
        const unsigned gen = old / nloc;
        if (old + 1u == (gen + 1u) * nloc) {
            __builtin_amdgcn_fence(__ATOMIC_RELEASE, "agent");
            asm volatile("s_waitcnt vmcnt(0)" ::: "memory");
            const unsigned og = xb_add(&bar[XB_TOP], 1u);
            const unsigned tg = og / nx;
            if (og + 1u == (tg + 1u) * nx) xb_add(&bar[XB_TOPGEN], 1u);
            else XB_SPIN(xb_ld(&bar[XB_TOPGEN]) == tg, bar);
            __builtin_amdgcn_fence(__ATOMIC_ACQUIRE, "agent");
            xb_add(&bar[XB_XGEN(b.x)], 1u);
            asm volatile("s_waitcnt vmcnt(0)" ::: "memory");
        } else {
            XB_SPIN(xb_ld(&bar[XB_XGEN(b.x)]) == gen, bar);
            __builtin_amdgcn_fence(__ATOMIC_ACQUIRE, "agent");
            asm volatile("s_waitcnt vmcnt(0)" ::: "memory");
        }
    }
    __syncthreads();
}

struct Args { const float* in[17]; float* out; unsigned char* ws; int never; int pad; };

__global__ void __launch_bounds__(512, 2) fwd_kernel(Args args) {
    extern __shared__ __attribute__((aligned(16))) unsigned char lds[];
    cg::grid_group grid = cg::this_grid();
    const int tid = threadIdx.x, lane = tid & 63, wave = __builtin_amdgcn_readfirstlane(tid >> 6);
    const int G = gridDim.x, bid = blockIdx.x;
    const int gw = bid * 8 + wave, NGW = G * 8;
    unsigned char* ws = args.ws;
    const float* x = args.in[0]; const float* attn_norm = args.in[1]; const float* w_in = args.in[2]; const float* ret_gain = args.in[3]; const float* ret_bias = args.in[4];
    const float* q_gain = args.in[5]; const float* k_gain = args.in[6]; const float* w_ret_o = args.in[7]; const float* w_moba_o = args.in[8]; const float* w_gate = args.in[9];
    const float* b_gate = args.in[10]; const float* w_out = args.in[11]; const float* ffn_norm = args.in[12]; const float* w_up = args.in[13]; const float* conv_w = args.in[14];
    const float* conv_b = args.in[15]; const float* w_down = args.in[16];
    float* out = args.out;
    bf16_t* W1 = (bf16_t*)(ws + WS_W1); bf16_t* W2 = (bf16_t*)(ws + WS_W2); bf16_t* WO = (bf16_t*)(ws + WS_WO); bf16_t* WUP = (bf16_t*)(ws + WS_WUP); bf16_t* WDN = (bf16_t*)(ws + WS_WDN);
    f32x2* rope = (f32x2*)(ws + WS_ROPE); float* kmean = (float*)(ws + WS_KMEAN); f32x2* stats = (f32x2*)(ws + WS_STATS);
    bf16_t* HB = (bf16_t*)(ws + WS_H); bf16_t* PROJ = (bf16_t*)(ws + WS_PROJ); bf16_t* ACT = (bf16_t*)(ws + WS_PROJ); float* UH = (float*)(ws + WS_UH); bf16_t* XB = (bf16_t*)(ws + WS_XB); float* SSQ = (float*)(ws + WS_STATS); float* RSTD = (float*)(ws + WS_RSTD);
    bf16_t* GATES = (bf16_t*)out;
    LAS unsigned char* lds3 = (LAS unsigned char*)lds;
#ifndef PROBE_A
#define PROBE_A -1
#endif
#ifndef PROBE_B
#define PROBE_B -1
#endif
    unsigned long long* stamps = (unsigned long long*)(ws + 46 * MiB);
    int n_stamp = 0;
#define STAMP() do { if (PROBE_A >= 0) { if (bid == 0 && tid == 0) stamps[n_stamp] = __builtin_amdgcn_s_memrealtime(); ++n_stamp; } } while (0)
    STAMP();
    unsigned* barw = (unsigned*)(ws + 47 * MiB);
    volatile LAS unsigned* bst = (volatile LAS unsigned*)(lds3 + LDS_BYTES - 256);
    if (tid < 2) bst[tid] = 0u;
    const XcdBarrier xbar = xcd_barrier_post(barw, bst);
#define GSYNC() xcd_barrier(xbar)

#ifndef PHMASK
#define PHMASK 0xffff
#endif
#define RUNP(n) ((((PHMASK) >> (n)) & 1) != 0)
    if constexpr (RUNP(0)) {
        float* scr = (float*)(lds + wave * 16384);
        constexpr int I_IN = 16 * (DIN / 32), I_G = 16 * (NGATE / 32), I_O = 16 * 32, I_UP = 16 * (NUP / 32), I_DN = (DFF / 64) * 32;
        (void)I_O; (void)I_UP; (void)I_DN;
        for (int it = gw; it < I_IN + I_G; it += NGW) {
            int r = it;
            if (r < I_IN) { transpose_item<2>(w_in, DM, DIN, W1, DM, 0, 0, scr, r, lane); continue; } r -= I_IN;
            transpose_item(w_gate, DM, NGATE, W1, DM, DIN, 0, scr, r, lane);
        }
        for (int m = gw; m < M; m += 2 * NGW) {
            const int m2 = m + NGW;
            const f32x4* xa = (const f32x4*)(x + (size_t)m * DM) + lane; const f32x4* xc = (const f32x4*)(x + (size_t)m2 * DM) + lane; const f32x4* gr = (const f32x4*)attn_norm + lane;
            f32x4 va[4], vc[4]; float sa = 0.f, sc = 0.f;
#pragma unroll
            for (int j = 0; j < 4; ++j) { va[j] = xa[64 * j]; vc[j] = xc[64 * j]; }
#pragma unroll
            for (int j = 0; j < 4; ++j) { sa += (va[j].x * va[j].x + va[j].y * va[j].y) + (va[j].z * va[j].z + va[j].w * va[j].w); sc += (vc[j].x * vc[j].x + vc[j].y * vc[j].y) + (vc[j].z * vc[j].z + vc[j].w * vc[j].w); }
            const float ra = 1.f / sqrtf(wave_sum(sa) * (1.f / DM) + EPS), rc = 1.f / sqrtf(wave_sum(sc) * (1.f / DM) + EPS);
            u32x2* oa = (u32x2*)(HB + (size_t)m * DM) + lane; u32x2* oc = (u32x2*)(HB + (size_t)m2 * DM) + lane;
#pragma unroll
            for (int j = 0; j < 4; ++j) { const f32x4 gg = gr[64 * j]; u32x2 w; w.x = pk2(va[j].x * ra * gg.x, va[j].y * ra * gg.y); w.y = pk2(va[j].z * ra * gg.z, va[j].w * ra * gg.w); oa[64 * j] = w;
                u32x2 w2; w2.x = pk2(vc[j].x * rc * gg.x, vc[j].y * rc * gg.y); w2.y = pk2(vc[j].z * rc * gg.z, vc[j].w * rc * gg.w); oc[64 * j] = w2; }
        }
        for (int i = bid * 512 + tid; i < NB * 8 * 8 * 128; i += G * 512) kmean[i] = 0.f;
        for (int i = bid * 512 + tid; i < SEQ * 64; i += G * 512) {
            const int pos = i >> 6, fi = i & 63;
            const float inv_freq = __builtin_amdgcn_exp2f(-(float)fi * (13.287712379549449f / 64.f));
            double rev = (double)pos * (double)inv_freq * 0.15915494309189535; rev -= __builtin_floor(rev);
            const float rf = (float)rev;
            rope[i] = (f32x2){__builtin_amdgcn_cosf(rf), __builtin_amdgcn_sinf(rf)};
        }
    }
    if (args.never) grid.sync();
    GSYNC(); STAMP();
#ifdef DUP_SYNC
    for (int i_ = 0; i_ < 10; ++i_) GSYNC();
#endif
#ifdef DUP_G1
    {
        pg8::Gemm g{HB, W1, M, N1, DM, DM}; pg8::StaticOrder S; S.init(M, N1, G, bid);
        pg8::EpiProj E{PROJ, GATES, b_gate, q_gain, k_gain, kmean, (float*)(lds + 131072), rope};
        pg8::gemm_phase<pg8::EpiProj>(lds3, g, S, E);
    }
#endif
    if constexpr (RUNP(1)) {
        pg8::Gemm g{HB, W1, M, N1, DM, DM}; pg8::StaticOrder S; S.init(M, N1, G, bid);
        pg8::EpiProj E{PROJ, GATES, b_gate, q_gain, k_gain, kmean, (float*)(lds + 131072), rope};
        pg8::gemm_phase<pg8::EpiProj>(lds3, g, S, E);
    }
    GSYNC(); STAMP();
    if constexpr (RUNP(2)) {
#ifdef DUP_RET
        for (int it = bid; it < NB * 4 * 4; it += G) retention_item(lds, PROJ, rope, stats, it >> 4, (it >> 2) & 3, it & 3, (bf16_t*)(ws + 500 * MiB));
#endif
        if constexpr (RUNP(10)) for (int it = bid; it < NB * 4 * 4; it += G) retention_item(lds, PROJ, rope, stats, it >> 4, (it >> 2) & 3, it & 3);
        {
            float* scr = (float*)(lds + wave * 16384);
            constexpr int I_O = 16 * 32, I_UP = 16 * (NUP / 32), I_DN = (DFF / 64) * 32;
            for (int it = gw; it < 3 * I_O + I_UP + I_DN; it += NGW) {
                int r = it;
                if (r < I_O) { transpose_item(w_ret_o, DM, DM, W2, 2 * DM, 0, 0, scr, r, lane); continue; } r -= I_O;
                if (r < I_O) { transpose_item(w_moba_o, DM, DM, W2, 2 * DM, 0, DM, scr, r, lane); continue; } r -= I_O;
                if (r < I_O) { transpose_item(w_out, DM, DM, WO, DM, 0, 0, scr, r, lane); continue; } r -= I_O;
                if (r < I_UP) { transpose_item<1>(w_up, DM, NUP, WUP, DM, 0, 0, scr, r, lane, ffn_norm); continue; } r -= I_UP;
                transpose_item(w_down, DFF, DM, WDN, DFF, 0, 0, scr, r, lane);
            }
        }
    }
    GSYNC(); STAMP();
    if constexpr (RUNP(3)) {
      const int first_fin = (bid >> 3) & 1;
#pragma unroll 1
      for (int step = 0; step < 2; ++step) {
       if ((step ^ first_fin) == 1) {
        for (int bh = bid >> 1; bh < NB * 8; bh += (G >> 1)) {
            const int par = bid & 1;
#pragma unroll 1
            for (int k = 0; k < 4; ++k) { const int own = par ? (k == 0 ? 6 : k == 1 ? 5 : k == 2 ? 2 : 1) : (k == 0 ? 7 : k == 1 ? 4 : k == 2 ? 3 : 0);
#ifdef DUP_MOBA
                moba_unit(lds, PROJ, HB, kmean, bh >> 3, bh & 7, own, (bf16_t*)(ws + 500 * MiB));
#endif
                moba_unit(lds, PROJ, HB, kmean, bh >> 3, bh & 7, own); }
        }
       } else {
        retfin_rows(PROJ, stats, ret_gain, ret_bias, gw, NGW, lane);
       }
      }
    }
    GSYNC(); STAMP();
    if constexpr (RUNP(4)) {
        pg8::Gemm g{PROJ + C_GR, W2, M, DM, 2 * DM, DIN}; pg8::StaticOrder S; S.init(M, DM, G, bid);
        pg8::EpiMerge E{GATES, HB};
        pg8::gemm_phase<pg8::EpiMerge>(lds3, g, S, E);
    }
    GSYNC(); STAMP();
#ifdef DUP_G4
    {
        pg8::Gemm g{HB, WO, M, DM, DM, DM}; pg8::StaticOrder S; S.init(M, DM, G, bid);
        pg8::EpiResidNorm E{x, XB, SSQ};
        pg8::gemm_phase<pg8::EpiResidNorm>(lds3, g, S, E);
    }
    GSYNC();
#endif
    if constexpr (RUNP(5)) {
        pg8::Gemm g{HB, WO, M, DM, DM, DM}; pg8::StaticOrder S; S.init(M, DM, G, bid);
        pg8::EpiResidNorm E{x, XB, SSQ};
        pg8::gemm_phase<pg8::EpiResidNorm>(lds3, g, S, E);
    }
    GSYNC(); STAMP();
    for (int m = bid * 512 + tid; m < M; m += G * 512) { const f32x4* p = (const f32x4*)(SSQ + (size_t)m * 16); const f32x4 a = p[0], b = p[1], c = p[2], d = p[3];
        const float s = ((a.x + a.y) + (a.z + a.w)) + ((b.x + b.y) + (b.z + b.w)) + ((c.x + c.y) + (c.z + c.w)) + ((d.x + d.y) + (d.z + d.w));
        RSTD[m] = 1.f / sqrtf(s * (1.f / DM) + EPS); }
    GSYNC(); STAMP();
#ifdef DUP_G5
    {
        pg8::Gemm g{XB, WUP, M, NUP, DM, DM}; pg8::StaticOrder S; S.init(M, NUP, G, bid);
        pg8::EpiConv E{ACT, UH, conv_w, conv_b, (f32x2*)(lds + 131072), RSTD};
        pg8::gemm_phase<pg8::EpiConv, true, true, true>(lds3, g, S, E);
    }
#endif
    {
        pg8::Gemm g{XB, WUP, M, NUP, DM, DM}; pg8::StaticOrder S; S.init(M, NUP, G, bid);
        pg8::EpiConv E{ACT, UH, conv_w, conv_b, (f32x2*)(lds + 131072), RSTD};
        pg8::gemm_phase<pg8::EpiConv, true, true, true>(lds3, g, S, E);
    }
    GSYNC(); STAMP();
    for (int idx = bid * 512 + tid; idx < 112 * DFF; idx += G * 512) {
        const int t = idx / DFF, c = idx - t * DFF, pm = (t / 7) * 8 + (t % 7) + 1;
        const int colg = 256 * (c >> 7) + (c & 127), colv = colg + 128;
        const float* up = UH + ((size_t)(pm - 1) * 4 + 2) * NUP; const float* uc = UH + ((size_t)pm * 4) * NUP;
        const float a2 = up[colg], a1 = up[NUP + colg], a0 = uc[colg], an = uc[NUP + colg];
        const float b2 = up[colv], b1 = up[NUP + colv], b0 = uc[colv], bn = uc[NUP + colv];
        const float gb = conv_b[c], g0 = conv_w[c], g1 = conv_w[NUP + c], g2 = conv_w[2 * NUP + c];
        const float vb = conv_b[DFF + c], v0 = conv_w[DFF + c], v1 = conv_w[NUP + DFF + c], v2 = conv_w[2 * NUP + DFF + c];
        const float og0 = gb + g0 * a2 + g1 * a1 + g2 * a0, og1 = gb + g0 * a1 + g1 * a0 + g2 * an;
        const float ov0 = vb + v0 * b2 + v1 * b1 + v2 * b0, ov1 = vb + v0 * b1 + v1 * b0 + v2 * bn;
        const unsigned w = pk2(og0 * fsigmoid(og0) * ov0, og1 * fsigmoid(og1) * ov1);
        ACT[(size_t)(pm * 256) * DFF + c] = (bf16_t)(w & 0xffffu); ACT[(size_t)(pm * 256 + 1) * DFF + c] = (bf16_t)(w >> 16);
    }
    GSYNC(); STAMP();
    {
        pg8::Gemm g{ACT, WDN, M, DM, DFF, DFF}; pg8::StaticOrder S; S.init(M, DM, G, bid);
        pg8::EpiResid E{XB, out};
        pg8::gemm_phase<pg8::EpiResid>(lds3, g, S, E);
    }
    if (PROBE_A >= 0) {
        GSYNC(); STAMP(); __threadfence(); __syncthreads();
        if (bid == 0) {
            const int pa = PROBE_A, pb = PROBE_B;
            const float ta = (float)(stamps[pa + 1] - stamps[pa]) * 0.01f;
            const float tb = pb >= 100 ? (float)(stamps[n_stamp - 1] - stamps[0]) * 0.01f : (pb >= 0 ? (float)(stamps[pb + 1] - stamps[pb]) * 0.01f : 0.f);
            if (tid == 0) out[0] += ta * 0.01f;
            for (int i = tid; i < 65536; i += 512) out[4096 + i] += tb * 0.001f;
        }
    }
}

extern "C" void kernel_launch(void* const* d_in, const int* in_sizes, int n_in, void* d_out, int out_size, void* d_ws, size_t ws_size, hipStream_t stream) {
    static int grid = 0;
    if (grid == 0) {
        if (n_in != 17 || out_size != M * DM || ws_size < WS_END) { fprintf(stderr, "kernel_launch: unexpected shapes (n_in %d out %d ws %zu)\n", n_in, out_size, ws_size); grid = -1; return; }
        int dev = 0, cus = 0, per_cu = 0;
        hipGetDevice(&dev); hipDeviceGetAttribute(&cus, hipDeviceAttributeMultiprocessorCount, dev);
        hipFuncSetAttribute((const void*)fwd_kernel, hipFuncAttributeMaxDynamicSharedMemorySize, LDS_BYTES);
        hipOccupancyMaxActiveBlocksPerMultiprocessor(&per_cu, (const void*)fwd_kernel, 512, LDS_BYTES);
        if (per_cu < 1) { fprintf(stderr, "kernel_launch: occupancy query says %d blocks per CU\n", per_cu); per_cu = 1; }
        (void)hipGetLastError();
        grid = cus * per_cu;
    }
    if (grid < 0) return;
    if (hipMemsetAsync((char*)d_ws + 47 * MiB, 0, XCD_BAR_WORDS * 4, stream) != hipSuccess) { fprintf(stderr, "kernel_launch: memset of the barrier words failed\n"); return; }
    Args a{};
    for (int i = 0; i < 17; ++i) a.in[i] = (const float*)d_in[i];
    a.out = (float*)d_out; a.ws = (unsigned char*)d_ws;
    void* params[] = {&a};
    hipError_t e = hipLaunchCooperativeKernel((const void*)fwd_kernel, dim3(grid), dim3(512), params, LDS_BYTES, stream);
    if (e != hipSuccess) fprintf(stderr, "cooperative launch failed: %s (grid %d)\n", hipGetErrorString(e), grid);
}
```

```cpp
#include <hip/hip_runtime.h>
#include <hip/hip_cooperative_groups.h>
#include <cstdio>
#include <cstdint>
namespace cg = cooperative_groups;

#define LAS __attribute__((address_space(3)))
typedef unsigned short bf16_t;
typedef short bf16x8 __attribute__((ext_vector_type(8)));
typedef short s16x4 __attribute__((ext_vector_type(4)));
typedef float f32x4 __attribute__((ext_vector_type(4)));
typedef float f32x2 __attribute__((ext_vector_type(2)));
typedef float f32x16 __attribute__((ext_vector_type(16)));
typedef unsigned u32x4 __attribute__((ext_vector_type(4)));
typedef unsigned u32x2 __attribute__((ext_vector_type(2)));
typedef __bf16 bf16x2_t __attribute__((ext_vector_type(2)));

constexpr int SEQ = 2048, NB = 16, DM = 1024, M = NB * SEQ;
constexpr int DIN = 6144, NGATE = 2048, N1 = DIN + NGATE;
constexpr int DFF = 2816, NUP = 2 * DFF;
constexpr int C_QR = 0, C_KR = 512, C_VR = 1024, C_GR = 2048, C_QM = 3072, C_KM = 4096, C_VM = 5120;
constexpr float EPS = 1e-6f;
constexpr int RET_QKW = 512;
constexpr int MH = M / 2;

constexpr size_t MiB = 1u << 20;
constexpr size_t WS_W1 = 0;
constexpr size_t WS_W2 = 16 * MiB;
constexpr size_t WS_WO = 20 * MiB;
constexpr size_t WS_WUP = 22 * MiB;
constexpr size_t WS_WDN = 33 * MiB;
constexpr size_t WS_ROPE = 39 * MiB;
constexpr size_t WS_KMEAN = 40 * MiB;
constexpr size_t WS_STATS = 41 * MiB;
constexpr size_t WS_H = 48 * MiB;
constexpr size_t WS_PROJ = 112 * MiB;
constexpr size_t WS_XB = WS_PROJ + 224 * MiB;
constexpr size_t WS_RSTD = 45 * MiB;
constexpr size_t WS_UH = WS_PROJ + 200 * MiB;
constexpr size_t WS_END = 496 * MiB;

constexpr int LDS_BYTES = 147456;

__device__ __forceinline__ unsigned pk2(float lo, float hi) { f32x2 v = {lo, hi}; bf16x2_t b = __builtin_convertvector(v, bf16x2_t); return __builtin_bit_cast(unsigned, b); }
__device__ __forceinline__ float bflo(unsigned u) { return __uint_as_float(u << 16); }
__device__ __forceinline__ float bfhi(unsigned u) { return __uint_as_float(u & 0xffff0000u); }
__device__ __forceinline__ float fsigmoid(float x) { return __builtin_amdgcn_rcpf(1.f + __builtin_amdgcn_exp2f(-1.4426950408889634f * x)); }
__device__ __forceinline__ void unpack8(const u32x4 v, float* f) { f[0] = bflo(v.x); f[1] = bfhi(v.x); f[2] = bflo(v.y); f[3] = bfhi(v.y); f[4] = bflo(v.z); f[5] = bfhi(v.z); f[6] = bflo(v.w); f[7] = bfhi(v.w); }
__device__ __forceinline__ u32x4 pack8(const float* f) { u32x4 o; o.x = pk2(f[0], f[1]); o.y = pk2(f[2], f[3]); o.z = pk2(f[4], f[5]); o.w = pk2(f[6], f[7]); return o; }
#define LDS_WAIT() asm volatile("s_waitcnt lgkmcnt(0)" ::: "memory")

namespace pg8 {
constexpr int BM = 256, BK = 64, HALF = 128, HTB = HALF * BK * 2, STAGE_BYTES = 8 * HTB, NXCD = 8, WGM = 4;
__host__ __device__ __forceinline__ int lds_byte(int r, int c) { const int st = (r >> 4) * 2 + (c >> 5), rr = r & 15, cc = c & 31, ob = rr * 64 + cc * 2; return st * 1024 + (ob ^ (((ob >> 9) & 1) << 5)); }
__host__ __device__ __forceinline__ void stage_rc(int b, int& R, int& C) { const int st = b / 1024, sb = b % 1024, swz = sb ^ (((sb >> 9) & 1) << 5); R = (st >> 1) * 16 + swz / 64; C = (st & 1) * 32 + (swz % 64) / 2; }
__host__ __device__ __forceinline__ int perm32(int rho) { const int n = rho >> 4, i = rho & 15; return 8 * (i >> 2) + 4 * n + (i & 3); }

struct Unit { int pm, pn; };
struct Gemm { const bf16_t* A; const bf16_t* Bt; int M, N, K, lda; };

struct StaticOrder {
    int nM, nN, nwg, G, c;
    __device__ void init(int M_, int N_, int G_, int c_) { nM = M_ / BM; nN = N_ / BM; nwg = nM * nN; G = G_; c = c_; }
    __device__ bool next(int i, Unit& u) const {
        const long L = (long)i * G + c; if (L >= nwg) return false;
        int wgid = (int)L; { const int q = nwg / NXCD, r = nwg % NXCD, xcd = wgid % NXCD, off = wgid / NXCD; wgid = (xcd < r ? xcd * (q + 1) : r * (q + 1) + (xcd - r) * q) + off; }
        const int nig = WGM * nN, gid = wgid / nig, fm = gid * WGM, gsz = (nM - fm) < WGM ? (nM - fm) : WGM;
        u.pm = fm + ((wgid % nig) % gsz); u.pn = (wgid % nig) / gsz; return true;
    }
};

typedef f32x4 Acc[2][2][4][2];

template <class Epi, bool ALIGN_EPI = true, bool SP2 = true, bool SWAP = false>
__device__ __forceinline__ void gemm_phase(LAS unsigned char* lds, const Gemm g, const StaticOrder& S, const Epi& E) {
    int tid_ = threadIdx.x; asm volatile("" : "+v"(tid_));
    const int tid = tid_, wid = __builtin_amdgcn_readfirstlane(tid >> 6), lane = tid & 63, wr = wid >> 2, wc = wid & 3, fr = lane & 15, fq = lane >> 4;
    const int K = g.K, nt = K / BK, lda = g.lda;
    unsigned voffA[2], voffB[2], voffB1[2];
#pragma unroll
    for (int i = 0; i < 2; ++i) { int R, C; stage_rc(tid * 16 + i * 8192, R, C); const int Rb = Epi::PERM ? ((R & ~31) + perm32(R & 31)) : R;
        voffA[i] = (unsigned)(R * lda + C) * 2u; voffB[i] = (unsigned)(Rb * K + C) * 2u; voffB1[i] = voffB[i];
        if constexpr (Epi::ADJ) { const int r0 = 64 * (R >> 5) + perm32(R & 31); voffB[i] = (unsigned)(r0 * K + C) * 2u; voffB1[i] = (unsigned)((r0 + 32) * K + C) * 2u; } }
    const size_t kstep = (size_t)(BK * 2);
    const size_t hstepA = (size_t)HALF * lda * 2, hstepB_ = (size_t)HALF * K * 2;
    const size_t tstepA = 2 * hstepA, tstepB = 2 * hstepB_;
    const size_t hstepB = Epi::ADJ ? 0 : hstepB_;
    const unsigned ldsw = (unsigned)wid * 1024u;
    const int aoff = lds_byte(wr * 64 + fr, fq * 8), boff = lds_byte(wc * 32 + fr, fq * 8);
#define PG8_SA(b, h) (((b) * 2 + (h)) * HTB)
#define PG8_SB(b, h) ((4 + (b) * 2 + (h)) * HTB)
#define PG8_STAGE(bufoff, gbase, voff) do { _Pragma("unroll") for (int _i = 0; _i < 2; ++_i) \
        __builtin_amdgcn_global_load_lds((const unsigned*)((const char*)(gbase) + (voff)[_i]), (LAS unsigned*)(lds + (bufoff) + ldsw + _i * 8192), 16, 0, 0); } while (0)
#define PG8_LDA(dst, b, h) do { _Pragma("unroll") for (int m = 0; m < 4; ++m) _Pragma("unroll") for (int k = 0; k < 2; ++k) dst[m][k] = *(const LAS bf16x8*)(lds + PG8_SA(b, h) + aoff + m * 2048 + k * 1024); } while (0)
#define PG8_LDB(dst, b, h) do { _Pragma("unroll") for (int n = 0; n < 2; ++n) _Pragma("unroll") for (int k = 0; k < 2; ++k) dst[n][k] = *(const LAS bf16x8*)(lds + PG8_SB(b, h) + boff + n * 2048 + k * 1024); } while (0)
#define PG8_MMA(ai, bj, At, Bt) do { __builtin_amdgcn_s_setprio(1); _Pragma("unroll") for (int m = 0; m < 4; ++m) _Pragma("unroll") for (int n = 0; n < 2; ++n) _Pragma("unroll") for (int k = 0; k < 2; ++k) \
        acc[ai][bj][m][n] = SWAP ? __builtin_amdgcn_mfma_f32_16x16x32_bf16(At[m][k], Bt[n][k], acc[ai][bj][m][n], 0, 0, 0) : __builtin_amdgcn_mfma_f32_16x16x32_bf16(Bt[n][k], At[m][k], acc[ai][bj][m][n], 0, 0, 0); __builtin_amdgcn_s_setprio(0); } while (0)
#define PG8_WAIT_V(n) asm volatile("s_waitcnt vmcnt(" #n ")" ::: "memory")
#define PG8_WAIT_L(n) asm volatile("s_waitcnt lgkmcnt(" #n ")" ::: "memory")
#define PG8_BAR __builtin_amdgcn_s_barrier()
#define PG8_SCHED __builtin_amdgcn_sched_barrier(0)
    Unit cur, nxt; int ui = 0;
    if (!S.next(0, cur)) return;
    Acc acc;
#pragma unroll
    for (int a = 0; a < 2; ++a)
#pragma unroll
        for (int b = 0; b < 2; ++b)
#pragma unroll
            for (int m = 0; m < 4; ++m)
#pragma unroll
                for (int n = 0; n < 2; ++n) acc[a][b][m][n] = (f32x4){0.f, 0.f, 0.f, 0.f};
    bf16x8 At[4][2], B0[2][2], B1[2][2];
    const char* cA = (const char*)g.A + (size_t)cur.pm * tstepA; const char* cB = (const char*)g.Bt + (size_t)cur.pn * tstepB;
    if constexpr (SP2) {
        PG8_STAGE(PG8_SB(0, 0), cB, voffB); PG8_STAGE(PG8_SB(0, 1), cB + hstepB, voffB1); PG8_STAGE(PG8_SA(0, 0), cA, voffA); PG8_STAGE(PG8_SA(0, 1), cA + hstepA, voffA);
        if (wr == 1) PG8_BAR;
        PG8_WAIT_V(2); PG8_BAR;
        PG8_STAGE(PG8_SB(1, 0), cB + kstep, voffB); PG8_STAGE(PG8_SA(1, 0), cA + kstep, voffA); PG8_STAGE(PG8_SB(1, 1), cB + hstepB + kstep, voffB1);
        PG8_WAIT_V(6); PG8_BAR;
    } else {
        PG8_STAGE(PG8_SB(0, 0), cB, voffB); PG8_STAGE(PG8_SA(0, 0), cA, voffA); PG8_STAGE(PG8_SB(0, 1), cB + hstepB, voffB1); PG8_STAGE(PG8_SA(0, 1), cA + hstepA, voffA);
        if (wr == 1) PG8_BAR;
        PG8_WAIT_V(4); PG8_BAR;
        PG8_STAGE(PG8_SB(1, 0), cB + kstep, voffB); PG8_STAGE(PG8_SA(1, 0), cA + kstep, voffA); PG8_STAGE(PG8_SB(1, 1), cB + hstepB + kstep, voffB1);
        PG8_WAIT_V(6); PG8_BAR;
    }
    for (;;) {
        const bool has_next = S.next(ui + 1, nxt);
        const char* nA = has_next ? (const char*)g.A + (size_t)nxt.pm * tstepA : cA; const char* nB = has_next ? (const char*)g.Bt + (size_t)nxt.pn * tstepB : cB;
        for (int t = 0; t < nt; t += 2) {
            const bool last = (t == nt - 2);
            const char* a1 = cA + (size_t)(t + 1) * kstep;
            const char* a2 = last ? nA : cA + (size_t)(t + 2) * kstep; const char* b2 = last ? nB : cB + (size_t)(t + 2) * kstep;
            const char* a3 = a2 + kstep; const char* b3 = b2 + kstep;
            if constexpr (Epi::HAS_MID) { if (t == Epi::MID_T) E.mid(acc, cur, wr, wc, fr, fq); }
            if constexpr (SP2) {
            PG8_LDB(B0, 0, 0); PG8_LDB(B1, 0, 1); PG8_SCHED; PG8_LDA(At, 0, 0); PG8_STAGE(PG8_SA(1, 1), a1 + hstepA, voffA);
            PG8_WAIT_V(8); PG8_WAIT_L(0); PG8_BAR; PG8_MMA(0, 0, At, B0); PG8_MMA(0, 1, At, B1); PG8_BAR; PG8_SCHED;
            PG8_LDA(At, 0, 1); PG8_STAGE(PG8_SB(0, 0), b2, voffB); PG8_STAGE(PG8_SB(0, 1), b2 + hstepB, voffB1); PG8_STAGE(PG8_SA(0, 0), a2, voffA);
            PG8_WAIT_V(8); PG8_WAIT_L(0); PG8_BAR; PG8_MMA(1, 0, At, B0); PG8_MMA(1, 1, At, B1); PG8_BAR; PG8_SCHED;
            PG8_LDB(B0, 1, 0); PG8_LDB(B1, 1, 1); PG8_SCHED; PG8_LDA(At, 1, 0); PG8_STAGE(PG8_SA(0, 1), a2 + hstepA, voffA);
            PG8_WAIT_V(8); PG8_WAIT_L(0); PG8_BAR; PG8_MMA(0, 0, At, B0); PG8_MMA(0, 1, At, B1); PG8_BAR; PG8_SCHED;
            PG8_LDA(At, 1, 1); PG8_STAGE(PG8_SB(1, 0), b3, voffB); PG8_STAGE(PG8_SB(1, 1), b3 + hstepB, voffB1); PG8_STAGE(PG8_SA(1, 0), a3, voffA);
            PG8_WAIT_V(8); PG8_WAIT_L(0); PG8_BAR; PG8_MMA(1, 0, At, B0); PG8_MMA(1, 1, At, B1); PG8_BAR; PG8_SCHED;
            } else {
            PG8_LDB(B0, 0, 0); PG8_SCHED; PG8_LDA(At, 0, 0); PG8_STAGE(PG8_SA(1, 1), a1 + hstepA, voffA);
            PG8_WAIT_L(8); PG8_BAR; PG8_WAIT_L(0); PG8_MMA(0, 0, At, B0); PG8_BAR; PG8_SCHED;
            PG8_LDB(B1, 0, 1); PG8_STAGE(PG8_SB(0, 0), b2, voffB);
            PG8_BAR; PG8_WAIT_L(0); PG8_MMA(0, 1, At, B1); PG8_BAR;
            PG8_LDA(At, 0, 1); PG8_STAGE(PG8_SA(0, 0), a2, voffA);
            PG8_BAR; PG8_WAIT_L(0); PG8_MMA(1, 0, At, B0); PG8_BAR; PG8_SCHED;
            PG8_STAGE(PG8_SB(0, 1), b2 + hstepB, voffB1);
            PG8_WAIT_V(6); PG8_BAR; PG8_MMA(1, 1, At, B1); PG8_BAR;
            PG8_LDB(B0, 1, 0); PG8_SCHED; PG8_LDA(At, 1, 0); PG8_STAGE(PG8_SA(0, 1), a2 + hstepA, voffA);
            PG8_WAIT_L(8); PG8_BAR; PG8_WAIT_L(0); PG8_MMA(0, 0, At, B0); PG8_BAR; PG8_SCHED;
            PG8_LDB(B1, 1, 1); PG8_STAGE(PG8_SB(1, 0), b3, voffB);
            PG8_BAR; PG8_WAIT_L(0); PG8_MMA(0, 1, At, B1); PG8_BAR;
            PG8_LDA(At, 1, 1); PG8_STAGE(PG8_SA(1, 0), a3, voffA);
            PG8_BAR; PG8_WAIT_L(0); PG8_MMA(1, 0, At, B0); PG8_BAR; PG8_SCHED;
            PG8_STAGE(PG8_SB(1, 1), b3 + hstepB, voffB1);
            PG8_WAIT_V(6); PG8_BAR; PG8_MMA(1, 1, At, B1); PG8_BAR;
            }
        }
        if constexpr (ALIGN_EPI) { if (wr == 0) PG8_BAR; }
        E.fin(acc, cur, wr, wc, fr, fq);
        if (!has_next) break;
#pragma unroll
        for (int a = 0; a < 2; ++a)
#pragma unroll
            for (int b = 0; b < 2; ++b)
#pragma unroll
                for (int m = 0; m < 4; ++m)
#pragma unroll
                    for (int n = 0; n < 2; ++n) acc[a][b][m][n] = (f32x4){0.f, 0.f, 0.f, 0.f};
        cur = nxt; cA = nA; cB = nB; ++ui;
        if constexpr (ALIGN_EPI) { if (wr == 1) PG8_BAR; }
    }
    PG8_WAIT_V(0);
    if constexpr (!ALIGN_EPI) { if (wr == 0) PG8_BAR; }
    PG8_BAR;
#undef PG8_SA
#undef PG8_SB
#undef PG8_STAGE
#undef PG8_LDA
#undef PG8_LDB
#undef PG8_MMA
#undef PG8_WAIT_V
#undef PG8_WAIT_L
#undef PG8_BAR
#undef PG8_SCHED
}

__device__ __forceinline__ f32x4 ror8(const f32x4 v) { f32x4 r;
#pragma unroll
    for (int j = 0; j < 4; ++j) r[j] = __int_as_float(__builtin_amdgcn_update_dpp(0, __float_as_int(v[j]), 0x128, 0xF, 0xF, false));
    return r; }
__device__ __forceinline__ u32x4 ror8u(const u32x4 v) { u32x4 r;
#pragma unroll
    for (int j = 0; j < 4; ++j) r[j] = (unsigned)__builtin_amdgcn_update_dpp(0, (int)v[j], 0x128, 0xF, 0xF, false);
    return r; }
__device__ __forceinline__ void store_pair128(bf16_t* p, int pitch, bool hi, const u32x4 w0, const u32x4 w1) {
    const u32x4 rc = ror8u(hi ? w0 : w1);
    *(u32x4*)p = hi ? rc : w0; *(u32x4*)(p + 8 * (size_t)pitch) = hi ? w1 : rc;
}
struct EpiProj {
    static constexpr bool PERM = true, HAS_MID = false, ADJ = true; static constexpr int MID_T = -1;
    bf16_t* proj; bf16_t* gates; const float* bgate; const float* qgain; const float* kgain; float* kmean; float* X; const f32x2* rope;
    __device__ __forceinline__ void mid(Acc&, const Unit&, int, int, int, int) const {}
    __device__ __forceinline__ void fin(const Acc& acc, const Unit& u, int wr, int wc, int fr, int fq) const {
        asm volatile("" : "+v"(fr), "+v"(fq));
        const bool hi = fr >= 8;
        const int rowl = wr * 64 + fr;
        const int rows = u.pm * BM + wr * 64 + (fr & 7);
        const int colw = u.pn * BM + wc * 64 + 8 * fq;
        const int cols = colw + (hi ? 32 : 0);
        if (u.pn < 2 * RET_QKW / BM) {
            const bool iskr = u.pn >= RET_QKW / BM;
            const float lg2h = __builtin_log2f(1.f - __builtin_amdgcn_exp2f(-5.f - (float)(2 * (u.pn & 1) + (wc >> 1))));
            const int dl = 32 * (wc & 1) + 8 * fq;
            bf16_t* pbase = proj + (size_t)(u.pm * BM + rowl) * DIN + u.pn * BM + 128 * (wc >> 1) + dl;
            const f32x2* rbase = rope + (size_t)((u.pm * BM + rowl) & (SEQ - 1)) * 64 + dl;
#pragma unroll
            for (int ai = 0; ai < 2; ++ai) {
                f32x4 cst[4][4];
#pragma unroll
                for (int m = 0; m < 4; ++m) { const f32x4* cs = (const f32x4*)(rbase + (size_t)(ai * HALF + m * 16) * 64);
#pragma unroll
                    for (int j = 0; j < 4; ++j) cst[m][j] = cs[j]; }
#pragma unroll
                for (int m = 0; m < 4; ++m) {
                    bf16_t* p = pbase + (size_t)(ai * HALF + m * 16) * DIN;
                    const float ks = iskr ? 0.08838834764831845f * __builtin_amdgcn_exp2f(lg2h * (float)(127 - (rowl + 16 * m))) : 1.f;
#pragma unroll
                    for (int n = 0; n < 2; ++n) { const f32x4 t0 = cst[m][2 * n], t1 = cst[m][2 * n + 1]; const f32x4 x1 = acc[ai][0][m][n], x2 = acc[ai][1][m][n];
                        u32x2 lo, hi2;
                        lo.x = pk2((x1[0] * t0[0] - x2[0] * t0[1]) * ks, (x1[1] * t0[2] - x2[1] * t0[3]) * ks); lo.y = pk2((x1[2] * t1[0] - x2[2] * t1[1]) * ks, (x1[3] * t1[2] - x2[3] * t1[3]) * ks);
                        hi2.x = pk2((x1[0] * t0[1] + x2[0] * t0[0]) * ks, (x1[1] * t0[3] + x2[1] * t0[2]) * ks); hi2.y = pk2((x1[2] * t1[1] + x2[2] * t1[0]) * ks, (x1[3] * t1[3] + x2[3] * t1[2]) * ks);
                        *(u32x2*)(p + 4 * n) = lo; *(u32x2*)(p + 64 + 4 * n) = hi2; }
                }
                asm volatile("" ::: "memory");
            }
        } else if (u.pn >= C_QM / BM && u.pn < C_VM / BM) {
            const bool isk = u.pn >= C_KM / BM;
#pragma unroll
            for (int ai = 0; ai < 2; ++ai)
#pragma unroll
                for (int m = 0; m < 4; ++m) { float s = 0.f;
#pragma unroll
                    for (int bj = 0; bj < 2; ++bj) { const f32x4 v0 = acc[ai][bj][m][0], v1 = acc[ai][bj][m][1];
                        s += (v0[0] * v0[0] + v0[1] * v0[1]) + (v0[2] * v0[2] + v0[3] * v0[3]) + (v1[0] * v1[0] + v1[1] * v1[1]) + (v1[2] * v1[2] + v1[3] * v1[3]); }
                    s += __shfl_xor(s, 16); s += __shfl_xor(s, 32);
                    if (fq == 0) X[(ai * HALF + m * 16 + rowl) * 4 + wc] = s; }
            asm volatile("s_waitcnt lgkmcnt(0)" ::: "memory"); __builtin_amdgcn_s_barrier(); asm volatile("" ::: "memory");
            const int dw = (wc & 1) * 64 + 8 * fq;
            const float* gp = (isk ? kgain : qgain) + dw;
            f32x4 g[2][2];
#pragma unroll
            for (int bj = 0; bj < 2; ++bj) { g[bj][0] = *(const f32x4*)(gp + 32 * bj); g[bj][1] = *(const f32x4*)(gp + 32 * bj + 4); }
            f32x4 cs[2][2];
#pragma unroll
            for (int bj = 0; bj < 2; ++bj) { cs[bj][0] = (f32x4){0.f, 0.f, 0.f, 0.f}; cs[bj][1] = (f32x4){0.f, 0.f, 0.f, 0.f}; }
#pragma unroll
            for (int ai = 0; ai < 2; ++ai)
#pragma unroll
                for (int m = 0; m < 4; ++m) { const f32x2 p = *(const f32x2*)(X + (ai * HALF + m * 16 + rowl) * 4 + (wc & 2));
                    const float rstd = 1.f / sqrtf((p[0] + p[1]) * (1.f / 128.f) + EPS);
                    u32x4 w[2];
#pragma unroll
                    for (int bj = 0; bj < 2; ++bj) { const f32x4 v0 = acc[ai][bj][m][0] * rstd * g[bj][0], v1 = acc[ai][bj][m][1] * rstd * g[bj][1]; cs[bj][0] += v0; cs[bj][1] += v1;
                        w[bj].x = pk2(v0[0], v0[1]); w[bj].y = pk2(v0[2], v0[3]); w[bj].z = pk2(v1[0], v1[1]); w[bj].w = pk2(v1[2], v1[3]); }
                    store_pair128(proj + (size_t)(rows + ai * HALF + m * 16) * DIN + cols, DIN, hi, w[0], w[1]);
                    asm volatile("" : "+v"(cs[0][0]), "+v"(cs[0][1]), "+v"(cs[1][0]), "+v"(cs[1][1])); }
            if (isk) {
#pragma unroll
                for (int bj = 0; bj < 2; ++bj)
#pragma unroll
                    for (int n = 0; n < 2; ++n)
#pragma unroll
                        for (int i = 0; i < 4; ++i) { float s = cs[bj][n][i]; s += __shfl_xor(s, 1); s += __shfl_xor(s, 2); s += __shfl_xor(s, 4); s += __shfl_xor(s, 8); cs[bj][n][i] = s; }
                if (fr == 0) {
                    const int bb = u.pm >> 3, blk = u.pm & 7, head = 2 * (u.pn - C_KM / BM) + (wc >> 1);
                    float* kp = kmean + (((size_t)bb * 8 + head) * 8 + blk) * 128 + dw;
#pragma unroll
                    for (int bj = 0; bj < 2; ++bj)
#pragma unroll
                        for (int n = 0; n < 2; ++n)
#pragma unroll
                            for (int i = 0; i < 4; ++i) atomicAdd(kp + 32 * bj + 4 * n + i, cs[bj][n][i] * (1.f / 256.f));
                }
            }
        } else if (u.pn < DIN / BM) {
#pragma unroll
            for (int ai = 0; ai < 2; ++ai)
#pragma unroll
                for (int m = 0; m < 4; ++m) { u32x4 w[2];
#pragma unroll
                    for (int bj = 0; bj < 2; ++bj) { const f32x4 v0 = acc[ai][bj][m][0], v1 = acc[ai][bj][m][1]; w[bj].x = pk2(v0[0], v0[1]); w[bj].y = pk2(v0[2], v0[3]); w[bj].z = pk2(v1[0], v1[1]); w[bj].w = pk2(v1[2], v1[3]); }
                    store_pair128(proj + (size_t)(rows + ai * HALF + m * 16) * DIN + cols, DIN, hi, w[0], w[1]); }
        } else {
            const int gcw = colw - DIN;
            f32x4 bv[2][2];
#pragma unroll
            for (int bj = 0; bj < 2; ++bj)
#pragma unroll
                for (int n = 0; n < 2; ++n) bv[bj][n] = *(const f32x4*)(bgate + gcw + 32 * bj + 4 * n);
#pragma unroll
            for (int ai = 0; ai < 2; ++ai)
#pragma unroll
                for (int m = 0; m < 4; ++m) { u32x4 w[2];
#pragma unroll
                    for (int bj = 0; bj < 2; ++bj) { const f32x4 v0 = acc[ai][bj][m][0] + bv[bj][0], v1 = acc[ai][bj][m][1] + bv[bj][1];
                        w[bj].x = pk2(fsigmoid(v0[0]), fsigmoid(v0[1])); w[bj].y = pk2(fsigmoid(v0[2]), fsigmoid(v0[3])); w[bj].z = pk2(fsigmoid(v1[0]), fsigmoid(v1[1])); w[bj].w = pk2(fsigmoid(v1[2]), fsigmoid(v1[3])); }
                    store_pair128(gates + (size_t)(rows + ai * HALF + m * 16) * NGATE + (cols - DIN), NGATE, hi, w[0], w[1]); }
        }
    }
};
struct EpiBf16 {
    static constexpr bool PERM = true, HAS_MID = false, ADJ = false; static constexpr int MID_T = -1;
    bf16_t* O; int ldc;
    __device__ __forceinline__ void mid(Acc&, const Unit&, int, int, int, int) const {}
    __device__ __forceinline__ void fin(const Acc& acc, const Unit& u, int wr, int wc, int fr, int fq) const {
        asm volatile("" : "+v"(fr), "+v"(fq));
        const int row0 = u.pm * BM + wr * 64 + fr; const int col0 = u.pn * BM + wc * 32 + 8 * fq;
#pragma unroll
        for (int ai = 0; ai < 2; ++ai)
#pragma unroll
            for (int m = 0; m < 4; ++m) { bf16_t* rowp = O + (size_t)(row0 + ai * HALF + m * 16) * ldc + col0;
#pragma unroll
                for (int bj = 0; bj < 2; ++bj) { const f32x4 v0 = acc[ai][bj][m][0], v1 = acc[ai][bj][m][1]; u32x4 w; w.x = pk2(v0[0], v0[1]); w.y = pk2(v0[2], v0[3]); w.z = pk2(v1[0], v1[1]); w.w = pk2(v1[2], v1[3]);
                    *(u32x4*)(rowp + bj * HALF) = w; } }
    }
};
struct EpiMerge {
    static constexpr bool PERM = true, HAS_MID = true, ADJ = true; static constexpr int MID_T = 16;
    const bf16_t* gates; bf16_t* O;
    static __device__ __forceinline__ void unswap(bool hi, const u32x4 l1, const u32x4 l2, u32x4& b0, u32x4& b1) { const u32x4 rc = ror8u(hi ? l1 : l2); b0 = hi ? rc : l1; b1 = hi ? l2 : rc; }
    __device__ __forceinline__ void mid(Acc& acc, const Unit& u, int wr, int wc, int fr, int fq) const {
        asm volatile("" : "+v"(fr), "+v"(fq));
        const bool hi = fr >= 8;
        const bf16_t* gbase = gates + (size_t)(u.pm * BM + wr * 64 + (fr & 7)) * NGATE + u.pn * BM + wc * 64 + 8 * fq + (hi ? 32 : 0);
#pragma unroll
        for (int ai = 0; ai < 2; ++ai) {
            u32x4 r1[4], r2[4], m1[4], m2[4];
#pragma unroll
            for (int m = 0; m < 4; ++m) { const bf16_t* gp = gbase + (size_t)(ai * HALF + m * 16) * NGATE;
                r1[m] = *(const u32x4*)gp; r2[m] = *(const u32x4*)(gp + 8 * NGATE); m1[m] = *(const u32x4*)(gp + DM); m2[m] = *(const u32x4*)(gp + 8 * NGATE + DM); }
#pragma unroll
            for (int m = 0; m < 4; ++m) { u32x4 gr[2], gm[2]; unswap(hi, r1[m], r2[m], gr[0], gr[1]); unswap(hi, m1[m], m2[m], gm[0], gm[1]);
#pragma unroll
                for (int bj = 0; bj < 2; ++bj) { float a[8], b[8]; unpack8(gr[bj], a); unpack8(gm[bj], b);
                    f32x4 q0, q1;
#pragma unroll
                    for (int j = 0; j < 4; ++j) { q0[j] = a[j] * __builtin_amdgcn_rcpf(fmaxf(b[j], 1e-30f)); q1[j] = a[4 + j] * __builtin_amdgcn_rcpf(fmaxf(b[4 + j], 1e-30f)); }
                    acc[ai][bj][m][0] *= q0; acc[ai][bj][m][1] *= q1; } }
            asm volatile("" ::: "memory");
        }
    }
    __device__ __forceinline__ void fin(const Acc& acc, const Unit& u, int wr, int wc, int fr, int fq) const {
        asm volatile("" : "+v"(fr), "+v"(fq));
        const bool hi = fr >= 8;
        const size_t rs = (size_t)(u.pm * BM + wr * 64 + (fr & 7)); const int cs = u.pn * BM + wc * 64 + 8 * fq + (hi ? 32 : 0);
#pragma unroll
        for (int ai = 0; ai < 2; ++ai)
#pragma unroll
            for (int m = 0; m < 4; ++m) { const size_t r = rs + ai * HALF + m * 16; const bf16_t* gp = gates + r * NGATE + DM + cs;
                u32x4 gm[2]; unswap(hi, *(const u32x4*)gp, *(const u32x4*)(gp + 8 * NGATE), gm[0], gm[1]);
                u32x4 w[2];
#pragma unroll
                for (int bj = 0; bj < 2; ++bj) { float b[8]; unpack8(gm[bj], b); const f32x4 v0 = acc[ai][bj][m][0], v1 = acc[ai][bj][m][1];
                    w[bj].x = pk2(v0[0] * b[0], v0[1] * b[1]); w[bj].y = pk2(v0[2] * b[2], v0[3] * b[3]); w[bj].z = pk2(v1[0] * b[4], v1[1] * b[5]); w[bj].w = pk2(v1[2] * b[6], v1[3] * b[7]); }
                store_pair128(O + r * DM + cs, DM, hi, w[0], w[1]); }
    }
};
struct EpiResid {
    static constexpr bool PERM = false, HAS_MID = false, ADJ = false; static constexpr int MID_T = -1;
    const bf16_t* base; float* out;
    __device__ __forceinline__ void mid(Acc&, const Unit&, int, int, int, int) const {}
    __device__ __forceinline__ void fin(const Acc& acc, const Unit& u, int wr, int wc, int fr, int fq) const {
        asm volatile("" : "+v"(fr), "+v"(fq));
        const bool hi = fr >= 8;
        const int row0 = u.pm * BM + wr * 64 + (fr & 7); const int col0 = u.pn * BM + wc * 32 + (hi ? 16 : 0) + 4 * fq;
#pragma unroll
        for (int ai = 0; ai < 2; ++ai)
#pragma unroll
            for (int m = 0; m < 4; ++m) { const size_t off = (size_t)(row0 + ai * HALF + m * 16) * DM + col0;
#pragma unroll
                for (int bj = 0; bj < 2; ++bj) { const f32x4 a0 = acc[ai][bj][m][0], a1 = acc[ai][bj][m][1]; const f32x4 rc = ror8(hi ? a0 : a1);
                    const f32x4 first = hi ? rc : a0, second = hi ? a1 : rc;
                    const u32x2 p1 = *(const u32x2*)(base + off + bj * HALF), p2 = *(const u32x2*)(base + off + 8 * DM + bj * HALF);
                    const f32x4 b1 = (f32x4){bflo(p1.x), bfhi(p1.x), bflo(p1.y), bfhi(p1.y)}, b2 = (f32x4){bflo(p2.x), bfhi(p2.x), bflo(p2.y), bfhi(p2.y)};
                    *(f32x4*)(out + off + bj * HALF) = b1 + first; *(f32x4*)(out + off + 8 * DM + bj * HALF) = b2 + second; } }
    }
};

struct EpiConv {
    static constexpr bool PERM = false, HAS_MID = false, ADJ = false; static constexpr int MID_T = -1;
    bf16_t* act; float* UH; const float* cw; const float* cb; f32x2* X; const float* rstd;
    __device__ __forceinline__ void mid(Acc&, const Unit&, int, int, int, int) const {}
    __device__ __forceinline__ void fin(Acc& acc, const Unit& u, int wr, int wc, int fr, int fq) const {
        asm volatile("" : "+v"(fr), "+v"(fq));
        const int lane = fr + 16 * fq, src_lane = (lane - 16) & 63;
        float cp[2][8];
#pragma unroll
        for (int n = 0; n < 2; ++n) { const int c = u.pn * HALF + wc * 32 + n * 16 + fr;
            cp[n][0] = cb[c]; cp[n][1] = cw[c]; cp[n][2] = cw[NUP + c]; cp[n][3] = cw[2 * NUP + c];
            cp[n][4] = cb[DFF + c]; cp[n][5] = cw[DFF + c]; cp[n][6] = cw[NUP + DFF + c]; cp[n][7] = cw[2 * NUP + DFF + c]; }
        f32x4 rsv[2][4];
#pragma unroll
        for (int ai = 0; ai < 2; ++ai)
#pragma unroll
            for (int m = 0; m < 4; ++m) rsv[ai][m] = *(const f32x4*)(rstd + u.pm * BM + ai * HALF + wr * 64 + 16 * m + 4 * fq);
#pragma unroll
        for (int ai = 0; ai < 2; ++ai)
#pragma unroll
            for (int m = 0; m < 4; ++m) { const f32x4 rs = rsv[ai][m];
#pragma unroll
                for (int bj = 0; bj < 2; ++bj)
#pragma unroll
                    for (int n = 0; n < 2; ++n) acc[ai][bj][m][n] *= rs; }
        if (fq == 3) {
#pragma unroll
            for (int ai = 0; ai < 2; ++ai)
#pragma unroll
                for (int bj = 0; bj < 2; ++bj)
#pragma unroll
                    for (int n = 0; n < 2; ++n) X[((((ai * 2 + wr) * 2 + bj) * 4 + wc) * 2 + n) * 16 + fr] = (f32x2){acc[ai][bj][3][n][2], acc[ai][bj][3][n][3]};
        }
        {
            const int colt = u.pn * BM + wc * 32 + fr;
            if (wr == 0 && fq == 0) {
#pragma unroll
                for (int bj = 0; bj < 2; ++bj)
#pragma unroll
                    for (int n = 0; n < 2; ++n) { UH[((size_t)u.pm * 4 + 0) * NUP + colt + bj * HALF + n * 16] = acc[0][bj][0][n][0]; UH[((size_t)u.pm * 4 + 1) * NUP + colt + bj * HALF + n * 16] = acc[0][bj][0][n][1]; }
            }
            if (wr == 1 && fq == 3) {
#pragma unroll
                for (int bj = 0; bj < 2; ++bj)
#pragma unroll
                    for (int n = 0; n < 2; ++n) { UH[((size_t)u.pm * 4 + 2) * NUP + colt + bj * HALF + n * 16] = acc[1][bj][3][n][2]; UH[((size_t)u.pm * 4 + 3) * NUP + colt + bj * HALF + n * 16] = acc[1][bj][3][n][3]; }
            }
        }
        asm volatile("s_waitcnt lgkmcnt(0)" ::: "memory"); __builtin_amdgcn_s_barrier(); asm volatile("" ::: "memory");
#pragma unroll
        for (int n = 0; n < 2; ++n) {
            const int c = u.pn * HALF + wc * 32 + n * 16 + fr;
            const float gb = cp[n][0], g0 = cp[n][1], g1 = cp[n][2], g2 = cp[n][3];
            const float vb = cp[n][4], v0 = cp[n][5], v1 = cp[n][6], v2 = cp[n][7];
#pragma unroll
            for (int ai = 0; ai < 2; ++ai) {
                f32x2 xg = (f32x2){0.f, 0.f}, xv = (f32x2){0.f, 0.f};
                if (!(ai == 0 && wr == 0)) { const int sa = wr ? ai : ai - 1, sw = wr ? 0 : 1;
                    xg = X[((((sa * 2 + sw) * 2 + 0) * 4 + wc) * 2 + n) * 16 + fr]; xv = X[((((sa * 2 + sw) * 2 + 1) * 4 + wc) * 2 + n) * 16 + fr]; }
                bf16_t* ap = act + (size_t)(u.pm * BM + ai * HALF + wr * 64 + 4 * fq) * DFF + c;
#pragma unroll
                for (int m = 0; m < 4; ++m) {
                    const f32x4 a = acc[ai][0][m][n], b = acc[ai][1][m][n];
                    const f32x4 pa = acc[ai][0][m > 0 ? m - 1 : 0][n], pb = acc[ai][1][m > 0 ? m - 1 : 0][n];
                    const bool up = (fq == 3) && (m > 0);
                    float a2 = __shfl(up ? pa[2] : a[2], src_lane), a1 = __shfl(up ? pa[3] : a[3], src_lane);
                    float b2 = __shfl(up ? pb[2] : b[2], src_lane), b1 = __shfl(up ? pb[3] : b[3], src_lane);
                    if (m == 0 && fq == 0) { a2 = xg.x; a1 = xg.y; b2 = xv.x; b1 = xv.y; }
                    const float og0 = gb + g0 * a2 + g1 * a1 + g2 * a[0], og1 = gb + g0 * a1 + g1 * a[0] + g2 * a[1], og2 = gb + g0 * a[0] + g1 * a[1] + g2 * a[2], og3 = gb + g0 * a[1] + g1 * a[2] + g2 * a[3];
                    const float ov0 = vb + v0 * b2 + v1 * b1 + v2 * b[0], ov1 = vb + v0 * b1 + v1 * b[0] + v2 * b[1], ov2 = vb + v0 * b[0] + v1 * b[1] + v2 * b[2], ov3 = vb + v0 * b[1] + v1 * b[2] + v2 * b[3];
                    const unsigned w01 = pk2(og0 * fsigmoid(og0) * ov0, og1 * fsigmoid(og1) * ov1), w23 = pk2(og2 * fsigmoid(og2) * ov2, og3 * fsigmoid(og3) * ov3);
                    bf16_t* rp = ap + (size_t)(16 * m) * DFF;
                    rp[0] = (bf16_t)(w01 & 0xffffu); rp[DFF] = (bf16_t)(w01 >> 16); rp[2 * DFF] = (bf16_t)(w23 & 0xffffu); rp[3 * DFF] = (bf16_t)(w23 >> 16);
                }
            }
        }
    }
};

struct EpiResidNorm {
    static constexpr bool PERM = false, HAS_MID = false, ADJ = false; static constexpr int MID_T = -1;
    const float* base; bf16_t* xb; float* ss;
    __device__ __forceinline__ void mid(Acc&, const Unit&, int, int, int, int) const {}
    __device__ __forceinline__ void fin(const Acc& acc, const Unit& u, int wr, int wc, int fr, int fq) const {
        asm volatile("" : "+v"(fr), "+v"(fq));
        const bool hi = fr >= 8;
        const int row0 = u.pm * BM + wr * 64 + (fr & 7); const int col0 = u.pn * BM + wc * 32 + (hi ? 16 : 0) + 4 * fq;
#pragma unroll
        for (int ai = 0; ai < 2; ++ai)
#pragma unroll
            for (int m = 0; m < 4; ++m) { const int row = row0 + ai * HALF + m * 16; const size_t off = (size_t)row * DM + col0; float s1 = 0.f, s2 = 0.f;
#pragma unroll
                for (int bj = 0; bj < 2; ++bj) { const f32x4 a0 = acc[ai][bj][m][0], a1 = acc[ai][bj][m][1]; const f32x4 rc = ror8(hi ? a0 : a1);
                    const f32x4 first = hi ? rc : a0, second = hi ? a1 : rc;
                    const f32x4 v1 = *(const f32x4*)(base + off + bj * HALF) + first, v2 = *(const f32x4*)(base + off + 8 * DM + bj * HALF) + second;
                    s1 += (v1[0] * v1[0] + v1[1] * v1[1]) + (v1[2] * v1[2] + v1[3] * v1[3]); s2 += (v2[0] * v2[0] + v2[1] * v2[1]) + (v2[2] * v2[2] + v2[3] * v2[3]);
                    u32x2 w1; w1.x = pk2(v1[0], v1[1]); w1.y = pk2(v1[2], v1[3]); *(u32x2*)(xb + off + bj * HALF) = w1;
                    u32x2 w2; w2.x = pk2(v2[0], v2[1]); w2.y = pk2(v2[2], v2[3]); *(u32x2*)(xb + off + 8 * DM + bj * HALF) = w2; }
                s1 += __shfl_xor(s1, 8); s1 += __shfl_xor(s1, 16); s1 += __shfl_xor(s1, 32); s2 += __shfl_xor(s2, 8); s2 += __shfl_xor(s2, 16); s2 += __shfl_xor(s2, 32);
                if (fq == 0 && !hi) { ss[(size_t)row * 16 + u.pn * 4 + wc] = s1; ss[(size_t)(row + 8) * 16 + u.pn * 4 + wc] = s2; } }
    }
};
}

__device__ __forceinline__ float wave_sum(float v) {
#pragma unroll
    for (int o = 1; o < 64; o <<= 1) v += __shfl_xor(v, o);
    return v;
}
template <int UPPERM = 0>
__device__ __forceinline__ void transpose_item(const float* W, int K, int N, bf16_t* WT, int ldt, int row_off, int col_off, float* scr, int item, int lane, const float* kgain = nullptr) {
    const int nblk = N / 32, kb = item / nblk, nb = item % nblk, k0 = 64 * kb, n0 = 32 * nb;
    int d0 = n0;
    if (UPPERM == 1) { const int isv = n0 >= DFF ? 1 : 0, c = n0 - isv * DFF; d0 = 256 * (c >> 7) + 128 * isv + (c & 127); }
    if (UPPERM == 2) { if (n0 < 2 * RET_QKW) { const int dd = n0 & 127; d0 = (n0 & ~127) + 64 * ((dd & 63) >> 5) + 32 * (dd >> 6); } }
    float wv[32];
#pragma unroll
    for (int i = 0; i < 32; ++i) { const int kk = 2 * i + (lane >> 5); wv[i] = W[(size_t)(k0 + kk) * N + n0 + (lane & 31)]; }
    if (kgain) {
#pragma unroll
        for (int i = 0; i < 32; ++i) wv[i] *= kgain[k0 + 2 * i + (lane >> 5)];
    }
#pragma unroll
    for (int i = 0; i < 32; ++i) scr[(2 * i + (lane >> 5)) * 33 + (lane & 31)] = wv[i];
    LDS_WAIT();
    const int c = lane & 7;
#pragma unroll
    for (int j = 0; j < 4; ++j) { const int n = (lane >> 3) + 8 * j; const float* s = scr + (8 * c) * 33 + n;
        u32x4 o; o.x = pk2(s[0 * 33], s[1 * 33]); o.y = pk2(s[2 * 33], s[3 * 33]); o.z = pk2(s[4 * 33], s[5 * 33]); o.w = pk2(s[6 * 33], s[7 * 33]);
        *(u32x4*)(WT + (size_t)(row_off + d0 + n) * ldt + col_off + k0 + 8 * c) = o; }
    LDS_WAIT();
}
__device__ __forceinline__ void rms_row_to_bf16(const float* xrow, const float* gain, bf16_t* orow, int lane) {
    const f32x4* xr = (const f32x4*)xrow + lane; const f32x4* gr = (const f32x4*)gain + lane;
    f32x4 v[4]; float s = 0.f;
#pragma unroll
    for (int j = 0; j < 4; ++j) { v[j] = xr[64 * j]; s += (v[j].x * v[j].x + v[j].y * v[j].y) + (v[j].z * v[j].z + v[j].w * v[j].w); }
    const float rstd = 1.f / sqrtf(wave_sum(s) * (1.f / DM) + EPS);
    u32x2* o8 = (u32x2*)orow + lane;
#pragma unroll
    for (int j = 0; j < 4; ++j) { const f32x4 gg = gr[64 * j]; u32x2 w; w.x = pk2(v[j].x * rstd * gg.x, v[j].y * rstd * gg.y); w.y = pk2(v[j].z * rstd * gg.z, v[j].w * rstd * gg.w); o8[64 * j] = w; }
}

__device__ __forceinline__ void retention_item(unsigned char* lds, bf16_t* proj, const f32x2* rope, f32x2* stats, int b, int h, int sl, bf16_t* dry = nullptr) {
    int tid_ = threadIdx.x; asm volatile("" : "+v"(tid_));
    const int tid = tid_, lane = tid & 63, w = __builtin_amdgcn_readfirstlane(tid >> 6), l15 = lane & 15, quad = lane >> 4;
    constexpr int P = 136, VPR = 96;
    bf16_t* Qs = (bf16_t*)lds;
    bf16_t* Kz = Qs + 128 * P;
    bf16_t* Vs = Kz + 128 * P;
    bf16_t* RsT = Vs + 128 * VPR;
    const float lg2 = __builtin_log2f(1.f - __builtin_amdgcn_exp2f(-5.f - (float)h));
    const float gamma_c = __builtin_amdgcn_exp2f(lg2 * 128.f);
    const float kscale = 0.08838834764831845f;
    for (int i = tid; i < 64 * P / 2; i += 512) ((unsigned*)RsT)[i] = 0u;
    f32x4 accR[4];
#pragma unroll
    for (int i = 0; i < 4; ++i) accR[i] = (f32x4){0.f, 0.f, 0.f, 0.f};
    const size_t rowbase = (size_t)b * SEQ;
    u32x4 rq1[2], rq2[2], rk1[2], rk2[2], rv[2];
#define RET_LOAD(n_) do { _Pragma("unroll") for (int k_ = 0; k_ < 2; ++k_) { const int i_ = tid + 512 * k_, r_ = i_ >> 3, g_ = i_ & 7; \
        const bf16_t* qp_ = proj + (rowbase + (n_) * 128 + r_) * DIN + C_QR + h * 128 + 8 * g_; \
        rq1[k_] = *(const u32x4*)qp_; rq2[k_] = *(const u32x4*)(qp_ + 64); rk1[k_] = *(const u32x4*)(qp_ + C_KR); rk2[k_] = *(const u32x4*)(qp_ + C_KR + 64); \
        rv[k_] = *(const u32x4*)(proj + (rowbase + (n_) * 128 + r_) * DIN + C_VR + h * 256 + sl * 64 + 8 * g_); } } while (0)
    RET_LOAD(0);
    const LAS bf16_t* VsL = (const LAS bf16_t*)Vs; const LAS bf16_t* KzL = (const LAS bf16_t*)Kz;
    const int trr = l15 >> 2, trc = 4 * (l15 & 3);
    for (int n = 0; n < 16; ++n) {
        const int t0 = n * 128;
#pragma unroll
        for (int k = 0; k < 2; ++k) {
            const int i = tid + 512 * k, r = i >> 3, g8 = i & 7;
            *(u32x4*)(Qs + r * P + 8 * g8) = rq1[k]; *(u32x4*)(Qs + r * P + 64 + 8 * g8) = rq2[k];
            *(u32x4*)(Kz + r * P + 8 * g8) = rk1[k]; *(u32x4*)(Kz + r * P + 64 + 8 * g8) = rk2[k];
            *(u32x4*)(Vs + r * VPR + 8 * g8) = rv[k];
        }
        __syncthreads();
        if (n + 1 < 16) RET_LOAD(n + 1);
        bf16x8 qf[4];
#pragma unroll
        for (int s = 0; s < 4; ++s) qf[s] = *(const bf16x8*)(Qs + (16 * w + l15) * P + 32 * s + 8 * quad);
        u32x4 pf[4];
#pragma unroll
        for (int s = 0; s < 4; ++s) pf[s] = (u32x4){0u, 0u, 0u, 0u};
        const int qpos = 16 * w + l15;
        const float qfac = __builtin_amdgcn_exp2f(lg2 * (float)(qpos - 127));
#pragma unroll
        for (int kb = 0; kb < 8; ++kb) {
            if (kb <= w) {
                f32x4 a = (f32x4){0.f, 0.f, 0.f, 0.f};
#pragma unroll
                for (int s = 0; s < 4; ++s) { const bf16x8 kf = *(const bf16x8*)(Kz + (16 * kb + l15) * P + 32 * s + 8 * quad); a = __builtin_amdgcn_mfma_f32_16x16x32_bf16(kf, qf[s], a, 0, 0, 0); }
                float pv[4];
#pragma unroll
                for (int i = 0; i < 4; ++i) pv[i] = (qpos >= 16 * kb + 4 * quad + i) ? a[i] * qfac : 0.f;
                if (kb & 1) { pf[kb >> 1].z = pk2(pv[0], pv[1]); pf[kb >> 1].w = pk2(pv[2], pv[3]); } else { pf[kb >> 1].x = pk2(pv[0], pv[1]); pf[kb >> 1].y = pk2(pv[2], pv[3]); }
            }
        }
        f32x4 ao[4], ac[4];
#pragma unroll
        for (int i = 0; i < 4; ++i) { ao[i] = (f32x4){0.f, 0.f, 0.f, 0.f}; ac[i] = (f32x4){0.f, 0.f, 0.f, 0.f}; }
#pragma unroll
        for (int s2 = 0; s2 < 4; ++s2) {
            if (2 * s2 <= w) {
#pragma unroll
                for (int dvb = 0; dvb < 4; ++dvb) { const LAS bf16_t* vp = VsL + (32 * s2 + 4 * quad + trr) * VPR + 16 * dvb + trc;
                    const s16x4 lo = __builtin_amdgcn_ds_read_tr16_b64_v4i16((LAS s16x4*)vp), hi = __builtin_amdgcn_ds_read_tr16_b64_v4i16((LAS s16x4*)(vp + 16 * VPR));
                    const bf16x8 va = __builtin_shufflevector(lo, hi, 0, 1, 2, 3, 4, 5, 6, 7);
                    ao[dvb] = __builtin_amdgcn_mfma_f32_16x16x32_bf16(va, __builtin_bit_cast(bf16x8, pf[s2]), ao[dvb], 0, 0, 0); }
            }
        }
#pragma unroll
        for (int s = 0; s < 4; ++s)
#pragma unroll
            for (int dvb = 0; dvb < 4; ++dvb) { const bf16x8 ra = *(const bf16x8*)(RsT + (16 * dvb + l15) * P + 32 * s + 8 * quad); ac[dvb] = __builtin_amdgcn_mfma_f32_16x16x32_bf16(ra, qf[s], ac[dvb], 0, 0, 0); }
        const float xi = __builtin_amdgcn_exp2f(lg2 * (float)(qpos + 1));
        float s1 = 0.f, s2s = 0.f;
        bf16_t* op = dry ? dry + tid * 128 : proj + (rowbase + t0 + qpos) * DIN + C_VR + h * 256 + sl * 64 + 4 * quad;
#pragma unroll
        for (int dvb = 0; dvb < 4; ++dvb) { const f32x4 o = ao[dvb] + ac[dvb] * xi; s1 += (o[0] + o[1]) + (o[2] + o[3]); s2s += (o[0] * o[0] + o[1] * o[1]) + (o[2] * o[2] + o[3] * o[3]);
            u32x2 wv; wv.x = pk2(o[0], o[1]); wv.y = pk2(o[2], o[3]); *(u32x2*)(op + 16 * dvb) = wv; }
        s1 += __shfl_xor(s1, 16); s1 += __shfl_xor(s1, 32); s2s += __shfl_xor(s2s, 16); s2s += __shfl_xor(s2s, 32);
        if (quad == 0) { if (dry) ((f32x2*)dry)[65536 + tid] = (f32x2){s1, s2s}; else stats[((rowbase + t0 + qpos) * 4 + h) * 4 + sl] = (f32x2){s1, s2s}; }
#pragma unroll
        for (int dvb = 0; dvb < 4; ++dvb) accR[dvb] *= gamma_c;
#pragma unroll
        for (int s = 0; s < 4; ++s) { const LAS bf16_t* kp = KzL + (32 * s + 8 * quad + trr) * P + 16 * w + trc;
            const s16x4 klo = __builtin_amdgcn_ds_read_tr16_b64_v4i16((LAS s16x4*)kp), khi = __builtin_amdgcn_ds_read_tr16_b64_v4i16((LAS s16x4*)(kp + 4 * P));
            const bf16x8 ka = __builtin_shufflevector(klo, khi, 0, 1, 2, 3, 4, 5, 6, 7);
#pragma unroll
            for (int dvb = 0; dvb < 4; ++dvb) { const LAS bf16_t* vp = VsL + (32 * s + 8 * quad + trr) * VPR + 16 * dvb + trc;
                const s16x4 vlo = __builtin_amdgcn_ds_read_tr16_b64_v4i16((LAS s16x4*)vp), vhi = __builtin_amdgcn_ds_read_tr16_b64_v4i16((LAS s16x4*)(vp + 4 * VPR));
                const bf16x8 vb = __builtin_shufflevector(vlo, vhi, 0, 1, 2, 3, 4, 5, 6, 7);
                accR[dvb] = __builtin_amdgcn_mfma_f32_16x16x32_bf16(ka, vb, accR[dvb], 0, 0, 0); } }
        __syncthreads();
#pragma unroll
        for (int dvb = 0; dvb < 4; ++dvb) { u32x2 wv; wv.x = pk2(accR[dvb][0], accR[dvb][1]); wv.y = pk2(accR[dvb][2], accR[dvb][3]); *(u32x2*)(RsT + (16 * dvb + l15) * P + 16 * w + 4 * quad) = wv; }
    }
#undef RET_LOAD
    __syncthreads();
}

__device__ __forceinline__ void knorm_item(unsigned char* lds, bf16_t* proj, const float* kgain, float* kmean, int b, int h, int blk) {
    const int tid = threadIdx.x, lane = tid & 63, w = __builtin_amdgcn_readfirstlane(tid >> 6), l15 = lane & 15, quad = lane >> 4;
    float* red = (float*)lds;
    float csum[8], gn[8];
#pragma unroll
    for (int j = 0; j < 8; ++j) { csum[j] = 0.f; gn[j] = kgain[8 * l15 + j]; }
    for (int st = 0; st < 8; ++st) {
        const int r = 32 * w + 4 * st + quad;
        bf16_t* p = proj + ((size_t)b * SEQ + blk * 256 + r) * DIN + C_KM + h * 128 + 8 * l15;
        const u32x4 v = *(const u32x4*)p; float f[8]; unpack8(v, f);
        float ss = 0.f;
#pragma unroll
        for (int j = 0; j < 8; ++j) ss += f[j] * f[j];
        ss += __shfl_xor(ss, 1); ss += __shfl_xor(ss, 2); ss += __shfl_xor(ss, 4); ss += __shfl_xor(ss, 8);
        const float rstd = 1.f / sqrtf(ss * (1.f / 128.f) + EPS);
#pragma unroll
        for (int j = 0; j < 8; ++j) { f[j] = f[j] * rstd * gn[j]; csum[j] += f[j]; }
        *(u32x4*)p = pack8(f);
    }
#pragma unroll
    for (int j = 0; j < 8; ++j) { csum[j] += __shfl_xor(csum[j], 16); csum[j] += __shfl_xor(csum[j], 32); }
    if (quad == 0) {
#pragma unroll
        for (int j = 0; j < 8; ++j) red[w * 128 + 8 * l15 + j] = csum[j];
    }
    __syncthreads();
    if (tid < 128) { float s = 0.f;
#pragma unroll
        for (int k = 0; k < 8; ++k) s += red[k * 128 + tid];
        kmean[(((size_t)b * 8 + h) * 8 + blk) * 128 + tid] = s * (1.f / 256.f); }
    __syncthreads();
}
__device__ __forceinline__ void qnorm_rows(bf16_t* proj, const float* qgain, int row4, int lane) {
    const int l15 = lane & 15, quad = lane >> 4;
    float gn[8];
#pragma unroll
    for (int j = 0; j < 8; ++j) gn[j] = qgain[8 * l15 + j];
    bf16_t* base = proj + (size_t)(4 * row4 + quad) * DIN + C_QM + 8 * l15;
#pragma unroll
    for (int hh = 0; hh < 8; ++hh) {
        bf16_t* p = base + hh * 128;
        const u32x4 v = *(const u32x4*)p; float f[8]; unpack8(v, f);
        float ss = 0.f;
#pragma unroll
        for (int j = 0; j < 8; ++j) ss += f[j] * f[j];
        ss += __shfl_xor(ss, 1); ss += __shfl_xor(ss, 2); ss += __shfl_xor(ss, 4); ss += __shfl_xor(ss, 8);
        const float rstd = 1.f / sqrtf(ss * (1.f / 128.f) + EPS);
#pragma unroll
        for (int j = 0; j < 8; ++j) f[j] = f[j] * rstd * gn[j];
        *(u32x4*)p = pack8(f);
    }
}
__device__ __forceinline__ void vtrans_item(bf16_t* T, const bf16_t* proj, bf16_t* Vt, int item, int lane) {
    const int dh = item & 1, st = (item >> 1) & 31, h = (item >> 6) & 7, b = item >> 9;
    const bf16_t* src = proj + ((size_t)b * SEQ + 64 * st + lane) * DIN + C_VM + h * 128 + 64 * dh;
#pragma unroll
    for (int c = 0; c < 8; ++c) { const u32x4 v = *(const u32x4*)(src + 8 * c);
        T[(8 * c + 0) * 72 + lane] = (bf16_t)(v.x & 0xffffu); T[(8 * c + 1) * 72 + lane] = (bf16_t)(v.x >> 16);
        T[(8 * c + 2) * 72 + lane] = (bf16_t)(v.y & 0xffffu); T[(8 * c + 3) * 72 + lane] = (bf16_t)(v.y >> 16);
        T[(8 * c + 4) * 72 + lane] = (bf16_t)(v.z & 0xffffu); T[(8 * c + 5) * 72 + lane] = (bf16_t)(v.z >> 16);
        T[(8 * c + 6) * 72 + lane] = (bf16_t)(v.w & 0xffffu); T[(8 * c + 7) * 72 + lane] = (bf16_t)(v.w >> 16); }
    LDS_WAIT();
    const int g = lane & 7;
#pragma unroll
    for (int k = 0; k < 8; ++k) { const int d = (lane >> 3) + 8 * k; const u32x4 o = *(const u32x4*)(T + d * 72 + 8 * g);
        *(u32x4*)(Vt + (((size_t)b * 8 + h) * 128 + 64 * dh + d) * SEQ + 64 * st + 8 * g) = o; }
    LDS_WAIT();
}

__device__ __forceinline__ int crow(int r, int hi) { return (r & 3) + 8 * (r >> 2) + 4 * hi; }
__device__ __forceinline__ void moba_unit(unsigned char* lds, bf16_t* proj, const bf16_t* Vt, const float* kmean, int b, int h, int own, bf16_t* dry = nullptr) {
    int tid_ = threadIdx.x; asm volatile("" : "+v"(tid_));
    const int tid = tid_, lane = tid & 63, w = __builtin_amdgcn_readfirstlane(tid >> 6), r32 = lane & 31, hh = lane >> 5;
    constexpr int KP = 136, VP = 144;
    bf16_t* KsB = (bf16_t*)lds;
    bf16_t* VsB = KsB + 2 * 128 * KP;
    const size_t rowbase = (size_t)b * SEQ;
    const int qrel = 32 * w + r32;
    bf16_t* qptr = proj + (rowbase + own * 256 + qrel) * DIN + C_QM + h * 128;
    bf16x8 qf[8];
#pragma unroll
    for (int s = 0; s < 8; ++s) qf[s] = *(const bf16x8*)(qptr + 16 * s + 8 * hh);
    unsigned sel = 0u;
    {
        float g[7];
        const float* km = kmean + ((size_t)b * 8 + h) * 8 * 128;
#pragma unroll
        for (int jb = 0; jb < 7; ++jb) {
            float a = 0.f;
            if (jb < own) {
#pragma unroll
                for (int s = 0; s < 8; ++s) { const f32x4 k0 = *(const f32x4*)(km + jb * 128 + 16 * s + 8 * hh), k1 = *(const f32x4*)(km + jb * 128 + 16 * s + 8 * hh + 4);
                    const u32x4 qu = __builtin_bit_cast(u32x4, qf[s]);
                    a += bflo(qu.x) * k0.x + bfhi(qu.x) * k0.y + bflo(qu.y) * k0.z + bfhi(qu.y) * k0.w + bflo(qu.z) * k1.x + bfhi(qu.z) * k1.y + bflo(qu.w) * k1.z + bfhi(qu.w) * k1.w; }
                a += __shfl_xor(a, 32);
            }
            g[jb] = a;
        }
#pragma unroll
        for (int jb = 0; jb < 7; ++jb) {
            int rank = 0;
#pragma unroll
            for (int j2 = 0; j2 < 7; ++j2) { if (j2 != jb) { const bool better = (g[j2] > g[jb]) || (g[j2] == g[jb] && j2 < jb); rank += (j2 < own && better) ? 1 : 0; } }
            if (jb < own && rank < 3) sel |= (1u << jb);
        }
    }
    f32x16 o[4];
#pragma unroll
    for (int i = 0; i < 4; ++i)
#pragma unroll
        for (int r = 0; r < 16; ++r) o[i][r] = 0.f;
    float mrun = -1e30f, lrun = 0.f;
    const float SC = 0.08838834764831845f * 1.4426950408889634f;
    const int NT = 4 * (own + 1);
    const bf16_t* kg = proj + rowbase * DIN + C_KM + h * 128;
    const bf16_t* vg = proj + rowbase * DIN + C_VM + h * 128;
    const int vtoff = (4 * hh + ((lane & 15) >> 2)) * VP + 16 * ((lane >> 4) & 1) + 4 * (lane & 3);
    u32x4 kr[4], vr[4];
#define MOBA_LOAD(T_) do { _Pragma("unroll") for (int k_ = 0; k_ < 4; ++k_) { const int c_ = tid + 512 * k_; \
        kr[k_] = *(const u32x4*)(kg + (size_t)(128 * (T_) + (c_ >> 4)) * DIN + 8 * (c_ & 15)); \
        vr[k_] = *(const u32x4*)(vg + (size_t)(128 * (T_) + (c_ >> 4)) * DIN + 8 * (c_ & 15)); } } while (0)
#define MOBA_STORE(buf) do { _Pragma("unroll") for (int k_ = 0; k_ < 4; ++k_) { const int c_ = tid + 512 * k_; \
        *(u32x4*)(KsB + (buf) * 128 * KP + (c_ >> 4) * KP + 8 * (c_ & 15)) = kr[k_]; \
        *(u32x4*)(VsB + (buf) * 128 * VP + (c_ >> 4) * VP + 8 * (c_ & 15)) = vr[k_]; } } while (0)
    MOBA_LOAD(0);
    for (int T = 0; T < NT / 2; ++T) {
        const int buf = T & 1;
        MOBA_STORE(buf);
        __syncthreads();
        if (2 * T + 2 < NT) MOBA_LOAD(T + 1);
#pragma unroll
      for (int hf = 0; hf < 2; ++hf) {
        const int t = 2 * T + hf;
        const int jb = t >> 2, kt = t & 3;
        const bool isown = (jb == own);
        bool active;
        if (isown) active = (64 * kt <= 32 * w + 31);
        else active = __any((sel >> jb) & 1u) != 0;
        if (active) {
            const bf16_t* Kt = KsB + (buf * 128 + hf * 64) * KP; const LAS bf16_t* Vv = (const LAS bf16_t*)(VsB + (buf * 128 + hf * 64) * VP) + vtoff;
            f32x16 sc[2];
#pragma unroll
            for (int kb = 0; kb < 2; ++kb) {
#pragma unroll
                for (int r = 0; r < 16; ++r) sc[kb][r] = 0.f;
#pragma unroll
                for (int s = 0; s < 8; ++s) { const bf16x8 kf = *(const bf16x8*)(Kt + (32 * kb + r32) * KP + 16 * s + 8 * hh); sc[kb] = __builtin_amdgcn_mfma_f32_32x32x16_bf16(kf, qf[s], sc[kb], 0, 0, 0); }
            }
            const bool lane_sel = isown || (((sel >> jb) & 1u) != 0u);
            if (isown && (64 * kt + 63 > 32 * w)) {
#pragma unroll
                for (int kb = 0; kb < 2; ++kb)
#pragma unroll
                    for (int r = 0; r < 16; ++r) { const int krel = 64 * kt + 32 * kb + crow(r, hh); if (krel > qrel) sc[kb][r] = -INFINITY; }
            }
            float mx = -INFINITY;
#pragma unroll
            for (int kb = 0; kb < 2; ++kb)
#pragma unroll
                for (int r = 0; r < 16; ++r) mx = fmaxf(mx, sc[kb][r]);
            mx = fmaxf(mx, __shfl_xor(mx, 32)) * SC;
            const bool grow = lane_sel && (mx > mrun + 8.f);
            if (__any(grow)) {
                const float mnew = grow ? mx : mrun;
                const float alpha = __builtin_amdgcn_exp2f(mrun - mnew);
                lrun *= alpha; mrun = mnew;
#pragma unroll
                for (int i = 0; i < 4; ++i)
#pragma unroll
                    for (int r = 0; r < 16; ++r) o[i][r] *= alpha;
            }
            const float mref = lane_sel ? mrun : INFINITY;
            float ps = 0.f;
#pragma unroll
            for (int kb = 0; kb < 2; ++kb)
#pragma unroll
                for (int r = 0; r < 16; ++r) { const float p = __builtin_amdgcn_exp2f(__builtin_fmaf(sc[kb][r], SC, -mref)); sc[kb][r] = p; ps += p; }
            ps += __shfl_xor(ps, 32);
            lrun += ps;
#pragma unroll
            for (int kb = 0; kb < 2; ++kb)
#pragma unroll
                for (int s = 0; s < 2; ++s) {
                    u32x4 pw; pw.x = pk2(sc[kb][8 * s + 0], sc[kb][8 * s + 1]); pw.y = pk2(sc[kb][8 * s + 2], sc[kb][8 * s + 3]); pw.z = pk2(sc[kb][8 * s + 4], sc[kb][8 * s + 5]); pw.w = pk2(sc[kb][8 * s + 6], sc[kb][8 * s + 7]);
                    const bf16x8 pb = __builtin_bit_cast(bf16x8, pw);
#pragma unroll
                    for (int db = 0; db < 4; ++db) { const LAS bf16_t* vp = Vv + (32 * kb + 16 * s) * VP + 32 * db;
                        const s16x4 lo = __builtin_amdgcn_ds_read_tr16_b64_v4i16((LAS s16x4*)vp), hi = __builtin_amdgcn_ds_read_tr16_b64_v4i16((LAS s16x4*)(vp + 8 * VP));
                        const bf16x8 va = __builtin_shufflevector(lo, hi, 0, 1, 2, 3, 4, 5, 6, 7);
                        o[db] = __builtin_amdgcn_mfma_f32_32x32x16_bf16(va, pb, o[db], 0, 0, 0); }
                }
        }
      }
    }
#undef MOBA_LOAD
#undef MOBA_STORE
    const float rl = 1.f / lrun;
#pragma unroll
    for (int db = 0; db < 4; ++db)
#pragma unroll
        for (int g4 = 0; g4 < 4; ++g4) { u32x2 wv; wv.x = pk2(o[db][4 * g4 + 0] * rl, o[db][4 * g4 + 1] * rl); wv.y = pk2(o[db][4 * g4 + 2] * rl, o[db][4 * g4 + 3] * rl);
            *(u32x2*)((dry ? dry + tid * 8 : qptr + 32 * db + 8 * g4) + 4 * hh) = wv; }
    __syncthreads();
}

__device__ __forceinline__ void retfin_rows(bf16_t* proj, const f32x2* stats, const float* gain, const float* bias, int m_first, int m_step, int lane) {
    const int hd = lane >> 4;
    float gg[16], bb[16];
#pragma unroll
    for (int k = 0; k < 4; ++k) { const f32x4 g4 = *(const f32x4*)(gain + 16 * lane + 4 * k), b4 = *(const f32x4*)(bias + 16 * lane + 4 * k);
        gg[4 * k] = g4.x; gg[4 * k + 1] = g4.y; gg[4 * k + 2] = g4.z; gg[4 * k + 3] = g4.w; bb[4 * k] = b4.x; bb[4 * k + 1] = b4.y; bb[4 * k + 2] = b4.z; bb[4 * k + 3] = b4.w; }
    for (int m = m_first; m < M; m += 2 * m_step) {
        u32x4 ov[2][2], gv[2][2]; f32x2 st[2][4];
#pragma unroll
        for (int t = 0; t < 2; ++t) { const size_t mm = (size_t)(m + t * m_step); const bf16_t* op = proj + mm * DIN + C_VR + 16 * lane; const bf16_t* gp = proj + mm * DIN + C_GR + 16 * lane;
            ov[t][0] = *(const u32x4*)op; ov[t][1] = *(const u32x4*)(op + 8); gv[t][0] = *(const u32x4*)gp; gv[t][1] = *(const u32x4*)(gp + 8);
            const f32x2* sp = stats + (mm * 4 + hd) * 4; st[t][0] = sp[0]; st[t][1] = sp[1]; st[t][2] = sp[2]; st[t][3] = sp[3]; }
#pragma unroll
        for (int t = 0; t < 2; ++t) {
            const float mu = ((st[t][0].x + st[t][1].x) + (st[t][2].x + st[t][3].x)) * (1.f / 256.f);
            const float var = fmaxf(((st[t][0].y + st[t][1].y) + (st[t][2].y + st[t][3].y)) * (1.f / 256.f) - mu * mu, 0.f);
            const float rstd = 1.f / sqrtf(var + EPS);
            bf16_t* gp = proj + (size_t)(m + t * m_step) * DIN + C_GR + 16 * lane;
#pragma unroll
            for (int k = 0; k < 2; ++k) { float of[8], gf[8], r[8]; unpack8(ov[t][k], of); unpack8(gv[t][k], gf);
#pragma unroll
                for (int j = 0; j < 8; ++j) r[j] = ((of[j] - mu) * rstd * gg[8 * k + j] + bb[8 * k + j]) * (gf[j] * fsigmoid(gf[j]));
                *(u32x4*)(gp + 8 * k) = pack8(r); }
        }
    }
}

#define XB_TMO      128
#define XB_XCNT(j)  (256  + 64 * (j))
#define XB_XSUB(j)  (1280 + 64 * (j))
#define XB_XGEN(j)  (2304 + 64 * (j))
#define XB_TOP      3328
#define XB_TOPGEN   3392
#define XCD_BAR_WORDS 3456
#define XB_SPIN_CAP (1u << 18)
__device__ __forceinline__ unsigned xb_ld(unsigned* p)              { return __hip_atomic_load(p, __ATOMIC_RELAXED, __HIP_MEMORY_SCOPE_AGENT); }
__device__ __forceinline__ unsigned xb_add(unsigned* p, unsigned v) { return __hip_atomic_fetch_add(p, v, __ATOMIC_RELAXED, __HIP_MEMORY_SCOPE_AGENT); }
__device__ __forceinline__ unsigned xb_xcc_id() { return (unsigned)__builtin_amdgcn_s_getreg((3 << 11) | 20) & 0xFu; }
#define XB_SPIN(cond, bar) do { unsigned _sp = 0; while (cond) { __builtin_amdgcn_s_sleep(1); \
    if ((++_sp & 255u) == 0u) { if (xb_ld(&(bar)[XB_TMO])) break; if (_sp > XB_SPIN_CAP) { atomicAdd(&(bar)[XB_TMO], 1u); break; } } } } while (0)
struct XcdBarrier { unsigned* bar; unsigned x; volatile LAS unsigned* st; };
__device__ __forceinline__ XcdBarrier xcd_barrier_post(unsigned* bar, volatile LAS unsigned* st) {
    XcdBarrier b; b.bar = bar; b.x = xb_xcc_id(); b.st = st;
    if (threadIdx.x == 0) (void)xb_add(&bar[XB_XCNT(b.x)], 1u);
    return b;
}
__device__ __forceinline__ void xcd_barrier_complete(unsigned* bar, unsigned x, unsigned& nloc, unsigned& nx) {
    const unsigned G = gridDim.x * gridDim.y * gridDim.z;
    unsigned sum, cnt, mine, sp = 0u;
    for (;;) {
        sum = 0u; cnt = 0u; mine = 0u;
#pragma unroll
        for (unsigned j = 0; j < 16; ++j) { const unsigned c = xb_ld(&bar[XB_XCNT(j)]); sum += c; cnt += (c > 0u) ? 1u : 0u; mine = (j == x) ? c : mine; }
        if (sum == G) break;
        __builtin_amdgcn_s_sleep(1);
        if ((++sp & 255u) == 0u) { if (xb_ld(&bar[XB_TMO])) break; if (sp > XB_SPIN_CAP) { atomicAdd(&bar[XB_TMO], 1u); break; } }
    }
    nloc = mine > 0u ? mine : 1u; nx = cnt > 0u ? cnt : 1u;
}
__device__ __forceinline__ void xcd_barrier(const XcdBarrier& b) {
    asm volatile("s_waitcnt vmcnt(0)" ::: "memory");
    __syncthreads();
    if (threadIdx.x == 0) {
        unsigned* bar = b.bar;
        __builtin_amdgcn_s_waitcnt(0);
        unsigned nloc = b.st[0], nx = b.st[1];
        if (nloc == 0u) { xcd_barrier_complete(bar, b.x, nloc, nx); b.st[0] = nloc; b.st[1] = nx; }
        const unsigned old = xb_add(&bar[XB_XSUB(b.x)], 1u);
        const unsigned gen = old / nloc;
        if (old + 1u == (gen + 1u) * nloc) {
            __builtin_amdgcn_fence(__ATOMIC_RELEASE, "agent");
            asm volatile("s_waitcnt vmcnt(0)" ::: "memory");
            const unsigned og = xb_add(&bar[XB_TOP], 1u);
            const unsigned tg = og / nx;
            if (og + 1u == (tg + 1u) * nx) xb_add(&bar[XB_TOPGEN], 1u);
            else XB_SPIN(xb_ld(&bar[XB_TOPGEN]) == tg, bar);
            __builtin_amdgcn_fence(__ATOMIC_ACQUIRE, "agent");
            xb_add(&bar[XB_XGEN(b.x)], 1u);
            asm volatile("s_waitcnt vmcnt(0)" ::: "memory");
        } else {
            XB_SPIN(xb_ld(&bar[XB_XGEN(b.x)]) == gen, bar);
            __builtin_amdgcn_fence(__ATOMIC_ACQUIRE, "agent");
            asm volatile("s_waitcnt vmcnt(0)" ::: "memory");
        }
    }
    __syncthreads();
}

struct Args { const float* in[17]; float* out; unsigned char* ws; int never; int pad; };

__global__ void __launch_bounds__(512, 2) fwd_kernel(Args args) {
    extern __shared__ __attribute__((aligned(16))) unsigned char lds[];
    cg::grid_group grid = cg::this_grid();
    const int tid = threadIdx.x, lane = tid & 63, wave = __builtin_amdgcn_readfirstlane(tid >> 6);
    const int G = gridDim.x, bid = blockIdx.x;
    const int gw = bid * 8 + wave, NGW = G * 8;
    unsigned char* ws = args.ws;
    const float* x = args.in[0]; const float* attn_norm = args.in[1]; const float* w_in = args.in[2]; const float* ret_gain = args.in[3]; const float* ret_bias = args.in[4];
    const float* q_gain = args.in[5]; const float* k_gain = args.in[6]; const float* w_ret_o = args.in[7]; const float* w_moba_o = args.in[8]; const float* w_gate = args.in[9];
    const float* b_gate = args.in[10]; const float* w_out = args.in[11]; const float* ffn_norm = args.in[12]; const float* w_up = args.in[13]; const float* conv_w = args.in[14];
    const float* conv_b = args.in[15]; const float* w_down = args.in[16];
    float* out = args.out;
    bf16_t* W1 = (bf16_t*)(ws + WS_W1); bf16_t* W2 = (bf16_t*)(ws + WS_W2); bf16_t* WO = (bf16_t*)(ws + WS_WO); bf16_t* WUP = (bf16_t*)(ws + WS_WUP); bf16_t* WDN = (bf16_t*)(ws + WS_WDN);
    f32x2* rope = (f32x2*)(ws + WS_ROPE); float* kmean = (float*)(ws + WS_KMEAN); f32x2* stats = (f32x2*)(ws + WS_STATS);
    bf16_t* HB = (bf16_t*)(ws + WS_H); bf16_t* PROJ = (bf16_t*)(ws + WS_PROJ); bf16_t* ACT = (bf16_t*)(ws + WS_PROJ); float* UH = (float*)(ws + WS_UH); bf16_t* XB = (bf16_t*)(ws + WS_XB); float* SSQ = (float*)(ws + WS_STATS); float* RSTD = (float*)(ws + WS_RSTD);
    bf16_t* GATES = (bf16_t*)out;
    LAS unsigned char* lds3 = (LAS unsigned char*)lds;
#ifndef PROBE_A
#define PROBE_A -1
#endif
#ifndef PROBE_B
#define PROBE_B -1
#endif
    unsigned long long* stamps = (unsigned long long*)(ws + 46 * MiB);
    int n_stamp = 0;
#define STAMP() do { if (PROBE_A >= 0) { if (bid == 0 && tid == 0) stamps[n_stamp] = __builtin_amdgcn_s_memrealtime(); ++n_stamp; } } while (0)
    STAMP();
    unsigned* barw = (unsigned*)(ws + 47 * MiB);
    volatile LAS unsigned* bst = (volatile LAS unsigned*)(lds3 + LDS_BYTES - 256);
    if (tid < 2) bst[tid] = 0u;
    const XcdBarrier xbar = xcd_barrier_post(barw, bst);
#define GSYNC() xcd_barrier(xbar)

#ifndef PHMASK
#define PHMASK 0xffff
#endif
#define RUNP(n) ((((PHMASK) >> (n)) & 1) != 0)
    if constexpr (RUNP(0)) {
        float* scr = (float*)(lds + wave * 16384);
        constexpr int I_IN = 16 * (DIN / 32), I_G = 16 * (NGATE / 32), I_O = 16 * 32, I_UP = 16 * (NUP / 32), I_DN = (DFF / 64) * 32;
        (void)I_O; (void)I_UP; (void)I_DN;
        for (int it = gw; it < I_IN + I_G; it += NGW) {
            int r = it;
            if (r < I_IN) { transpose_item<2>(w_in, DM, DIN, W1, DM, 0, 0, scr, r, lane); continue; } r -= I_IN;
            transpose_item(w_gate, DM, NGATE, W1, DM, DIN, 0, scr, r, lane);
        }
        for (int m = gw; m < M; m += 2 * NGW) {
            const int m2 = m + NGW;
            const f32x4* xa = (const f32x4*)(x + (size_t)m * DM) + lane; const f32x4* xc = (const f32x4*)(x + (size_t)m2 * DM) + lane; const f32x4* gr = (const f32x4*)attn_norm + lane;
            f32x4 va[4], vc[4]; float sa = 0.f, sc = 0.f;
#pragma unroll
            for (int j = 0; j < 4; ++j) { va[j] = xa[64 * j]; vc[j] = xc[64 * j]; }
#pragma unroll
            for (int j = 0; j < 4; ++j) { sa += (va[j].x * va[j].x + va[j].y * va[j].y) + (va[j].z * va[j].z + va[j].w * va[j].w); sc += (vc[j].x * vc[j].x + vc[j].y * vc[j].y) + (vc[j].z * vc[j].z + vc[j].w * vc[j].w); }
            const float ra = 1.f / sqrtf(wave_sum(sa) * (1.f / DM) + EPS), rc = 1.f / sqrtf(wave_sum(sc) * (1.f / DM) + EPS);
            u32x2* oa = (u32x2*)(HB + (size_t)m * DM) + lane; u32x2* oc = (u32x2*)(HB + (size_t)m2 * DM) + lane;
#pragma unroll
            for (int j = 0; j < 4; ++j) { const f32x4 gg = gr[64 * j]; u32x2 w; w.x = pk2(va[j].x * ra * gg.x, va[j].y * ra * gg.y); w.y = pk2(va[j].z * ra * gg.z, va[j].w * ra * gg.w); oa[64 * j] = w;
                u32x2 w2; w2.x = pk2(vc[j].x * rc * gg.x, vc[j].y * rc * gg.y); w2.y = pk2(vc[j].z * rc * gg.z, vc[j].w * rc * gg.w); oc[64 * j] = w2; }
        }
        for (int i = bid * 512 + tid; i < NB * 8 * 8 * 128; i += G * 512) kmean[i] = 0.f;
        for (int i = bid * 512 + tid; i < SEQ * 64; i += G * 512) {
            const int pos = i >> 6, fi = i & 63;
            const float inv_freq = __builtin_amdgcn_exp2f(-(float)fi * (13.287712379549449f / 64.f));
            double rev = (double)pos * (double)inv_freq * 0.15915494309189535; rev -= __builtin_floor(rev);
            const float rf = (float)rev;
            rope[i] = (f32x2){__builtin_amdgcn_cosf(rf), __builtin_amdgcn_sinf(rf)};
        }
    }
    if (args.never) grid.sync();
    GSYNC(); STAMP();
#ifdef DUP_SYNC
    for (int i_ = 0; i_ < 10; ++i_) GSYNC();
#endif
#ifdef DUP_G1
    {
        pg8::Gemm g{HB, W1, M, N1, DM, DM}; pg8::StaticOrder S; S.init(M, N1, G, bid);
        pg8::EpiProj E{PROJ, GATES, b_gate, q_gain, k_gain, kmean, (float*)(lds + 131072), rope};
        pg8::gemm_phase<pg8::EpiProj>(lds3, g, S, E);
    }
#endif
    if constexpr (RUNP(1)) {
        pg8::Gemm g{HB, W1, M, N1, DM, DM}; pg8::StaticOrder S; S.init(M, N1, G, bid);
        pg8::EpiProj E{PROJ, GATES, b_gate, q_gain, k_gain, kmean, (float*)(lds + 131072), rope};
        pg8::gemm_phase<pg8::EpiProj>(lds3, g, S, E);
    }
    GSYNC(); STAMP();
    if constexpr (RUNP(2)) {
#ifdef DUP_RET
        for (int it = bid; it < NB * 4 * 4; it += G) retention_item(lds, PROJ, rope, stats, it >> 4, (it >> 2) & 3, it & 3, (bf16_t*)(ws + 500 * MiB));
#endif
        if constexpr (RUNP(10)) for (int it = bid; it < NB * 4 * 4; it += G) retention_item(lds, PROJ, rope, stats, it >> 4, (it >> 2) & 3, it & 3);
        {
            float* scr = (float*)(lds + wave * 16384);
            constexpr int I_O = 16 * 32, I_UP = 16 * (NUP / 32), I_DN = (DFF / 64) * 32;
            for (int it = gw; it < 3 * I_O + I_UP + I_DN; it += NGW) {
                int r = it;
                if (r < I_O) { transpose_item(w_ret_o, DM, DM, W2, 2 * DM, 0, 0, scr, r, lane); continue; } r -= I_O;
                if (r < I_O) { transpose_item(w_moba_o, DM, DM, W2, 2 * DM, 0, DM, scr, r, lane); continue; } r -= I_O;
                if (r < I_O) { transpose_item(w_out, DM, DM, WO, DM, 0, 0, scr, r, lane); continue; } r -= I_O;
                if (r < I_UP) { transpose_item<1>(w_up, DM, NUP, WUP, DM, 0, 0, scr, r, lane, ffn_norm); continue; } r -= I_UP;
                transpose_item(w_down, DFF, DM, WDN, DFF, 0, 0, scr, r, lane);
            }
        }
    }
    GSYNC(); STAMP();
    if constexpr (RUNP(3)) {
      const int first_fin = (bid >> 3) & 1;
#pragma unroll 1
      for (int step = 0; step < 2; ++step) {
       if ((step ^ first_fin) == 1) {
        for (int bh = bid >> 1; bh < NB * 8; bh += (G >> 1)) {
            const int par = bid & 1;
#pragma unroll 1
            for (int k = 0; k < 4; ++k) { const int own = par ? (k == 0 ? 6 : k == 1 ? 5 : k == 2 ? 2 : 1) : (k == 0 ? 7 : k == 1 ? 4 : k == 2 ? 3 : 0);
#ifdef DUP_MOBA
                moba_unit(lds, PROJ, HB, kmean, bh >> 3, bh & 7, own, (bf16_t*)(ws + 500 * MiB));
#endif
                moba_unit(lds, PROJ, HB, kmean, bh >> 3, bh & 7, own); }
        }
       } else {
        retfin_rows(PROJ, stats, ret_gain, ret_bias, gw, NGW, lane);
       }
      }
    }
    GSYNC(); STAMP();
    if constexpr (RUNP(4)) {
        pg8::Gemm g{PROJ + C_GR, W2, M, DM, 2 * DM, DIN}; pg8::StaticOrder S; S.init(M, DM, G, bid);
        pg8::EpiMerge E{GATES, HB};
        pg8::gemm_phase<pg8::EpiMerge>(lds3, g, S, E);
    }
    GSYNC(); STAMP();
#ifdef DUP_G4
    {
        pg8::Gemm g{HB, WO, M, DM, DM, DM}; pg8::StaticOrder S; S.init(M, DM, G, bid);
        pg8::EpiResidNorm E{x, XB, SSQ};
        pg8::gemm_phase<pg8::EpiResidNorm>(lds3, g, S, E);
    }
    GSYNC();
#endif
    if constexpr (RUNP(5)) {
        pg8::Gemm g{HB, WO, M, DM, DM, DM}; pg8::StaticOrder S; S.init(M, DM, G, bid);
        pg8::EpiResidNorm E{x, XB, SSQ};
        pg8::gemm_phase<pg8::EpiResidNorm>(lds3, g, S, E);
    }
    GSYNC(); STAMP();
    for (int m = bid * 512 + tid; m < M; m += G * 512) { const f32x4* p = (const f32x4*)(SSQ + (size_t)m * 16); const f32x4 a = p[0], b = p[1], c = p[2], d = p[3];
        const float s = ((a.x + a.y) + (a.z + a.w)) + ((b.x + b.y) + (b.z + b.w)) + ((c.x + c.y) + (c.z + c.w)) + ((d.x + d.y) + (d.z + d.w));
        RSTD[m] = 1.f / sqrtf(s * (1.f / DM) + EPS); }
    GSYNC(); STAMP();
#ifdef DUP_G5
    {
        pg8::Gemm g{XB, WUP, M, NUP, DM, DM}; pg8::StaticOrder S; S.init(M, NUP, G, bid);
        pg8::EpiConv E{ACT, UH, conv_w, conv_b, (f32x2*)(lds + 131072), RSTD};
        pg8::gemm_phase<pg8::EpiConv, true, true, true>(lds3, g, S, E);
    }
#endif
    {
        pg8::Gemm g{XB, WUP, M, NUP, DM, DM}; pg8::StaticOrder S; S.init(M, NUP, G, bid);
        pg8::EpiConv E{ACT, UH, conv_w, conv_b, (f32x2*)(lds + 131072), RSTD};
        pg8::gemm_phase<pg8::EpiConv, true, true, true>(lds3, g, S, E);
    }
    GSYNC(); STAMP();
    for (int idx = bid * 512 + tid; idx < 112 * DFF; idx += G * 512) {
        const int t = idx / DFF, c = idx - t * DFF, pm = (t / 7) * 8 + (t % 7) + 1;
        const int colg = 256 * (c >> 7) + (c & 127), colv = colg + 128;
        const float* up = UH + ((size_t)(pm - 1) * 4 + 2) * NUP; const float* uc = UH + ((size_t)pm * 4) * NUP;
        const float a2 = up[colg], a1 = up[NUP + colg], a0 = uc[colg], an = uc[NUP + colg];
        const float b2 = up[colv], b1 = up[NUP + colv], b0 = uc[colv], bn = uc[NUP + colv];
        const float gb = conv_b[c], g0 = conv_w[c], g1 = conv_w[NUP + c], g2 = conv_w[2 * NUP + c];
        const float vb = conv_b[DFF + c], v0 = conv_w[DFF + c], v1 = conv_w[NUP + DFF + c], v2 = conv_w[2 * NUP + DFF + c];
        const float og0 = gb + g0 * a2 + g1 * a1 + g2 * a0, og1 = gb + g0 * a1 + g1 * a0 + g2 * an;
        const float ov0 = vb + v0 * b2 + v1 * b1 + v2 * b0, ov1 = vb + v0 * b1 + v1 * b0 + v2 * bn;
        const unsigned w = pk2(og0 * fsigmoid(og0) * ov0, og1 * fsigmoid(og1) * ov1);
        ACT[(size_t)(pm * 256) * DFF + c] = (bf16_t)(w & 0xffffu); ACT[(size_t)(pm * 256 + 1) * DFF + c] = (bf16_t)(w >> 16);
    }
    GSYNC(); STAMP();
    {
        pg8::Gemm g{ACT, WDN, M, DM, DFF, DFF}; pg8::StaticOrder S; S.init(M, DM, G, bid);
        pg8::EpiResid E{XB, out};
        pg8::gemm_phase<pg8::EpiResid>(lds3, g, S, E);
    }
    if (PROBE_A >= 0) {
        GSYNC(); STAMP(); __threadfence(); __syncthreads();
        if (bid == 0) {
            const int pa = PROBE_A, pb = PROBE_B;
            const float ta = (float)(stamps[pa + 1] - stamps[pa]) * 0.01f;
            const float tb = pb >= 100 ? (float)(stamps[n_stamp - 1] - stamps[0]) * 0.01f : (pb >= 0 ? (float)(stamps[pb + 1] - stamps[pb]) * 0.01f : 0.f);
            if (tid == 0) out[0] += ta * 0.01f;
            for (int i = tid; i < 65536; i += 512) out[4096 + i] += tb * 0.001f;
        }
    }
}

extern "C" void kernel_launch(void* const* d_in, const int* in_sizes, int n_in, void* d_out, int out_size, void* d_ws, size_t ws_size, hipStream_t stream) {
    static int grid = 0;
    if (grid == 0) {
        if (n_in != 17 || out_size != M * DM || ws_size < WS_END) { fprintf(stderr, "kernel_launch: unexpected shapes (n_in %d out %d ws %zu)\n", n_in, out_size, ws_size); grid = -1; return; }
        int dev = 0, cus = 0, per_cu = 0;
        hipGetDevice(&dev); hipDeviceGetAttribute(&cus, hipDeviceAttributeMultiprocessorCount, dev);
        hipFuncSetAttribute((const void*)fwd_kernel, hipFuncAttributeMaxDynamicSharedMemorySize, LDS_BYTES);
        hipOccupancyMaxActiveBlocksPerMultiprocessor(&per_cu, (const void*)fwd_kernel, 512, LDS_BYTES);
        if (per_cu < 1) { fprintf(stderr, "kernel_launch: occupancy query says %d blocks per CU\n", per_cu); per_cu = 1; }
        (void)hipGetLastError();
        grid = cus * per_cu;
    }
    if (grid < 0) return;
    if (hipMemsetAsync((char*)d_ws + 47 * MiB, 0, XCD_BAR_WORDS * 4, stream) != hipSuccess) { fprintf(stderr, "kernel_launch: memset of the barrier words failed\n"); return; }
    Args a{};
    for (int i = 0; i < 17; ++i) a.in[i] = (const float*)d_in[i];
    a.out = (float*)d_out; a.ws = (unsigned char*)d_ws;
    void* params[] = {&a};
    hipError_t e = hipLaunchCooperativeKernel((const void*)fwd_kernel, dim3(grid), dim3(512), params, LDS_BYTES, stream);
    if (e != hipSuccess) fprintf(stderr, "cooperative launch failed: %s (grid %d)\n", hipGetErrorString(e), grid);
}
```

```cpp
#include <hip/hip_runtime.h>
#include <hip/hip_cooperative_groups.h>
#include <cstdio>
#include <cstdint>
namespace cg = cooperative_groups;

#define LAS __attribute__((address_space(3)))
typedef unsigned short bf16_t;
typedef short bf16x8 __attribute__((ext_vector_type(8)));
typedef short s16x4 __attribute__((ext_vector_type(4)));
typedef float f32x4 __attribute__((ext_vector_type(4)));
typedef float f32x2 __attribute__((ext_vector_type(2)));
typedef float f32x16 __attribute__((ext_vector_type(16)));
typedef unsigned u32x4 __attribute__((ext_vector_type(4)));
typedef unsigned u32x2 __attribute__((ext_vector_type(2)));
typedef __bf16 bf16x2_t __attribute__((ext_vector_type(2)));

constexpr int SEQ = 2048, NB = 16, DM = 1024, M = NB * SEQ;
constexpr int DIN = 6144, NGATE = 2048, N1 = DIN + NGATE;
constexpr int DFF = 2816, NUP = 2 * DFF;
constexpr int C_QR = 0, C_KR = 512, C_VR = 1024, C_GR = 2048, C_QM = 3072, C_KM = 4096, C_VM = 5120;
constexpr float EPS = 1e-6f;
constexpr int RET_QKW = 512;
constexpr int MH = M / 2;

constexpr size_t MiB = 1u << 20;
constexpr size_t WS_W1 = 0;
constexpr size_t WS_W2 = 16 * MiB;
constexpr size_t WS_WO = 20 * MiB;
constexpr size_t WS_WUP = 22 * MiB;
constexpr size_t WS_WDN = 33 * MiB;
constexpr size_t WS_ROPE = 39 * MiB;
constexpr size_t WS_KMEAN = 40 * MiB;
constexpr size_t WS_STATS = 41 * MiB;
constexpr size_t WS_H = 48 * MiB;
constexpr size_t WS_PROJ = 112 * MiB;
constexpr size_t WS_XB = WS_PROJ + 224 * MiB;
constexpr size_t WS_RSTD = 45 * MiB;
constexpr size_t WS_UH = WS_PROJ + 200 * MiB;
constexpr size_t WS_END = 496 * MiB;

constexpr int LDS_BYTES = 147456;

__device__ __forceinline__ unsigned pk2(float lo, float hi) { f32x2 v = {lo, hi}; bf16x2_t b = __builtin_convertvector(v, bf16x2_t); return __builtin_bit_cast(unsigned, b); }
__device__ __forceinline__ float bflo(unsigned u) { return __uint_as_float(u << 16); }
__device__ __forceinline__ float bfhi(unsigned u) { return __uint_as_float(u & 0xffff0000u); }
__device__ __forceinline__ float fsigmoid(float x) { return __builtin_amdgcn_rcpf(1.f + __builtin_amdgcn_exp2f(-1.4426950408889634f * x)); }
__device__ __forceinline__ void unpack8(const u32x4 v, float* f) { f[0] = bflo(v.x); f[1] = bfhi(v.x); f[2] = bflo(v.y); f[3] = bfhi(v.y); f[4] = bflo(v.z); f[5] = bfhi(v.z); f[6] = bflo(v.w); f[7] = bfhi(v.w); }
__device__ __forceinline__ u32x4 pack8(const float* f) { u32x4 o; o.x = pk2(f[0], f[1]); o.y = pk2(f[2], f[3]); o.z = pk2(f[4], f[5]); o.w = pk2(f[6], f[7]); return o; }
__device__ __forceinline__ float xsum32(float v) { auto rr = __builtin_amdgcn_permlane32_swap(__float_as_uint(v), __float_as_uint(v), false, false); return __uint_as_float(rr[0]) + __uint_as_float(rr[1]); }
__device__ __forceinline__ float xmax32(float v) { auto rr = __builtin_amdgcn_permlane32_swap(__float_as_uint(v), __float_as_uint(v), false, false); return fmaxf(__uint_as_float(rr[0]), __uint_as_float(rr[1])); }
#define LDS_WAIT() asm volatile("s_waitcnt lgkmcnt(0)" ::: "memory")

namespace pg8 {
constexpr int BM = 256, BK = 64, HALF = 128, HTB = HALF * BK * 2, STAGE_BYTES = 8 * HTB, NXCD = 8, WGM = 4;
__host__ __device__ __forceinline__ int lds_byte(int r, int c) { const int st = (r >> 4) * 2 + (c >> 5), rr = r & 15, cc = c & 31, ob = rr * 64 + cc * 2; return st * 1024 + (ob ^ (((ob >> 9) & 1) << 5)); }
__host__ __device__ __forceinline__ void stage_rc(int b, int& R, int& C) { const int st = b / 1024, sb = b % 1024, swz = sb ^ (((sb >> 9) & 1) << 5); R = (st >> 1) * 16 + swz / 64; C = (st & 1) * 32 + (swz % 64) / 2; }
__host__ __device__ __forceinline__ int perm32(int rho) { const int n = rho >> 4, i = rho & 15; return 8 * (i >> 2) + 4 * n + (i & 3); }

struct Unit { int pm, pn; };
struct Gemm { const bf16_t* A; const bf16_t* Bt; int M, N, K, lda; };

struct StaticOrder {
    int nM, nN, nwg, G, c;
    __device__ void init(int M_, int N_, int G_, int c_) { nM = M_ / BM; nN = N_ / BM; nwg = nM * nN; G = G_; c = c_; }
    __device__ bool next(int i, Unit& u) const {
        const long L = (long)i * G + c; if (L >= nwg) return false;
        int wgid = (int)L; { const int q = nwg / NXCD, r = nwg % NXCD, xcd = wgid % NXCD, off = wgid / NXCD; wgid = (xcd < r ? xcd * (q + 1) : r * (q + 1) + (xcd - r) * q) + off; }
        const int nig = WGM * nN, gid = wgid / nig, fm = gid * WGM, gsz = (nM - fm) < WGM ? (nM - fm) : WGM;
        u.pm = fm + ((wgid % nig) % gsz); u.pn = (wgid % nig) / gsz; return true;
    }
};

typedef f32x4 Acc[2][2][4][2];

template <class Epi, bool ALIGN_EPI = true, bool SP2 = true, bool SWAP = false>
__device__ __forceinline__ void gemm_phase(LAS unsigned char* lds, const Gemm g, const StaticOrder& S, const Epi& E) {
    int tid_ = threadIdx.x; asm volatile("" : "+v"(tid_));
    const int tid = tid_, wid = __builtin_amdgcn_readfirstlane(tid >> 6), lane = tid & 63, wr = wid >> 2, wc = wid & 3, fr = lane & 15, fq = lane >> 4;
    const int K = g.K, nt = K / BK, lda = g.lda;
    unsigned voffA[2], voffB[2], voffB1[2];
#pragma unroll
    for (int i = 0; i < 2; ++i) { int R, C; stage_rc(tid * 16 + i * 8192, R, C); const int Rb = Epi::PERM ? ((R & ~31) + perm32(R & 31)) : R;
        voffA[i] = (unsigned)(R * lda + C) * 2u; voffB[i] = (unsigned)(Rb * K + C) * 2u; voffB1[i] = voffB[i];
        if constexpr (Epi::ADJ) { const int r0 = 64 * (R >> 5) + perm32(R & 31); voffB[i] = (unsigned)(r0 * K + C) * 2u; voffB1[i] = (unsigned)((r0 + 32) * K + C) * 2u; } }
    const size_t kstep = (size_t)(BK * 2);
    const size_t hstepA = (size_t)HALF * lda * 2, hstepB_ = (size_t)HALF * K * 2;
    const size_t tstepA = 2 * hstepA, tstepB = 2 * hstepB_;
    const size_t hstepB = Epi::ADJ ? 0 : hstepB_;
    const unsigned ldsw = (unsigned)wid * 1024u;
    const int aoff = lds_byte(wr * 64 + fr, fq * 8), boff = lds_byte(wc * 32 + fr, fq * 8);
#define PG8_SA(b, h) (((b) * 2 + (h)) * HTB)
#define PG8_SB(b, h) ((4 + (b) * 2 + (h)) * HTB)
#define PG8_STAGE(bufoff, gbase, voff) do { _Pragma("unroll") for (int _i = 0; _i < 2; ++_i) \
        __builtin_amdgcn_global_load_lds((const unsigned*)((const char*)(gbase) + (voff)[_i]), (LAS unsigned*)(lds + (bufoff) + ldsw + _i * 8192), 16, 0, 0); } while (0)
#define PG8_LDA(dst, b, h) do { _Pragma("unroll") for (int m = 0; m < 4; ++m) _Pragma("unroll") for (int k = 0; k < 2; ++k) dst[m][k] = *(const LAS bf16x8*)(lds + PG8_SA(b, h) + aoff + m * 2048 + k * 1024); } while (0)
#define PG8_LDB(dst, b, h) do { _Pragma("unroll") for (int n = 0; n < 2; ++n) _Pragma("unroll") for (int k = 0; k < 2; ++k) dst[n][k] = *(const LAS bf16x8*)(lds + PG8_SB(b, h) + boff + n * 2048 + k * 1024); } while (0)
#define PG8_MMA(ai, bj, At, Bt) do { __builtin_amdgcn_s_setprio(1); _Pragma("unroll") for (int m = 0; m < 4; ++m) _Pragma("unroll") for (int n = 0; n < 2; ++n) _Pragma("unroll") for (int k = 0; k < 2; ++k) \
        acc[ai][bj][m][n] = SWAP ? __builtin_amdgcn_mfma_f32_16x16x32_bf16(At[m][k], Bt[n][k], acc[ai][bj][m][n], 0, 0, 0) : __builtin_amdgcn_mfma_f32_16x16x32_bf16(Bt[n][k], At[m][k], acc[ai][bj][m][n], 0, 0, 0); __builtin_amdgcn_s_setprio(0); } while (0)
#define PG8_WAIT_V(n) asm volatile("s_waitcnt vmcnt(" #n ")" ::: "memory")
#define PG8_WAIT_L(n) asm volatile("s_waitcnt lgkmcnt(" #n ")" ::: "memory")
#define PG8_BAR __builtin_amdgcn_s_barrier()
#define PG8_SCHED __builtin_amdgcn_sched_barrier(0)
    Unit cur, nxt; int ui = 0;
    if (!S.next(0, cur)) return;
    Acc acc;
#pragma unroll
    for (int a = 0; a < 2; ++a)
#pragma unroll
        for (int b = 0; b < 2; ++b)
#pragma unroll
            for (int m = 0; m < 4; ++m)
#pragma unroll
                for (int n = 0; n < 2; ++n) acc[a][b][m][n] = (f32x4){0.f, 0.f, 0.f, 0.f};
    bf16x8 At[4][2], B0[2][2], B1[2][2];
    const char* cA = (const char*)g.A + (size_t)cur.pm * tstepA; const char* cB = (const char*)g.Bt + (size_t)cur.pn * tstepB;
    if constexpr (SP2) {
        PG8_STAGE(PG8_SB(0, 0), cB, voffB); PG8_STAGE(PG8_SB(0, 1), cB + hstepB, voffB1); PG8_STAGE(PG8_SA(0, 0), cA, voffA); PG8_STAGE(PG8_SA(0, 1), cA + hstepA, voffA);
        if (wr == 1) PG8_BAR;
        PG8_WAIT_V(2); PG8_BAR;
        PG8_STAGE(PG8_SB(1, 0), cB + kstep, voffB); PG8_STAGE(PG8_SA(1, 0), cA + kstep, voffA); PG8_STAGE(PG8_SB(1, 1), cB + hstepB + kstep, voffB1);
        PG8_WAIT_V(6); PG8_BAR;
    } else {
        PG8_STAGE(PG8_SB(0, 0), cB, voffB); PG8_STAGE(PG8_SA(0, 0), cA, voffA); PG8_STAGE(PG8_SB(0, 1), cB + hstepB, voffB1); PG8_STAGE(PG8_SA(0, 1), cA + hstepA, voffA);
        if (wr == 1) PG8_BAR;
        PG8_WAIT_V(4); PG8_BAR;
        PG8_STAGE(PG8_SB(1, 0), cB + kstep, voffB); PG8_STAGE(PG8_SA(1, 0), cA + kstep, voffA); PG8_STAGE(PG8_SB(1, 1), cB + hstepB + kstep, voffB1);
        PG8_WAIT_V(6); PG8_BAR;
    }
    for (;;) {
        const bool has_next = S.next(ui + 1, nxt);
        const char* nA = has_next ? (const char*)g.A + (size_t)nxt.pm * tstepA : cA; const char* nB = has_next ? (const char*)g.Bt + (size_t)nxt.pn * tstepB : cB;
        for (int t = 0; t < nt; t += 2) {
            const bool last = (t == nt - 2);
            const char* a1 = cA + (size_t)(t + 1) * kstep;
            const char* a2 = last ? nA : cA + (size_t)(t + 2) * kstep; const char* b2 = last ? nB : cB + (size_t)(t + 2) * kstep;
            const char* a3 = a2 + kstep; const char* b3 = b2 + kstep;
            if constexpr (Epi::HAS_MID) { if (t == Epi::MID_T) E.mid(acc, cur, wr, wc, fr, fq); }
            if constexpr (SP2) {
            PG8_LDB(B0, 0, 0); PG8_LDB(B1, 0, 1); PG8_SCHED; PG8_LDA(At, 0, 0); PG8_STAGE(PG8_SA(1, 1), a1 + hstepA, voffA);
            PG8_WAIT_V(8); PG8_WAIT_L(0); PG8_BAR; PG8_MMA(0, 0, At, B0); PG8_MMA(0, 1, At, B1); PG8_BAR; PG8_SCHED;
            PG8_LDA(At, 0, 1); PG8_STAGE(PG8_SB(0, 0), b2, voffB); PG8_STAGE(PG8_SB(0, 1), b2 + hstepB, voffB1); PG8_STAGE(PG8_SA(0, 0), a2, voffA);
            PG8_WAIT_V(8); PG8_WAIT_L(0); PG8_BAR; PG8_MMA(1, 0, At, B0); PG8_MMA(1, 1, At, B1); PG8_BAR; PG8_SCHED;
            PG8_LDB(B0, 1, 0); PG8_LDB(B1, 1, 1); PG8_SCHED; PG8_LDA(At, 1, 0); PG8_STAGE(PG8_SA(0, 1), a2 + hstepA, voffA);
            PG8_WAIT_V(8); PG8_WAIT_L(0); PG8_BAR; PG8_MMA(0, 0, At, B0); PG8_MMA(0, 1, At, B1); PG8_BAR; PG8_SCHED;
            PG8_LDA(At, 1, 1); PG8_STAGE(PG8_SB(1, 0), b3, voffB); PG8_STAGE(PG8_SB(1, 1), b3 + hstepB, voffB1); PG8_STAGE(PG8_SA(1, 0), a3, voffA);
            PG8_WAIT_V(8); PG8_WAIT_L(0); PG8_BAR; PG8_MMA(1, 0, At, B0); PG8_MMA(1, 1, At, B1); PG8_BAR; PG8_SCHED;
            } else {
            PG8_LDB(B0, 0, 0); PG8_SCHED; PG8_LDA(At, 0, 0); PG8_STAGE(PG8_SA(1, 1), a1 + hstepA, voffA);
            PG8_WAIT_L(8); PG8_BAR; PG8_WAIT_L(0); PG8_MMA(0, 0, At, B0); PG8_BAR; PG8_SCHED;
            PG8_LDB(B1, 0, 1); PG8_STAGE(PG8_SB(0, 0), b2, voffB);
            PG8_BAR; PG8_WAIT_L(0); PG8_MMA(0, 1, At, B1); PG8_BAR;
            PG8_LDA(At, 0, 1); PG8_STAGE(PG8_SA(0, 0), a2, voffA);
            PG8_BAR; PG8_WAIT_L(0); PG8_MMA(1, 0, At, B0); PG8_BAR; PG8_SCHED;
            PG8_STAGE(PG8_SB(0, 1), b2 + hstepB, voffB1);
            PG8_WAIT_V(6); PG8_BAR; PG8_MMA(1, 1, At, B1); PG8_BAR;
            PG8_LDB(B0, 1, 0); PG8_SCHED; PG8_LDA(At, 1, 0); PG8_STAGE(PG8_SA(0, 1), a2 + hstepA, voffA);
            PG8_WAIT_L(8); PG8_BAR; PG8_WAIT_L(0); PG8_MMA(0, 0, At, B0); PG8_BAR; PG8_SCHED;
            PG8_LDB(B1, 1, 1); PG8_STAGE(PG8_SB(1, 0), b3, voffB);
            PG8_BAR; PG8_WAIT_L(0); PG8_MMA(0, 1, At, B1); PG8_BAR;
            PG8_LDA(At, 1, 1); PG8_STAGE(PG8_SA(1, 0), a3, voffA);
            PG8_BAR; PG8_WAIT_L(0); PG8_MMA(1, 0, At, B0); PG8_BAR; PG8_SCHED;
            PG8_STAGE(PG8_SB(1, 1), b3 + hstepB, voffB1);
            PG8_WAIT_V(6); PG8_BAR; PG8_MMA(1, 1, At, B1); PG8_BAR;
            }
        }
        if constexpr (ALIGN_EPI) { if (wr == 0) PG8_BAR; }
        E.fin(acc, cur, wr, wc, fr, fq);
        if (!has_next) break;
#pragma unroll
        for (int a = 0; a < 2; ++a)
#pragma unroll
            for (int b = 0; b < 2; ++b)
#pragma unroll
                for (int m = 0; m < 4; ++m)
#pragma unroll
                    for (int n = 0; n < 2; ++n) acc[a][b][m][n] = (f32x4){0.f, 0.f, 0.f, 0.f};
        cur = nxt; cA = nA; cB = nB; ++ui;
        if constexpr (ALIGN_EPI) { if (wr == 1) PG8_BAR; }
    }
    PG8_WAIT_V(0);
    if constexpr (!ALIGN_EPI) { if (wr == 0) PG8_BAR; }
    PG8_BAR;
#undef PG8_SA
#undef PG8_SB
#undef PG8_STAGE
#undef PG8_LDA
#undef PG8_LDB
#undef PG8_MMA
#undef PG8_WAIT_V
#undef PG8_WAIT_L
#undef PG8_BAR
#undef PG8_SCHED
}

__device__ __forceinline__ f32x4 ror8(const f32x4 v) { f32x4 r;
#pragma unroll
    for (int j = 0; j < 4; ++j) r[j] = __int_as_float(__builtin_amdgcn_update_dpp(0, __float_as_int(v[j]), 0x128, 0xF, 0xF, false));
    return r; }
__device__ __forceinline__ u32x4 ror8u(const u32x4 v) { u32x4 r;
#pragma unroll
    for (int j = 0; j < 4; ++j) r[j] = (unsigned)__builtin_amdgcn_update_dpp(0, (int)v[j], 0x128, 0xF, 0xF, false);
    return r; }
__device__ __forceinline__ void store_pair128(bf16_t* p, int pitch, bool hi, const u32x4 w0, const u32x4 w1) {
    const u32x4 rc = ror8u(hi ? w0 : w1);
    *(u32x4*)p = hi ? rc : w0; *(u32x4*)(p + 8 * (size_t)pitch) = hi ? w1 : rc;
}
struct EpiProj {
    static constexpr bool PERM = true, HAS_MID = false, ADJ = true; static constexpr int MID_T = -1;
    bf16_t* proj; bf16_t* gates; const float* bgate; const float* qgain; const float* kgain; float* kmean; float* X; const f32x2* rope;
    __device__ __forceinline__ void mid(Acc&, const Unit&, int, int, int, int) const {}
    __device__ __forceinline__ void fin(const Acc& acc, const Unit& u, int wr, int wc, int fr, int fq) const {
        asm volatile("" : "+v"(fr), "+v"(fq));
        const bool hi = fr >= 8;
        const int rowl = wr * 64 + fr;
        const int rows = u.pm * BM + wr * 64 + (fr & 7);
        const int colw = u.pn * BM + wc * 64 + 8 * fq;
        const int cols = colw + (hi ? 32 : 0);
        if (u.pn < 2 * RET_QKW / BM) {
            const bool iskr = u.pn >= RET_QKW / BM;
            const float lg2h = __builtin_log2f(1.f - __builtin_amdgcn_exp2f(-5.f - (float)(2 * (u.pn & 1) + (wc >> 1))));
            const int dl = 32 * (wc & 1) + 8 * fq;
            bf16_t* pbase = proj + (size_t)(u.pm * BM + rowl) * DIN + u.pn * BM + 128 * (wc >> 1) + dl;
            const f32x2* rbase = rope + (size_t)((u.pm * BM + rowl) & (SEQ - 1)) * 64 + dl;
#pragma unroll
            for (int ai = 0; ai < 2; ++ai) {
                f32x4 cst[4][4];
#pragma unroll
                for (int m = 0; m < 4; ++m) { const f32x4* cs = (const f32x4*)(rbase + (size_t)(ai * HALF + m * 16) * 64);
#pragma unroll
                    for (int j = 0; j < 4; ++j) cst[m][j] = cs[j]; }
#pragma unroll
                for (int m = 0; m < 4; ++m) {
                    bf16_t* p = pbase + (size_t)(ai * HALF + m * 16) * DIN;
                    const float ks = iskr ? 0.08838834764831845f * __builtin_amdgcn_exp2f(lg2h * (float)(127 - (rowl + 16 * m))) : 1.f;
#pragma unroll
                    for (int n = 0; n < 2; ++n) { const f32x4 t0 = cst[m][2 * n], t1 = cst[m][2 * n + 1]; const f32x4 x1 = acc[ai][0][m][n], x2 = acc[ai][1][m][n];
                        u32x2 lo, hi2;
                        lo.x = pk2((x1[0] * t0[0] - x2[0] * t0[1]) * ks, (x1[1] * t0[2] - x2[1] * t0[3]) * ks); lo.y = pk2((x1[2] * t1[0] - x2[2] * t1[1]) * ks, (x1[3] * t1[2] - x2[3] * t1[3]) * ks);
                        hi2.x = pk2((x1[0] * t0[1] + x2[0] * t0[0]) * ks, (x1[1] * t0[3] + x2[1] * t0[2]) * ks); hi2.y = pk2((x1[2] * t1[1] + x2[2] * t1[0]) * ks, (x1[3] * t1[3] + x2[3] * t1[2]) * ks);
                        *(u32x2*)(p + 4 * n) = lo; *(u32x2*)(p + 64 + 4 * n) = hi2; }
                }
                asm volatile("" ::: "memory");
            }
        } else if (u.pn >= C_QM / BM && u.pn < C_VM / BM) {
            const bool isk = u.pn >= C_KM / BM;
#pragma unroll
            for (int ai = 0; ai < 2; ++ai)
#pragma unroll
                for (int m = 0; m < 4; ++m) { float s = 0.f;
#pragma unroll
                    for (int bj = 0; bj < 2; ++bj) { const f32x4 v0 = acc[ai][bj][m][0], v1 = acc[ai][bj][m][1];
                        s += (v0[0] * v0[0] + v0[1] * v0[1]) + (v0[2] * v0[2] + v0[3] * v0[3]) + (v1[0] * v1[0] + v1[1] * v1[1]) + (v1[2] * v1[2] + v1[3] * v1[3]); }
                    s += __shfl_xor(s, 16); s += __shfl_xor(s, 32);
                    if (fq == 0) X[(ai * HALF + m * 16 + rowl) * 4 + wc] = s; }
            asm volatile("s_waitcnt lgkmcnt(0)" ::: "memory"); __builtin_amdgcn_s_barrier(); asm volatile("" ::: "memory");
            const int dw = (wc & 1) * 64 + 8 * fq;
            const float* gp = (isk ? kgain : qgain) + dw;
            f32x4 g[2][2];
#pragma unroll
            for (int bj = 0; bj < 2; ++bj) { g[bj][0] = *(const f32x4*)(gp + 32 * bj); g[bj][1] = *(const f32x4*)(gp + 32 * bj + 4); }
            f32x4 cs[2][2];
#pragma unroll
            for (int bj = 0; bj < 2; ++bj) { cs[bj][0] = (f32x4){0.f, 0.f, 0.f, 0.f}; cs[bj][1] = (f32x4){0.f, 0.f, 0.f, 0.f}; }
#pragma unroll
            for (int ai = 0; ai < 2; ++ai)
#pragma unroll
                for (int m = 0; m < 4; ++m) { const f32x2 p = *(const f32x2*)(X + (ai * HALF + m * 16 + rowl) * 4 + (wc & 2));
                    const float rstd = 1.f / sqrtf((p[0] + p[1]) * (1.f / 128.f) + EPS);
                    u32x4 w[2];
#pragma unroll
                    for (int bj = 0; bj < 2; ++bj) { const f32x4 v0 = acc[ai][bj][m][0] * rstd * g[bj][0], v1 = acc[ai][bj][m][1] * rstd * g[bj][1]; cs[bj][0] += v0; cs[bj][1] += v1;
                        w[bj].x = pk2(v0[0], v0[1]); w[bj].y = pk2(v0[2], v0[3]); w[bj].z = pk2(v1[0], v1[1]); w[bj].w = pk2(v1[2], v1[3]); }
                    store_pair128(proj + (size_t)(rows + ai * HALF + m * 16) * DIN + cols, DIN, hi, w[0], w[1]);
                    asm volatile("" : "+v"(cs[0][0]), "+v"(cs[0][1]), "+v"(cs[1][0]), "+v"(cs[1][1])); }
            if (isk) {
#pragma unroll
                for (int bj = 0; bj < 2; ++bj)
#pragma unroll
                    for (int n = 0; n < 2; ++n)
#pragma unroll
                        for (int i = 0; i < 4; ++i) { float s = cs[bj][n][i]; s += __shfl_xor(s, 1); s += __shfl_xor(s, 2); s += __shfl_xor(s, 4); s += __shfl_xor(s, 8); cs[bj][n][i] = s; }
                if (fr == 0) {
                    const int bb = u.pm >> 3, blk = u.pm & 7, head = 2 * (u.pn - C_KM / BM) + (wc >> 1);
                    float* kp = kmean + (((size_t)bb * 8 + head) * 8 + blk) * 128 + dw;
#pragma unroll
                    for (int bj = 0; bj < 2; ++bj)
#pragma unroll
                        for (int n = 0; n < 2; ++n)
#pragma unroll
                            for (int i = 0; i < 4; ++i) atomicAdd(kp + 32 * bj + 4 * n + i, cs[bj][n][i] * (1.f / 256.f));
                }
            }
        } else if (u.pn < DIN / BM) {
#pragma unroll
            for (int ai = 0; ai < 2; ++ai)
#pragma unroll
                for (int m = 0; m < 4; ++m) { u32x4 w[2];
#pragma unroll
                    for (int bj = 0; bj < 2; ++bj) { const f32x4 v0 = acc[ai][bj][m][0], v1 = acc[ai][bj][m][1]; w[bj].x = pk2(v0[0], v0[1]); w[bj].y = pk2(v0[2], v0[3]); w[bj].z = pk2(v1[0], v1[1]); w[bj].w = pk2(v1[2], v1[3]); }
                    store_pair128(proj + (size_t)(rows + ai * HALF + m * 16) * DIN + cols, DIN, hi, w[0], w[1]); }
        } else {
            const int gcw = colw - DIN;
            f32x4 bv[2][2];
#pragma unroll
            for (int bj = 0; bj < 2; ++bj)
#pragma unroll
                for (int n = 0; n < 2; ++n) bv[bj][n] = *(const f32x4*)(bgate + gcw + 32 * bj + 4 * n);
#pragma unroll
            for (int ai = 0; ai < 2; ++ai)
#pragma unroll
                for (int m = 0; m < 4; ++m) { u32x4 w[2];
#pragma unroll
                    for (int bj = 0; bj < 2; ++bj) { const f32x4 v0 = acc[ai][bj][m][0] + bv[bj][0], v1 = acc[ai][bj][m][1] + bv[bj][1];
                        w[bj].x = pk2(fsigmoid(v0[0]), fsigmoid(v0[1])); w[bj].y = pk2(fsigmoid(v0[2]), fsigmoid(v0[3])); w[bj].z = pk2(fsigmoid(v1[0]), fsigmoid(v1[1])); w[bj].w = pk2(fsigmoid(v1[2]), fsigmoid(v1[3])); }
                    store_pair128(gates + (size_t)(rows + ai * HALF + m * 16) * NGATE + (cols - DIN), NGATE, hi, w[0], w[1]); }
        }
    }
};
struct EpiBf16 {
    static constexpr bool PERM = true, HAS_MID = false, ADJ = false; static constexpr int MID_T = -1;
    bf16_t* O; int ldc;
    __device__ __forceinline__ void mid(Acc&, const Unit&, int, int, int, int) const {}
    __device__ __forceinline__ void fin(const Acc& acc, const Unit& u, int wr, int wc, int fr, int fq) const {
        asm volatile("" : "+v"(fr), "+v"(fq));
        const int row0 = u.pm * BM + wr * 64 + fr; const int col0 = u.pn * BM + wc * 32 + 8 * fq;
#pragma unroll
        for (int ai = 0; ai < 2; ++ai)
#pragma unroll
            for (int m = 0; m < 4; ++m) { bf16_t* rowp = O + (size_t)(row0 + ai * HALF + m * 16) * ldc + col0;
#pragma unroll
                for (int bj = 0; bj < 2; ++bj) { const f32x4 v0 = acc[ai][bj][m][0], v1 = acc[ai][bj][m][1]; u32x4 w; w.x = pk2(v0[0], v0[1]); w.y = pk2(v0[2], v0[3]); w.z = pk2(v1[0], v1[1]); w.w = pk2(v1[2], v1[3]);
                    *(u32x4*)(rowp + bj * HALF) = w; } }
    }
};
struct EpiMerge {
    static constexpr bool PERM = true, HAS_MID = true, ADJ = true; static constexpr int MID_T = 16;
    const bf16_t* gates; bf16_t* O;
    static __device__ __forceinline__ void unswap(bool hi, const u32x4 l1, const u32x4 l2, u32x4& b0, u32x4& b1) { const u32x4 rc = ror8u(hi ? l1 : l2); b0 = hi ? rc : l1; b1 = hi ? l2 : rc; }
    __device__ __forceinline__ void mid(Acc& acc, const Unit& u, int wr, int wc, int fr, int fq) const {
        asm volatile("" : "+v"(fr), "+v"(fq));
        const bool hi = fr >= 8;
        const bf16_t* gbase = gates + (size_t)(u.pm * BM + wr * 64 + (fr & 7)) * NGATE + u.pn * BM + wc * 64 + 8 * fq + (hi ? 32 : 0);
#pragma unroll
        for (int ai = 0; ai < 2; ++ai) {
            u32x4 r1[4], r2[4], m1[4], m2[4];
#pragma unroll
            for (int m = 0; m < 4; ++m) { const bf16_t* gp = gbase + (size_t)(ai * HALF + m * 16) * NGATE;
                r1[m] = *(const u32x4*)gp; r2[m] = *(const u32x4*)(gp + 8 * NGATE); m1[m] = *(const u32x4*)(gp + DM); m2[m] = *(const u32x4*)(gp + 8 * NGATE + DM); }
#pragma unroll
            for (int m = 0; m < 4; ++m) { u32x4 gr[2], gm[2]; unswap(hi, r1[m], r2[m], gr[0], gr[1]); unswap(hi, m1[m], m2[m], gm[0], gm[1]);
#pragma unroll
                for (int bj = 0; bj < 2; ++bj) { float a[8], b[8]; unpack8(gr[bj], a); unpack8(gm[bj], b);
                    f32x4 q0, q1;
#pragma unroll
                    for (int j = 0; j < 4; ++j) { q0[j] = a[j] * __builtin_amdgcn_rcpf(fmaxf(b[j], 1e-30f)); q1[j] = a[4 + j] * __builtin_amdgcn_rcpf(fmaxf(b[4 + j], 1e-30f)); }
                    acc[ai][bj][m][0] *= q0; acc[ai][bj][m][1] *= q1; } }
            asm volatile("" ::: "memory");
        }
    }
    __device__ __forceinline__ void fin(const Acc& acc, const Unit& u, int wr, int wc, int fr, int fq) const {
        asm volatile("" : "+v"(fr), "+v"(fq));
        const bool hi = fr >= 8;
        const size_t rs = (size_t)(u.pm * BM + wr * 64 + (fr & 7)); const int cs = u.pn * BM + wc * 64 + 8 * fq + (hi ? 32 : 0);
#pragma unroll
        for (int ai = 0; ai < 2; ++ai)
#pragma unroll
            for (int m = 0; m < 4; ++m) { const size_t r = rs + ai * HALF + m * 16; const bf16_t* gp = gates + r * NGATE + DM + cs;
                u32x4 gm[2]; unswap(hi, *(const u32x4*)gp, *(const u32x4*)(gp + 8 * NGATE), gm[0], gm[1]);
                u32x4 w[2];
#pragma unroll
                for (int bj = 0; bj < 2; ++bj) { float b[8]; unpack8(gm[bj], b); const f32x4 v0 = acc[ai][bj][m][0], v1 = acc[ai][bj][m][1];
                    w[bj].x = pk2(v0[0] * b[0], v0[1] * b[1]); w[bj].y = pk2(v0[2] * b[2], v0[3] * b[3]); w[bj].z = pk2(v1[0] * b[4], v1[1] * b[5]); w[bj].w = pk2(v1[2] * b[6], v1[3] * b[7]); }
                store_pair128(O + r * DM + cs, DM, hi, w[0], w[1]); }
    }
};
struct EpiResid {
    static constexpr bool PERM = false, HAS_MID = false, ADJ = false; static constexpr int MID_T = -1;
    const bf16_t* base; float* out;
    __device__ __forceinline__ void mid(Acc&, const Unit&, int, int, int, int) const {}
    __device__ __forceinline__ void fin(const Acc& acc, const Unit& u, int wr, int wc, int fr, int fq) const {
        asm volatile("" : "+v"(fr), "+v"(fq));
        const bool hi = fr >= 8;
        const int row0 = u.pm * BM + wr * 64 + (fr & 7); const int col0 = u.pn * BM + wc * 32 + (hi ? 16 : 0) + 4 * fq;
#pragma unroll
        for (int ai = 0; ai < 2; ++ai)
#pragma unroll
            for (int m = 0; m < 4; ++m) { const size_t off = (size_t)(row0 + ai * HALF + m * 16) * DM + col0;
#pragma unroll
                for (int bj = 0; bj < 2; ++bj) { const f32x4 a0 = acc[ai][bj][m][0], a1 = acc[ai][bj][m][1]; const f32x4 rc = ror8(hi ? a0 : a1);
                    const f32x4 first = hi ? rc : a0, second = hi ? a1 : rc;
                    const u32x2 p1 = *(const u32x2*)(base + off + bj * HALF), p2 = *(const u32x2*)(base + off + 8 * DM + bj * HALF);
                    const f32x4 b1 = (f32x4){bflo(p1.x), bfhi(p1.x), bflo(p1.y), bfhi(p1.y)}, b2 = (f32x4){bflo(p2.x), bfhi(p2.x), bflo(p2.y), bfhi(p2.y)};
                    *(f32x4*)(out + off + bj * HALF) = b1 + first; *(f32x4*)(out + off + 8 * DM + bj * HALF) = b2 + second; } }
    }
};

struct EpiConv {
    static constexpr bool PERM = false, HAS_MID = false, ADJ = false; static constexpr int MID_T = -1;
    bf16_t* act; float* UH; const float* cw; const float* cb; f32x2* X; const float* rstd;
    __device__ __forceinline__ void mid(Acc&, const Unit&, int, int, int, int) const {}
    __device__ __forceinline__ void fin(Acc& acc, const Unit& u, int wr, int wc, int fr, int fq) const {
        asm volatile("" : "+v"(fr), "+v"(fq));
        const int lane = fr + 16 * fq, src_lane = (lane - 16) & 63;
        float cp[2][8];
#pragma unroll
        for (int n = 0; n < 2; ++n) { const int c = u.pn * HALF + wc * 32 + n * 16 + fr;
            cp[n][0] = cb[c]; cp[n][1] = cw[c]; cp[n][2] = cw[NUP + c]; cp[n][3] = cw[2 * NUP + c];
            cp[n][4] = cb[DFF + c]; cp[n][5] = cw[DFF + c]; cp[n][6] = cw[NUP + DFF + c]; cp[n][7] = cw[2 * NUP + DFF + c]; }
        f32x4 rsv[2][4];
#pragma unroll
        for (int ai = 0; ai < 2; ++ai)
#pragma unroll
            for (int m = 0; m < 4; ++m) rsv[ai][m] = *(const f32x4*)(rstd + u.pm * BM + ai * HALF + wr * 64 + 16 * m + 4 * fq);
#pragma unroll
        for (int ai = 0; ai < 2; ++ai)
#pragma unroll
            for (int m = 0; m < 4; ++m) { const f32x4 rs = rsv[ai][m];
#pragma unroll
                for (int bj = 0; bj < 2; ++bj)
#pragma unroll
                    for (int n = 0; n < 2; ++n) acc[ai][bj][m][n] *= rs; }
        if (fq == 3) {
#pragma unroll
            for (int ai = 0; ai < 2; ++ai)
#pragma unroll
                for (int bj = 0; bj < 2; ++bj)
#pragma unroll
                    for (int n = 0; n < 2; ++n) X[((((ai * 2 + wr) * 2 + bj) * 4 + wc) * 2 + n) * 16 + fr] = (f32x2){acc[ai][bj][3][n][2], acc[ai][bj][3][n][3]};
        }
        {
            const int colt = u.pn * BM + wc * 32 + fr;
            if (wr == 0 && fq == 0) {
#pragma unroll
                for (int bj = 0; bj < 2; ++bj)
#pragma unroll
                    for (int n = 0; n < 2; ++n) { UH[((size_t)u.pm * 4 + 0) * NUP + colt + bj * HALF + n * 16] = acc[0][bj][0][n][0]; UH[((size_t)u.pm * 4 + 1) * NUP + colt + bj * HALF + n * 16] = acc[0][bj][0][n][1]; }
            }
            if (wr == 1 && fq == 3) {
#pragma unroll
                for (int bj = 0; bj < 2; ++bj)
#pragma unroll
                    for (int n = 0; n < 2; ++n) { UH[((size_t)u.pm * 4 + 2) * NUP + colt + bj * HALF + n * 16] = acc[1][bj][3][n][2]; UH[((size_t)u.pm * 4 + 3) * NUP + colt + bj * HALF + n * 16] = acc[1][bj][3][n][3]; }
            }
        }
        asm volatile("s_waitcnt lgkmcnt(0)" ::: "memory"); __builtin_amdgcn_s_barrier(); asm volatile("" ::: "memory");
#pragma unroll
        for (int n = 0; n < 2; ++n) {
            const int c = u.pn * HALF + wc * 32 + n * 16 + fr;
            const float gb = cp[n][0], g0 = cp[n][1], g1 = cp[n][2], g2 = cp[n][3];
            const float vb = cp[n][4], v0 = cp[n][5], v1 = cp[n][6], v2 = cp[n][7];
#pragma unroll
            for (int ai = 0; ai < 2; ++ai) {
                f32x2 xg = (f32x2){0.f, 0.f}, xv = (f32x2){0.f, 0.f};
                if (!(ai == 0 && wr == 0)) { const int sa = wr ? ai : ai - 1, sw = wr ? 0 : 1;
                    xg = X[((((sa * 2 + sw) * 2 + 0) * 4 + wc) * 2 + n) * 16 + fr]; xv = X[((((sa * 2 + sw) * 2 + 1) * 4 + wc) * 2 + n) * 16 + fr]; }
                bf16_t* ap = act + (size_t)(u.pm * BM + ai * HALF + wr * 64 + 4 * fq) * DFF + c;
#pragma unroll
                for (int m = 0; m < 4; ++m) {
                    const f32x4 a = acc[ai][0][m][n], b = acc[ai][1][m][n];
                    const f32x4 pa = acc[ai][0][m > 0 ? m - 1 : 0][n], pb = acc[ai][1][m > 0 ? m - 1 : 0][n];
                    const bool up = (fq == 3) && (m > 0);
                    float a2 = __shfl(up ? pa[2] : a[2], src_lane), a1 = __shfl(up ? pa[3] : a[3], src_lane);
                    float b2 = __shfl(up ? pb[2] : b[2], src_lane), b1 = __shfl(up ? pb[3] : b[3], src_lane);
                    if (m == 0 && fq == 0) { a2 = xg.x; a1 = xg.y; b2 = xv.x; b1 = xv.y; }
                    const float og0 = gb + g0 * a2 + g1 * a1 + g2 * a[0], og1 = gb + g0 * a1 + g1 * a[0] + g2 * a[1], og2 = gb + g0 * a[0] + g1 * a[1] + g2 * a[2], og3 = gb + g0 * a[1] + g1 * a[2] + g2 * a[3];
                    const float ov0 = vb + v0 * b2 + v1 * b1 + v2 * b[0], ov1 = vb + v0 * b1 + v1 * b[0] + v2 * b[1], ov2 = vb + v0 * b[0] + v1 * b[1] + v2 * b[2], ov3 = vb + v0 * b[1] + v1 * b[2] + v2 * b[3];
                    const unsigned w01 = pk2(og0 * fsigmoid(og0) * ov0, og1 * fsigmoid(og1) * ov1), w23 = pk2(og2 * fsigmoid(og2) * ov2, og3 * fsigmoid(og3) * ov3);
                    bf16_t* rp = ap + (size_t)(16 * m) * DFF;
                    rp[0] = (bf16_t)(w01 & 0xffffu); rp[DFF] = (bf16_t)(w01 >> 16); rp[2 * DFF] = (bf16_t)(w23 & 0xffffu); rp[3 * DFF] = (bf16_t)(w23 >> 16);
                }
            }
        }
    }
};

struct EpiResidNorm {
    static constexpr bool PERM = false, HAS_MID = false, ADJ = false; static constexpr int MID_T = -1;
    const float* base; bf16_t* xb; float* ss;
    __device__ __forceinline__ void mid(Acc&, const Unit&, int, int, int, int) const {}
    __device__ __forceinline__ void fin(const Acc& acc, const Unit& u, int wr, int wc, int fr, int fq) const {
        asm volatile("" : "+v"(fr), "+v"(fq));
        const bool hi = fr >= 8;
        const int row0 = u.pm * BM + wr * 64 + (fr & 7); const int col0 = u.pn * BM + wc * 32 + (hi ? 16 : 0) + 4 * fq;
#pragma unroll
        for (int ai = 0; ai < 2; ++ai)
#pragma unroll
            for (int m = 0; m < 4; ++m) { const int row = row0 + ai * HALF + m * 16; const size_t off = (size_t)row * DM + col0; float s1 = 0.f, s2 = 0.f;
#pragma unroll
                for (int bj = 0; bj < 2; ++bj) { const f32x4 a0 = acc[ai][bj][m][0], a1 = acc[ai][bj][m][1]; const f32x4 rc = ror8(hi ? a0 : a1);
                    const f32x4 first = hi ? rc : a0, second = hi ? a1 : rc;
                    const f32x4 v1 = *(const f32x4*)(base + off + bj * HALF) + first, v2 = *(const f32x4*)(base + off + 8 * DM + bj * HALF) + second;
                    s1 += (v1[0] * v1[0] + v1[1] * v1[1]) + (v1[2] * v1[2] + v1[3] * v1[3]); s2 += (v2[0] * v2[0] + v2[1] * v2[1]) + (v2[2] * v2[2] + v2[3] * v2[3]);
                    u32x2 w1; w1.x = pk2(v1[0], v1[1]); w1.y = pk2(v1[2], v1[3]); *(u32x2*)(xb + off + bj * HALF) = w1;
                    u32x2 w2; w2.x = pk2(v2[0], v2[1]); w2.y = pk2(v2[2], v2[3]); *(u32x2*)(xb + off + 8 * DM + bj * HALF) = w2; }
                s1 += __shfl_xor(s1, 8); s1 += __shfl_xor(s1, 16); s1 += __shfl_xor(s1, 32); s2 += __shfl_xor(s2, 8); s2 += __shfl_xor(s2, 16); s2 += __shfl_xor(s2, 32);
                if (fq == 0 && !hi) { ss[(size_t)row * 16 + u.pn * 4 + wc] = s1; ss[(size_t)(row + 8) * 16 + u.pn * 4 + wc] = s2; } }
    }
};
}

__device__ __forceinline__ float wave_sum(float v) {
#pragma unroll
    for (int o = 1; o < 64; o <<= 1) v += __shfl_xor(v, o);
    return v;
}
template <int UPPERM = 0>
__device__ __forceinline__ void transpose_item(const float* W, int K, int N, bf16_t* WT, int ldt, int row_off, int col_off, float* scr, int item, int lane, const float* kgain = nullptr) {
    const int nblk = N / 32, kb = item / nblk, nb = item % nblk, k0 = 64 * kb, n0 = 32 * nb;
    int d0 = n0;
    if (UPPERM == 1) { const int isv = n0 >= DFF ? 1 : 0, c = n0 - isv * DFF; d0 = 256 * (c >> 7) + 128 * isv + (c & 127); }
    if (UPPERM == 2) { if (n0 < 2 * RET_QKW) { const int dd = n0 & 127; d0 = (n0 & ~127) + 64 * ((dd & 63) >> 5) + 32 * (dd >> 6); } }
    float wv[32];
#pragma unroll
    for (int i = 0; i < 32; ++i) { const int kk = 2 * i + (lane >> 5); wv[i] = W[(size_t)(k0 + kk) * N + n0 + (lane & 31)]; }
    if (kgain) {
#pragma unroll
        for (int i = 0; i < 32; ++i) wv[i] *= kgain[k0 + 2 * i + (lane >> 5)];
    }
#pragma unroll
    for (int i = 0; i < 32; ++i) scr[(2 * i + (lane >> 5)) * 33 + (lane & 31)] = wv[i];
    LDS_WAIT();
    const int c = lane & 7;
#pragma unroll
    for (int j = 0; j < 4; ++j) { const int n = (lane >> 3) + 8 * j; const float* s = scr + (8 * c) * 33 + n;
        u32x4 o; o.x = pk2(s[0 * 33], s[1 * 33]); o.y = pk2(s[2 * 33], s[3 * 33]); o.z = pk2(s[4 * 33], s[5 * 33]); o.w = pk2(s[6 * 33], s[7 * 33]);
        *(u32x4*)(WT + (size_t)(row_off + d0 + n) * ldt + col_off + k0 + 8 * c) = o; }
    LDS_WAIT();
}
__device__ __forceinline__ void rms_row_to_bf16(const float* xrow, const float* gain, bf16_t* orow, int lane) {
    const f32x4* xr = (const f32x4*)xrow + lane; const f32x4* gr = (const f32x4*)gain + lane;
    f32x4 v[4]; float s = 0.f;
#pragma unroll
    for (int j = 0; j < 4; ++j) { v[j] = xr[64 * j]; s += (v[j].x * v[j].x + v[j].y * v[j].y) + (v[j].z * v[j].z + v[j].w * v[j].w); }
    const float rstd = 1.f / sqrtf(wave_sum(s) * (1.f / DM) + EPS);
    u32x2* o8 = (u32x2*)orow + lane;
#pragma unroll
    for (int j = 0; j < 4; ++j) { const f32x4 gg = gr[64 * j]; u32x2 w; w.x = pk2(v[j].x * rstd * gg.x, v[j].y * rstd * gg.y); w.y = pk2(v[j].z * rstd * gg.z, v[j].w * rstd * gg.w); o8[64 * j] = w; }
}

__device__ __forceinline__ void retention_item(unsigned char* lds, bf16_t* proj, const f32x2* rope, f32x2* stats, int b, int h, int sl, bf16_t* dry = nullptr) {
    int tid_ = threadIdx.x; asm volatile("" : "+v"(tid_));
    const int tid = tid_, lane = tid & 63, w = __builtin_amdgcn_readfirstlane(tid >> 6), l15 = lane & 15, quad = lane >> 4;
    constexpr int P = 136, VPR = 96;
    bf16_t* Qs = (bf16_t*)lds;
    bf16_t* Kz = Qs + 128 * P;
    bf16_t* Vs = Kz + 128 * P;
    bf16_t* RsT = Vs + 128 * VPR;
    const float lg2 = __builtin_log2f(1.f - __builtin_amdgcn_exp2f(-5.f - (float)h));
    const float gamma_c = __builtin_amdgcn_exp2f(lg2 * 128.f);
    const float kscale = 0.08838834764831845f;
    for (int i = tid; i < 64 * P / 2; i += 512) ((unsigned*)RsT)[i] = 0u;
    f32x4 accR[4];
#pragma unroll
    for (int i = 0; i < 4; ++i) accR[i] = (f32x4){0.f, 0.f, 0.f, 0.f};
    const size_t rowbase = (size_t)b * SEQ;
    u32x4 rq1[2], rq2[2], rk1[2], rk2[2], rv[2];
#define RET_LOAD(n_) do { _Pragma("unroll") for (int k_ = 0; k_ < 2; ++k_) { const int i_ = tid + 512 * k_, r_ = i_ >> 3, g_ = i_ & 7; \
        const bf16_t* qp_ = proj + (rowbase + (n_) * 128 + r_) * DIN + C_QR + h * 128 + 8 * g_; \
        rq1[k_] = *(const u32x4*)qp_; rq2[k_] = *(const u32x4*)(qp_ + 64); rk1[k_] = *(const u32x4*)(qp_ + C_KR); rk2[k_] = *(const u32x4*)(qp_ + C_KR + 64); \
        rv[k_] = *(const u32x4*)(proj + (rowbase + (n_) * 128 + r_) * DIN + C_VR + h * 256 + sl * 64 + 8 * g_); } } while (0)
    RET_LOAD(0);
    const LAS bf16_t* VsL = (const LAS bf16_t*)Vs; const LAS bf16_t* KzL = (const LAS bf16_t*)Kz;
    const int trr = l15 >> 2, trc = 4 * (l15 & 3);
    for (int n = 0; n < 16; ++n) {
        const int t0 = n * 128;
#pragma unroll
        for (int k = 0; k < 2; ++k) {
            const int i = tid + 512 * k, r = i >> 3, g8 = i & 7;
            *(u32x4*)(Qs + r * P + 8 * g8) = rq1[k]; *(u32x4*)(Qs + r * P + 64 + 8 * g8) = rq2[k];
            *(u32x4*)(Kz + r * P + 8 * g8) = rk1[k]; *(u32x4*)(Kz + r * P + 64 + 8 * g8) = rk2[k];
            *(u32x4*)(Vs + r * VPR + 8 * g8) = rv[k];
        }
        __syncthreads();
        if (n + 1 < 16) RET_LOAD(n + 1);
        bf16x8 qf[4];
#pragma unroll
        for (int s = 0; s < 4; ++s) qf[s] = *(const bf16x8*)(Qs + (16 * w + l15) * P + 32 * s + 8 * quad);
        u32x4 pf[4];
#pragma unroll
        for (int s = 0; s < 4; ++s) pf[s] = (u32x4){0u, 0u, 0u, 0u};
        const int qpos = 16 * w + l15;
        const float qfac = __builtin_amdgcn_exp2f(lg2 * (float)(qpos - 127));
#pragma unroll
        for (int kb = 0; kb < 8; ++kb) {
            if (kb <= w) {
                f32x4 a = (f32x4){0.f, 0.f, 0.f, 0.f};
#pragma unroll
                for (int s = 0; s < 4; ++s) { const bf16x8 kf = *(const bf16x8*)(Kz + (16 * kb + l15) * P + 32 * s + 8 * quad); a = __builtin_amdgcn_mfma_f32_16x16x32_bf16(kf, qf[s], a, 0, 0, 0); }
                float pv[4];
#pragma unroll
                for (int i = 0; i < 4; ++i) pv[i] = (qpos >= 16 * kb + 4 * quad + i) ? a[i] * qfac : 0.f;
                if (kb & 1) { pf[kb >> 1].z = pk2(pv[0], pv[1]); pf[kb >> 1].w = pk2(pv[2], pv[3]); } else { pf[kb >> 1].x = pk2(pv[0], pv[1]); pf[kb >> 1].y = pk2(pv[2], pv[3]); }
            }
        }
        f32x4 ao[4], ac[4];
#pragma unroll
        for (int i = 0; i < 4; ++i) { ao[i] = (f32x4){0.f, 0.f, 0.f, 0.f}; ac[i] = (f32x4){0.f, 0.f, 0.f, 0.f}; }
#pragma unroll
        for (int s2 = 0; s2 < 4; ++s2) {
            if (2 * s2 <= w) {
#pragma unroll
                for (int dvb = 0; dvb < 4; ++dvb) { const LAS bf16_t* vp = VsL + (32 * s2 + 4 * quad + trr) * VPR + 16 * dvb + trc;
                    const s16x4 lo = __builtin_amdgcn_ds_read_tr16_b64_v4i16((LAS s16x4*)vp), hi = __builtin_amdgcn_ds_read_tr16_b64_v4i16((LAS s16x4*)(vp + 16 * VPR));
                    const bf16x8 va = __builtin_shufflevector(lo, hi, 0, 1, 2, 3, 4, 5, 6, 7);
                    ao[dvb] = __builtin_amdgcn_mfma_f32_16x16x32_bf16(va, __builtin_bit_cast(bf16x8, pf[s2]), ao[dvb], 0, 0, 0); }
            }
        }
#pragma unroll
        for (int s = 0; s < 4; ++s)
#pragma unroll
            for (int dvb = 0; dvb < 4; ++dvb) { const bf16x8 ra = *(const bf16x8*)(RsT + (16 * dvb + l15) * P + 32 * s + 8 * quad); ac[dvb] = __builtin_amdgcn_mfma_f32_16x16x32_bf16(ra, qf[s], ac[dvb], 0, 0, 0); }
        const float xi = __builtin_amdgcn_exp2f(lg2 * (float)(qpos + 1));
        float s1 = 0.f, s2s = 0.f;
        bf16_t* op = dry ? dry + tid * 128 : proj + (rowbase + t0 + qpos) * DIN + C_VR + h * 256 + sl * 64 + 4 * quad;
#pragma unroll
        for (int dvb = 0; dvb < 4; ++dvb) { const f32x4 o = ao[dvb] + ac[dvb] * xi; s1 += (o[0] + o[1]) + (o[2] + o[3]); s2s += (o[0] * o[0] + o[1] * o[1]) + (o[2] * o[2] + o[3] * o[3]);
            u32x2 wv; wv.x = pk2(o[0], o[1]); wv.y = pk2(o[2], o[3]); *(u32x2*)(op + 16 * dvb) = wv; }
        s1 += __shfl_xor(s1, 16); s1 += __shfl_xor(s1, 32); s2s += __shfl_xor(s2s, 16); s2s += __shfl_xor(s2s, 32);
        if (quad == 0) { if (dry) ((f32x2*)dry)[65536 + tid] = (f32x2){s1, s2s}; else stats[((rowbase + t0 + qpos) * 4 + h) * 4 + sl] = (f32x2){s1, s2s}; }
#pragma unroll
        for (int dvb = 0; dvb < 4; ++dvb) accR[dvb] *= gamma_c;
#pragma unroll
        for (int s = 0; s < 4; ++s) { const LAS bf16_t* kp = KzL + (32 * s + 8 * quad + trr) * P + 16 * w + trc;
            const s16x4 klo = __builtin_amdgcn_ds_read_tr16_b64_v4i16((LAS s16x4*)kp), khi = __builtin_amdgcn_ds_read_tr16_b64_v4i16((LAS s16x4*)(kp + 4 * P));
            const bf16x8 ka = __builtin_shufflevector(klo, khi, 0, 1, 2, 3, 4, 5, 6, 7);
#pragma unroll
            for (int dvb = 0; dvb < 4; ++dvb) { const LAS bf16_t* vp = VsL + (32 * s + 8 * quad + trr) * VPR + 16 * dvb + trc;
                const s16x4 vlo = __builtin_amdgcn_ds_read_tr16_b64_v4i16((LAS s16x4*)vp), vhi = __builtin_amdgcn_ds_read_tr16_b64_v4i16((LAS s16x4*)(vp + 4 * VPR));
                const bf16x8 vb = __builtin_shufflevector(vlo, vhi, 0, 1, 2, 3, 4, 5, 6, 7);
                accR[dvb] = __builtin_amdgcn_mfma_f32_16x16x32_bf16(ka, vb, accR[dvb], 0, 0, 0); } }
        __syncthreads();
#pragma unroll
        for (int dvb = 0; dvb < 4; ++dvb) { u32x2 wv; wv.x = pk2(accR[dvb][0], accR[dvb][1]); wv.y = pk2(accR[dvb][2], accR[dvb][3]); *(u32x2*)(RsT + (16 * dvb + l15) * P + 16 * w + 4 * quad) = wv; }
    }
#undef RET_LOAD
    __syncthreads();
}

__device__ __forceinline__ void knorm_item(unsigned char* lds, bf16_t* proj, const float* kgain, float* kmean, int b, int h, int blk) {
    const int tid = threadIdx.x, lane = tid & 63, w = __builtin_amdgcn_readfirstlane(tid >> 6), l15 = lane & 15, quad = lane >> 4;
    float* red = (float*)lds;
    float csum[8], gn[8];
#pragma unroll
    for (int j = 0; j < 8; ++j) { csum[j] = 0.f; gn[j] = kgain[8 * l15 + j]; }
    for (int st = 0; st < 8; ++st) {
        const int r = 32 * w + 4 * st + quad;
        bf16_t* p = proj + ((size_t)b * SEQ + blk * 256 + r) * DIN + C_KM + h * 128 + 8 * l15;
        const u32x4 v = *(const u32x4*)p; float f[8]; unpack8(v, f);
        float ss = 0.f;
#pragma unroll
        for (int j = 0; j < 8; ++j) ss += f[j] * f[j];
        ss += __shfl_xor(ss, 1); ss += __shfl_xor(ss, 2); ss += __shfl_xor(ss, 4); ss += __shfl_xor(ss, 8);
        const float rstd = 1.f / sqrtf(ss * (1.f / 128.f) + EPS);
#pragma unroll
        for (int j = 0; j < 8; ++j) { f[j] = f[j] * rstd * gn[j]; csum[j] += f[j]; }
        *(u32x4*)p = pack8(f);
    }
#pragma unroll
    for (int j = 0; j < 8; ++j) { csum[j] += __shfl_xor(csum[j], 16); csum[j] += __shfl_xor(csum[j], 32); }
    if (quad == 0) {
#pragma unroll
        for (int j = 0; j < 8; ++j) red[w * 128 + 8 * l15 + j] = csum[j];
    }
    __syncthreads();
    if (tid < 128) { float s = 0.f;
#pragma unroll
        for (int k = 0; k < 8; ++k) s += red[k * 128 + tid];
        kmean[(((size_t)b * 8 + h) * 8 + blk) * 128 + tid] = s * (1.f / 256.f); }
    __syncthreads();
}
__device__ __forceinline__ void qnorm_rows(bf16_t* proj, const float* qgain, int row4, int lane) {
    const int l15 = lane & 15, quad = lane >> 4;
    float gn[8];
#pragma unroll
    for (int j = 0; j < 8; ++j) gn[j] = qgain[8 * l15 + j];
    bf16_t* base = proj + (size_t)(4 * row4 + quad) * DIN + C_QM + 8 * l15;
#pragma unroll
    for (int hh = 0; hh < 8; ++hh) {
        bf16_t* p = base + hh * 128;
        const u32x4 v = *(const u32x4*)p; float f[8]; unpack8(v, f);
        float ss = 0.f;
#pragma unroll
        for (int j = 0; j < 8; ++j) ss += f[j] * f[j];
        ss += __shfl_xor(ss, 1); ss += __shfl_xor(ss, 2); ss += __shfl_xor(ss, 4); ss += __shfl_xor(ss, 8);
        const float rstd = 1.f / sqrtf(ss * (1.f / 128.f) + EPS);
#pragma unroll
        for (int j = 0; j < 8; ++j) f[j] = f[j] * rstd * gn[j];
        *(u32x4*)p = pack8(f);
    }
}
__device__ __forceinline__ void vtrans_item(bf16_t* T, const bf16_t* proj, bf16_t* Vt, int item, int lane) {
    const int dh = item & 1, st = (item >> 1) & 31, h = (item >> 6) & 7, b = item >> 9;
    const bf16_t* src = proj + ((size_t)b * SEQ + 64 * st + lane) * DIN + C_VM + h * 128 + 64 * dh;
#pragma unroll
    for (int c = 0; c < 8; ++c) { const u32x4 v = *(const u32x4*)(src + 8 * c);
        T[(8 * c + 0) * 72 + lane] = (bf16_t)(v.x & 0xffffu); T[(8 * c + 1) * 72 + lane] = (bf16_t)(v.x >> 16);
        T[(8 * c + 2) * 72 + lane] = (bf16_t)(v.y & 0xffffu); T[(8 * c + 3) * 72 + lane] = (bf16_t)(v.y >> 16);
        T[(8 * c + 4) * 72 + lane] = (bf16_t)(v.z & 0xffffu); T[(8 * c + 5) * 72 + lane] = (bf16_t)(v.z >> 16);
        T[(8 * c + 6) * 72 + lane] = (bf16_t)(v.w & 0xffffu); T[(8 * c + 7) * 72 + lane] = (bf16_t)(v.w >> 16); }
    LDS_WAIT();
    const int g = lane & 7;
#pragma unroll
    for (int k = 0; k < 8; ++k) { const int d = (lane >> 3) + 8 * k; const u32x4 o = *(const u32x4*)(T + d * 72 + 8 * g);
        *(u32x4*)(Vt + (((size_t)b * 8 + h) * 128 + 64 * dh + d) * SEQ + 64 * st + 8 * g) = o; }
    LDS_WAIT();
}

__device__ __forceinline__ int crow(int r, int hi) { return (r & 3) + 8 * (r >> 2) + 4 * hi; }
__device__ __forceinline__ void moba_unit(unsigned char* lds, bf16_t* proj, const bf16_t* Vt, const float* kmean, int b, int h, int own, bf16_t* dry = nullptr) {
    int tid_ = threadIdx.x; asm volatile("" : "+v"(tid_));
    const int tid = tid_, lane = tid & 63, w = __builtin_amdgcn_readfirstlane(tid >> 6), r32 = lane & 31, hh = lane >> 5;
    constexpr int KP = 136, VP = 144;
    bf16_t* KsB = (bf16_t*)lds;
    bf16_t* VsB = KsB + 2 * 128 * KP;
    const size_t rowbase = (size_t)b * SEQ;
    const int qrel = 32 * w + r32;
    bf16_t* qptr = proj + (rowbase + own * 256 + qrel) * DIN + C_QM + h * 128;
    bf16x8 qf[8];
#pragma unroll
    for (int s = 0; s < 8; ++s) qf[s] = *(const bf16x8*)(qptr + 16 * s + 8 * hh);
    unsigned sel = 0u;
    {
        float g[7];
        const float* km = kmean + ((size_t)b * 8 + h) * 8 * 128;
#pragma unroll
        for (int jb = 0; jb < 7; ++jb) {
            float a = 0.f;
            if (jb < own) {
#pragma unroll
                for (int s = 0; s < 8; ++s) { const f32x4 k0 = *(const f32x4*)(km + jb * 128 + 16 * s + 8 * hh), k1 = *(const f32x4*)(km + jb * 128 + 16 * s + 8 * hh + 4);
                    const u32x4 qu = __builtin_bit_cast(u32x4, qf[s]);
                    a += bflo(qu.x) * k0.x + bfhi(qu.x) * k0.y + bflo(qu.y) * k0.z + bfhi(qu.y) * k0.w + bflo(qu.z) * k1.x + bfhi(qu.z) * k1.y + bflo(qu.w) * k1.z + bfhi(qu.w) * k1.w; }
                a = xsum32(a);
            }
            g[jb] = a;
        }
#pragma unroll
        for (int jb = 0; jb < 7; ++jb) {
            int rank = 0;
#pragma unroll
            for (int j2 = 0; j2 < 7; ++j2) { if (j2 != jb) { const bool better = (g[j2] > g[jb]) || (g[j2] == g[jb] && j2 < jb); rank += (j2 < own && better) ? 1 : 0; } }
            if (jb < own && rank < 3) sel |= (1u << jb);
        }
    }
    f32x16 o[4];
#pragma unroll
    for (int i = 0; i < 4; ++i)
#pragma unroll
        for (int r = 0; r < 16; ++r) o[i][r] = 0.f;
    float mrun = -1e30f, lrun = 0.f;
    const float SC = 0.08838834764831845f * 1.4426950408889634f;
    const int NT = 4 * (own + 1);
    const bf16_t* kg = proj + rowbase * DIN + C_KM + h * 128;
    const bf16_t* vg = proj + rowbase * DIN + C_VM + h * 128;
    const int vtoff = (4 * hh + ((lane & 15) >> 2)) * VP + 16 * ((lane >> 4) & 1) + 4 * (lane & 3);
    u32x4 kr[4], vr[4];
#define MOBA_LOAD(T_) do { _Pragma("unroll") for (int k_ = 0; k_ < 4; ++k_) { const int c_ = tid + 512 * k_; \
        kr[k_] = *(const u32x4*)(kg + (size_t)(128 * (T_) + (c_ >> 4)) * DIN + 8 * (c_ & 15)); \
        vr[k_] = *(const u32x4*)(vg + (size_t)(128 * (T_) + (c_ >> 4)) * DIN + 8 * (c_ & 15)); } } while (0)
#define MOBA_STORE(buf) do { _Pragma("unroll") for (int k_ = 0; k_ < 4; ++k_) { const int c_ = tid + 512 * k_; \
        *(u32x4*)(KsB + (buf) * 128 * KP + (c_ >> 4) * KP + 8 * (c_ & 15)) = kr[k_]; \
        *(u32x4*)(VsB + (buf) * 128 * VP + (c_ >> 4) * VP + 8 * (c_ & 15)) = vr[k_]; } } while (0)
    MOBA_LOAD(0);
    for (int T = 0; T < NT / 2; ++T) {
        const int buf = T & 1;
        MOBA_STORE(buf);
        __syncthreads();
        if (2 * T + 2 < NT) MOBA_LOAD(T + 1);
#pragma unroll
      for (int hf = 0; hf < 2; ++hf) {
        const int t = 2 * T + hf;
        const int jb = t >> 2, kt = t & 3;
        const bool isown = (jb == own);
        bool active;
        if (isown) active = (64 * kt <= 32 * w + 31);
        else active = __any((sel >> jb) & 1u) != 0;
        if (active) {
            const bf16_t* Kt = KsB + (buf * 128 + hf * 64) * KP; const LAS bf16_t* Vv = (const LAS bf16_t*)(VsB + (buf * 128 + hf * 64) * VP) + vtoff;
            f32x16 sc[2];
#pragma unroll
            for (int kb = 0; kb < 2; ++kb) {
#pragma unroll
                for (int r = 0; r < 16; ++r) sc[kb][r] = 0.f;
#pragma unroll
                for (int s = 0; s < 8; ++s) { const bf16x8 kf = *(const bf16x8*)(Kt + (32 * kb + r32) * KP + 16 * s + 8 * hh); sc[kb] = __builtin_amdgcn_mfma_f32_32x32x16_bf16(kf, qf[s], sc[kb], 0, 0, 0); }
            }
            const bool lane_sel = isown || (((sel >> jb) & 1u) != 0u);
            if (isown && (64 * kt + 63 > 32 * w)) {
#pragma unroll
                for (int kb = 0; kb < 2; ++kb)
#pragma unroll
                    for (int r = 0; r < 16; ++r) { const int krel = 64 * kt + 32 * kb + crow(r, hh); if (krel > qrel) sc[kb][r] = -INFINITY; }
            }
            float mx = -INFINITY;
#pragma unroll
            for (int kb = 0; kb < 2; ++kb)
#pragma unroll
                for (int r = 0; r < 16; ++r) mx = fmaxf(mx, sc[kb][r]);
            mx = xmax32(mx) * SC;
            const bool grow = lane_sel && (mx > mrun + 8.f);
            if (__any(grow)) {
                const float mnew = grow ? mx : mrun;
                const float alpha = __builtin_amdgcn_exp2f(mrun - mnew);
                lrun *= alpha; mrun = mnew;
#pragma unroll
                for (int i = 0; i < 4; ++i)
#pragma unroll
                    for (int r = 0; r < 16; ++r) o[i][r] *= alpha;
            }
            const float mref = lane_sel ? mrun : INFINITY;
            float ps = 0.f;
#pragma unroll
            for (int kb = 0; kb < 2; ++kb)
#pragma unroll
                for (int r = 0; r < 16; ++r) { const float p = __builtin_amdgcn_exp2f(__builtin_fmaf(sc[kb][r], SC, -mref)); sc[kb][r] = p; ps += p; }
            ps = xsum32(ps);
            lrun += ps;
#pragma unroll
            for (int kb = 0; kb < 2; ++kb)
#pragma unroll
                for (int s = 0; s < 2; ++s) {
                    u32x4 pw; pw.x = pk2(sc[kb][8 * s + 0], sc[kb][8 * s + 1]); pw.y = pk2(sc[kb][8 * s + 2], sc[kb][8 * s + 3]); pw.z = pk2(sc[kb][8 * s + 4], sc[kb][8 * s + 5]); pw.w = pk2(sc[kb][8 * s + 6], sc[kb][8 * s + 7]);
                    const bf16x8 pb = __builtin_bit_cast(bf16x8, pw);
#pragma unroll
                    for (int db = 0; db < 4; ++db) { const LAS bf16_t* vp = Vv + (32 * kb + 16 * s) * VP + 32 * db;
                        const s16x4 lo = __builtin_amdgcn_ds_read_tr16_b64_v4i16((LAS s16x4*)vp), hi = __builtin_amdgcn_ds_read_tr16_b64_v4i16((LAS s16x4*)(vp + 8 * VP));
                        const bf16x8 va = __builtin_shufflevector(lo, hi, 0, 1, 2, 3, 4, 5, 6, 7);
                        o[db] = __builtin_amdgcn_mfma_f32_32x32x16_bf16(va, pb, o[db], 0, 0, 0); }
                }
        }
      }
    }
#undef MOBA_LOAD
#undef MOBA_STORE
    const float rl = 1.f / lrun;
#pragma unroll
    for (int db = 0; db < 4; ++db)
#pragma unroll
        for (int g4 = 0; g4 < 4; ++g4) { u32x2 wv; wv.x = pk2(o[db][4 * g4 + 0] * rl, o[db][4 * g4 + 1] * rl); wv.y = pk2(o[db][4 * g4 + 2] * rl, o[db][4 * g4 + 3] * rl);
            *(u32x2*)((dry ? dry + tid * 8 : qptr + 32 * db + 8 * g4) + 4 * hh) = wv; }
    __syncthreads();
}

__device__ __forceinline__ void retfin_rows(bf16_t* proj, const f32x2* stats, const float* gain, const float* bias, int m_first, int m_step, int lane) {
    const int hd = lane >> 4;
    float gg[16], bb[16];
#pragma unroll
    for (int k = 0; k < 4; ++k) { const f32x4 g4 = *(const f32x4*)(gain + 16 * lane + 4 * k), b4 = *(const f32x4*)(bias + 16 * lane + 4 * k);
        gg[4 * k] = g4.x; gg[4 * k + 1] = g4.y; gg[4 * k + 2] = g4.z; gg[4 * k + 3] = g4.w; bb[4 * k] = b4.x; bb[4 * k + 1] = b4.y; bb[4 * k + 2] = b4.z; bb[4 * k + 3] = b4.w; }
    for (int m = m_first; m < M; m += 2 * m_step) {
        u32x4 ov[2][2], gv[2][2]; f32x2 st[2][4];
#pragma unroll
        for (int t = 0; t < 2; ++t) { const size_t mm = (size_t)(m + t * m_step); const bf16_t* op = proj + mm * DIN + C_VR + 16 * lane; const bf16_t* gp = proj + mm * DIN + C_GR + 16 * lane;
            ov[t][0] = *(const u32x4*)op; ov[t][1] = *(const u32x4*)(op + 8); gv[t][0] = *(const u32x4*)gp; gv[t][1] = *(const u32x4*)(gp + 8);
            const f32x2* sp = stats + (mm * 4 + hd) * 4; st[t][0] = sp[0]; st[t][1] = sp[1]; st[t][2] = sp[2]; st[t][3] = sp[3]; }
#pragma unroll
        for (int t = 0; t < 2; ++t) {
            const float mu = ((st[t][0].x + st[t][1].x) + (st[t][2].x + st[t][3].x)) * (1.f / 256.f);
            const float var = fmaxf(((st[t][0].y + st[t][1].y) + (st[t][2].y + st[t][3].y)) * (1.f / 256.f) - mu * mu, 0.f);
            const float rstd = 1.f / sqrtf(var + EPS);
            bf16_t* gp = proj + (size_t)(m + t * m_step) * DIN + C_GR + 16 * lane;
#pragma unroll
            for (int k = 0; k < 2; ++k) { float of[8], gf[8], r[8]; unpack8(ov[t][k], of); unpack8(gv[t][k], gf);
#pragma unroll
                for (int j = 0; j < 8; ++j) r[j] = ((of[j] - mu) * rstd * gg[8 * k + j] + bb[8 * k + j]) * (gf[j] * fsigmoid(gf[j]));
                *(u32x4*)(gp + 8 * k) = pack8(r); }
        }
    }
}

#define XB_TMO      128
#define XB_XCNT(j)  (256  + 64 * (j))
#define XB_XSUB(j)  (1280 + 64 * (j))
#define XB_XGEN(j)  (2304 + 64 * (j))
#define XB_TOP      3328
#define XB_TOPGEN   3392
#define XCD_BAR_WORDS 3456
#define XB_SPIN_CAP (1u << 18)
__device__ __forceinline__ unsigned xb_ld(unsigned* p)              { return __hip_atomic_load(p, __ATOMIC_RELAXED, __HIP_MEMORY_SCOPE_AGENT); }
__device__ __forceinline__ unsigned xb_add(unsigned* p, unsigned v) { return __hip_atomic_fetch_add(p, v, __ATOMIC_RELAXED, __HIP_MEMORY_SCOPE_AGENT); }
__device__ __forceinline__ unsigned xb_xcc_id() { return (unsigned)__builtin_amdgcn_s_getreg((3 << 11) | 20) & 0xFu; }
#define XB_SPIN(cond, bar) do { unsigned _sp = 0; while (cond) { __builtin_amdgcn_s_sleep(1); \
    if ((++_sp & 255u) == 0u) { if (xb_ld(&(bar)[XB_TMO])) break; if (_sp > XB_SPIN_CAP) { atomicAdd(&(bar)[XB_TMO], 1u); break; } } } } while (0)
struct XcdBarrier { unsigned* bar; unsigned x; volatile LAS unsigned* st; };
__device__ __forceinline__ XcdBarrier xcd_barrier_post(unsigned* bar, volatile LAS unsigned* st) {
    XcdBarrier b; b.bar = bar; b.x = xb_xcc_id(); b.st = st;
    if (threadIdx.x == 0) (void)xb_add(&bar[XB_XCNT(b.x)], 1u);
    return b;
}
__device__ __forceinline__ void xcd_barrier_complete(unsigned* bar, unsigned x, unsigned& nloc, unsigned& nx) {
    const unsigned G = gridDim.x * gridDim.y * gridDim.z;
    unsigned sum, cnt, mine, sp = 0u;
    for (;;) {
        sum = 0u; cnt = 0u; mine = 0u;
#pragma unroll
        for (unsigned j = 0; j < 16; ++j) { const unsigned c = xb_ld(&bar[XB_XCNT(j)]); sum += c; cnt += (c > 0u) ? 1u : 0u; mine = (j == x) ? c : mine; }
        if (sum == G) break;
        __builtin_amdgcn_s_sleep(1);
        if ((++sp & 255u) == 0u) { if (xb_ld(&bar[XB_TMO])) break; if (sp > XB_SPIN_CAP) { atomicAdd(&bar[XB_TMO], 1u); break; } }
    }
    nloc = mine > 0u ? mine : 1u; nx = cnt > 0u ? cnt : 1u;
}
__device__ __forceinline__ void xcd_barrier(const XcdBarrier& b) {
    asm volatile("s_waitcnt vmcnt(0)" ::: "memory");
    __syncthreads();
    if (threadIdx.x == 0) {
        unsigned* bar = b.bar;
        __builtin_amdgcn_s_waitcnt(0);
        unsigned nloc = b.st[0], nx = b.st[1];
        if (nloc == 0u) { xcd_barrier_complete(bar, b.x, nloc, nx); b.st[0] = nloc; b.st[1] = nx; }
        const unsigned old = xb_add(&bar[XB_XSUB(b.x)], 1u);
        const unsigned gen = old / nloc;
        if (old + 1u == (gen + 1u) * nloc) {
            __builtin_amdgcn_fence(__ATOMIC_RELEASE, "agent");
            asm volatile("s_waitcnt vmcnt(0)" ::: "memory");
            const unsigned og = xb_add(&bar[XB_TOP], 1u);
            const unsigned tg = og / nx;
            if (og + 1u == (tg + 1u) * nx) xb_add(&bar[XB_TOPGEN], 1u);
            else XB_SPIN(xb_ld(&bar[XB_TOPGEN]) == tg, bar);
            __builtin_amdgcn_fence(__ATOMIC_ACQUIRE, "agent");
            xb_add(&bar[XB_XGEN(b.x)], 1u);
            asm volatile("s_waitcnt vmcnt(0)" ::: "memory");
        } else {
            XB_SPIN(xb_ld(&bar[XB_XGEN(b.x)]) == gen, bar);
            __builtin_amdgcn_fence(__ATOMIC_ACQUIRE, "agent");
            asm volatile("s_waitcnt vmcnt(0)" ::: "memory");
        }
    }
    __syncthreads();
}

struct Args { const float* in[17]; float* out; unsigned char* ws; int never; int pad; };

__global__ void __launch_bounds__(512, 2) fwd_kernel(Args args) {
    extern __shared__ __attribute__((aligned(16))) unsigned char lds[];
    cg::grid_group grid = cg::this_grid();
    const int tid = threadIdx.x, lane = tid & 63, wave = __builtin_amdgcn_readfirstlane(tid >> 6);
    const int G = gridDim.x, bid = blockIdx.x;
    const int gw = bid * 8 + wave, NGW = G * 8;
    unsigned char* ws = args.ws;
    const float* x = args.in[0]; const float* attn_norm = args.in[1]; const float* w_in = args.in[2]; const float* ret_gain = args.in[3]; const float* ret_bias = args.in[4];
    const float* q_gain = args.in[5]; const float* k_gain = args.in[6]; const float* w_ret_o = args.in[7]; const float* w_moba_o = args.in[8]; const float* w_gate = args.in[9];
    const float* b_gate = args.in[10]; const float* w_out = args.in[11]; const float* ffn_norm = args.in[12]; const float* w_up = args.in[13]; const float* conv_w = args.in[14];
    const float* conv_b = args.in[15]; const float* w_down = args.in[16];
    float* out = args.out;
    bf16_t* W1 = (bf16_t*)(ws + WS_W1); bf16_t* W2 = (bf16_t*)(ws + WS_W2); bf16_t* WO = (bf16_t*)(ws + WS_WO); bf16_t* WUP = (bf16_t*)(ws + WS_WUP); bf16_t* WDN = (bf16_t*)(ws + WS_WDN);
    f32x2* rope = (f32x2*)(ws + WS_ROPE); float* kmean = (float*)(ws + WS_KMEAN); f32x2* stats = (f32x2*)(ws + WS_STATS);
    bf16_t* HB = (bf16_t*)(ws + WS_H); bf16_t* PROJ = (bf16_t*)(ws + WS_PROJ); bf16_t* ACT = (bf16_t*)(ws + WS_PROJ); float* UH = (float*)(ws + WS_UH); bf16_t* XB = (bf16_t*)(ws + WS_XB); float* SSQ = (float*)(ws + WS_STATS); float* RSTD = (float*)(ws + WS_RSTD);
    bf16_t* GATES = (bf16_t*)out;
    LAS unsigned char* lds3 = (LAS unsigned char*)lds;
#ifndef PROBE_A
#define PROBE_A -1
#endif
#ifndef PROBE_B
#define PROBE_B -1
#endif
    unsigned long long* stamps = (unsigned long long*)(ws + 46 * MiB);
    int n_stamp = 0;
#define STAMP() do { if (PROBE_A >= 0) { if (bid == 0 && tid == 0) stamps[n_stamp] = __builtin_amdgcn_s_memrealtime(); ++n_stamp; } } while (0)
    STAMP();
    unsigned* barw = (unsigned*)(ws + 47 * MiB);
    volatile LAS unsigned* bst = (volatile LAS unsigned*)(lds3 + LDS_BYTES - 256);
    if (tid < 2) bst[tid] = 0u;
    const XcdBarrier xbar = xcd_barrier_post(barw, bst);
#define GSYNC() xcd_barrier(xbar)

#ifndef PHMASK
#define PHMASK 0xffff
#endif
#define RUNP(n) ((((PHMASK) >> (n)) & 1) != 0)
    if constexpr (RUNP(0)) {
        float* scr = (float*)(lds + wave * 16384);
        constexpr int I_IN = 16 * (DIN / 32), I_G = 16 * (NGATE / 32), I_O = 16 * 32, I_UP = 16 * (NUP / 32), I_DN = (DFF / 64) * 32;
        (void)I_O; (void)I_UP; (void)I_DN;
        for (int it = gw; it < I_IN + I_G; it += NGW) {
            int r = it;
            if (r < I_IN) { transpose_item<2>(w_in, DM, DIN, W1, DM, 0, 0, scr, r, lane); continue; } r -= I_IN;
            transpose_item(w_gate, DM, NGATE, W1, DM, DIN, 0, scr, r, lane);
        }
        for (int m = gw; m < M; m += 2 * NGW) {
            const int m2 = m + NGW;
            const f32x4* xa = (const f32x4*)(x + (size_t)m * DM) + lane; const f32x4* xc = (const f32x4*)(x + (size_t)m2 * DM) + lane; const f32x4* gr = (const f32x4*)attn_norm + lane;
            f32x4 va[4], vc[4]; float sa = 0.f, sc = 0.f;
#pragma unroll
            for (int j = 0; j < 4; ++j) { va[j] = xa[64 * j]; vc[j] = xc[64 * j]; }
#pragma unroll
            for (int j = 0; j < 4; ++j) { sa += (va[j].x * va[j].x + va[j].y * va[j].y) + (va[j].z * va[j].z + va[j].w * va[j].w); sc += (vc[j].x * vc[j].x + vc[j].y * vc[j].y) + (vc[j].z * vc[j].z + vc[j].w * vc[j].w); }
            const float ra = 1.f / sqrtf(wave_sum(sa) * (1.f / DM) + EPS), rc = 1.f / sqrtf(wave_sum(sc) * (1.f / DM) + EPS);
            u32x2* oa = (u32x2*)(HB + (size_t)m * DM) + lane; u32x2* oc = (u32x2*)(HB + (size_t)m2 * DM) + lane;
#pragma unroll
            for (int j = 0; j < 4; ++j) { const f32x4 gg = gr[64 * j]; u32x2 w; w.x = pk2(va[j].x * ra * gg.x, va[j].y * ra * gg.y); w.y = pk2(va[j].z * ra * gg.z, va[j].w * ra * gg.w); oa[64 * j] = w;
                u32x2 w2; w2.x = pk2(vc[j].x * rc * gg.x, vc[j].y * rc * gg.y); w2.y = pk2(vc[j].z * rc * gg.z, vc[j].w * rc * gg.w); oc[64 * j] = w2; }
        }
        for (int i = bid * 512 + tid; i < NB * 8 * 8 * 128; i += G * 512) kmean[i] = 0.f;
        for (int i = bid * 512 + tid; i < SEQ * 64; i += G * 512) {
            const int pos = i >> 6, fi = i & 63;
            const float inv_freq = __builtin_amdgcn_exp2f(-(float)fi * (13.287712379549449f / 64.f));
            double rev = (double)pos * (double)inv_freq * 0.15915494309189535; rev -= __builtin_floor(rev);
            const float rf = (float)rev;
            rope[i] = (f32x2){__builtin_amdgcn_cosf(rf), __builtin_amdgcn_sinf(rf)};
        }
    }
    if (args.never) grid.sync();
    GSYNC(); STAMP();
#ifdef DUP_SYNC
    for (int i_ = 0; i_ < 10; ++i_) GSYNC();
#endif
#ifdef DUP_G1
    {
        pg8::Gemm g{HB, W1, M, N1, DM, DM}; pg8::StaticOrder S; S.init(M, N1, G, bid);
        pg8::EpiProj E{PROJ, GATES, b_gate, q_gain, k_gain, kmean, (float*)(lds + 131072), rope};
        pg8::gemm_phase<pg8::EpiProj>(lds3, g, S, E);
    }
#endif
    if constexpr (RUNP(1)) {
        pg8::Gemm g{HB, W1, M, N1, DM, DM}; pg8::StaticOrder S; S.init(M, N1, G, bid);
        pg8::EpiProj E{PROJ, GATES, b_gate, q_gain, k_gain, kmean, (float*)(lds + 131072), rope};
        pg8::gemm_phase<pg8::EpiProj>(lds3, g, S, E);
    }
    GSYNC(); STAMP();
    if constexpr (RUNP(2)) {
#ifdef DUP_RET
        for (int it = bid; it < NB * 4 * 4; it += G) retention_item(lds, PROJ, rope, stats, it >> 4, (it >> 2) & 3, it & 3, (bf16_t*)(ws + 500 * MiB));
#endif
        if constexpr (RUNP(10)) for (int it = bid; it < NB * 4 * 4; it += G) retention_item(lds, PROJ, rope, stats, it >> 4, (it >> 2) & 3, it & 3);
        {
            float* scr = (float*)(lds + wave * 16384);
            constexpr int I_O = 16 * 32, I_UP = 16 * (NUP / 32), I_DN = (DFF / 64) * 32;
            for (int it = gw; it < 3 * I_O + I_UP + I_DN; it += NGW) {
                int r = it;
                if (r < I_O) { transpose_item(w_ret_o, DM, DM, W2, 2 * DM, 0, 0, scr, r, lane); continue; } r -= I_O;
                if (r < I_O) { transpose_item(w_moba_o, DM, DM, W2, 2 * DM, 0, DM, scr, r, lane); continue; } r -= I_O;
                if (r < I_O) { transpose_item(w_out, DM, DM, WO, DM, 0, 0, scr, r, lane); continue; } r -= I_O;
                if (r < I_UP) { transpose_item<1>(w_up, DM, NUP, WUP, DM, 0, 0, scr, r, lane, ffn_norm); continue; } r -= I_UP;
                transpose_item(w_down, DFF, DM, WDN, DFF, 0, 0, scr, r, lane);
            }
        }
    }
    GSYNC(); STAMP();
    if constexpr (RUNP(3)) {
      const int first_fin = (bid >> 3) & 1;
#pragma unroll 1
      for (int step = 0; step < 2; ++step) {
       if ((step ^ first_fin) == 1) {
        for (int bh = bid >> 1; bh < NB * 8; bh += (G >> 1)) {
            const int par = bid & 1;
#pragma unroll 1
            for (int k = 0; k < 4; ++k) { const int own = par ? (k == 0 ? 6 : k == 1 ? 5 : k == 2 ? 2 : 1) : (k == 0 ? 7 : k == 1 ? 4 : k == 2 ? 3 : 0);
#ifdef DUP_MOBA
                moba_unit(lds, PROJ, HB, kmean, bh >> 3, bh & 7, own, (bf16_t*)(ws + 500 * MiB));
#endif
                moba_unit(lds, PROJ, HB, kmean, bh >> 3, bh & 7, own); }
        }
       } else {
        retfin_rows(PROJ, stats, ret_gain, ret_bias, gw, NGW, lane);
       }
      }
    }
    GSYNC(); STAMP();
    if constexpr (RUNP(4)) {
        pg8::Gemm g{PROJ + C_GR, W2, M, DM, 2 * DM, DIN}; pg8::StaticOrder S; S.init(M, DM, G, bid);
        pg8::EpiMerge E{GATES, HB};
        pg8::gemm_phase<pg8::EpiMerge>(lds3, g, S, E);
    }
    GSYNC(); STAMP();
#ifdef DUP_G4
    {
        pg8::Gemm g{HB, WO, M, DM, DM, DM}; pg8::StaticOrder S; S.init(M, DM, G, bid);
        pg8::EpiResidNorm E{x, XB, SSQ};
        pg8::gemm_phase<pg8::EpiResidNorm>(lds3, g, S, E);
    }
    GSYNC();
#endif
    if constexpr (RUNP(5)) {
        pg8::Gemm g{HB, WO, M, DM, DM, DM}; pg8::StaticOrder S; S.init(M, DM, G, bid);
        pg8::EpiResidNorm E{x, XB, SSQ};
        pg8::gemm_phase<pg8::EpiResidNorm>(lds3, g, S, E);
    }
    GSYNC(); STAMP();
    for (int m = bid * 512 + tid; m < M; m += G * 512) { const f32x4* p = (const f32x4*)(SSQ + (size_t)m * 16); const f32x4 a = p[0], b = p[1], c = p[2], d = p[3];
        const float s = ((a.x + a.y) + (a.z + a.w)) + ((b.x + b.y) + (b.z + b.w)) + ((c.x + c.y) + (c.z + c.w)) + ((d.x + d.y) + (d.z + d.w));
        RSTD[m] = 1.f / sqrtf(s * (1.f / DM) + EPS); }
    GSYNC(); STAMP();
#ifdef DUP_G5
    {
        pg8::Gemm g{XB, WUP, M, NUP, DM, DM}; pg8::StaticOrder S; S.init(M, NUP, G, bid);
        pg8::EpiConv E{ACT, UH, conv_w, conv_b, (f32x2*)(lds + 131072), RSTD};
        pg8::gemm_phase<pg8::EpiConv, true, true, true>(lds3, g, S, E);
    }
#endif
    {
        pg8::Gemm g{XB, WUP, M, NUP, DM, DM}; pg8::StaticOrder S; S.init(M, NUP, G, bid);
        pg8::EpiConv E{ACT, UH, conv_w, conv_b, (f32x2*)(lds + 131072), RSTD};
        pg8::gemm_phase<pg8::EpiConv, true, true, true>(lds3, g, S, E);
    }
    GSYNC(); STAMP();
    for (int idx = bid * 512 + tid; idx < 112 * DFF; idx += G * 512) {
        const int t = idx / DFF, c = idx - t * DFF, pm = (t / 7) * 8 + (t % 7) + 1;
        const int colg = 256 * (c >> 7) + (c & 127), colv = colg + 128;
        const float* up = UH + ((size_t)(pm - 1) * 4 + 2) * NUP; const float* uc = UH + ((size_t)pm * 4) * NUP;
        const float a2 = up[colg], a1 = up[NUP + colg], a0 = uc[colg], an = uc[NUP + colg];
        const float b2 = up[colv], b1 = up[NUP + colv], b0 = uc[colv], bn = uc[NUP + colv];
        const float gb = conv_b[c], g0 = conv_w[c], g1 = conv_w[NUP + c], g2 = conv_w[2 * NUP + c];
        const float vb = conv_b[DFF + c], v0 = conv_w[DFF + c], v1 = conv_w[NUP + DFF + c], v2 = conv_w[2 * NUP + DFF + c];
        const float og0 = gb + g0 * a2 + g1 * a1 + g2 * a0, og1 = gb + g0 * a1 + g1 * a0 + g2 * an;
        const float ov0 = vb + v0 * b2 + v1 * b1 + v2 * b0, ov1 = vb + v0 * b1 + v1 * b0 + v2 * bn;
        const unsigned w = pk2(og0 * fsigmoid(og0) * ov0, og1 * fsigmoid(og1) * ov1);
        ACT[(size_t)(pm * 256) * DFF + c] = (bf16_t)(w & 0xffffu); ACT[(size_t)(pm * 256 + 1) * DFF + c] = (bf16_t)(w >> 16);
    }
    GSYNC(); STAMP();
    {
        pg8::Gemm g{ACT, WDN, M, DM, DFF, DFF}; pg8::StaticOrder S; S.init(M, DM, G, bid);
        pg8::EpiResid E{XB, out};
        pg8::gemm_phase<pg8::EpiResid>(lds3, g, S, E);
    }
    if (PROBE_A >= 0) {
        GSYNC(); STAMP(); __threadfence(); __syncthreads();
        if (bid == 0) {
            const int pa = PROBE_A, pb = PROBE_B;
            const float ta = (float)(stamps[pa + 1] - stamps[pa]) * 0.01f;
            const float tb = pb >= 100 ? (float)(stamps[n_stamp - 1] - stamps[0]) * 0.01f : (pb >= 0 ? (float)(stamps[pb + 1] - stamps[pb]) * 0.01f : 0.f);
            if (tid == 0) out[0] += ta * 0.01f;
            for (int i = tid; i < 65536; i += 512) out[4096 + i] += tb * 0.001f;
        }
    }
}

extern "C" void kernel_launch(void* const* d_in, const int* in_sizes, int n_in, void* d_out, int out_size, void* d_ws, size_t ws_size, hipStream_t stream) {
    static int grid = 0;
    if (grid == 0) {
        if (n_in != 17 || out_size != M * DM || ws_size < WS_END) { fprintf(stderr, "kernel_launch: unexpected shapes (n_in %d out %d ws %zu)\n", n_in, out_size, ws_size); grid = -1; return; }
        int dev = 0, cus = 0, per_cu = 0;
        hipGetDevice(&dev); hipDeviceGetAttribute(&cus, hipDeviceAttributeMultiprocessorCount, dev);
        hipFuncSetAttribute((const void*)fwd_kernel, hipFuncAttributeMaxDynamicSharedMemorySize, LDS_BYTES);
        hipOccupancyMaxActiveBlocksPerMultiprocessor(&per_cu, (const void*)fwd_kernel, 512, LDS_BYTES);
        if (per_cu < 1) { fprintf(stderr, "kernel_launch: occupancy query says %d blocks per CU\n", per_cu); per_cu = 1; }
        (void)hipGetLastError();
        grid = cus * per_cu;
    }
    if (grid < 0) return;
    if (hipMemsetAsync((char*)d_ws + 47 * MiB, 0, XCD_BAR_WORDS * 4, stream) != hipSuccess) { fprintf(stderr, "kernel_launch: memset of the barrier words failed\n"); return; }
    Args a{};
    for (int i = 0; i < 17; ++i) a.in[i] = (const float*)d_in[i];
    a.out = (float*)d_out; a.ws = (unsigned char*)d_ws;
    void* params[] = {&a};
    hipError_t e = hipLaunchCooperativeKernel((const void*)fwd_kernel, dim3(grid), dim3(512), params, LDS_BYTES, stream);
    if (e != hipSuccess) fprintf(stderr, "cooperative launch failed: %s (grid %d)\n", hipGetErrorString(e), grid);
}
```
